# Optimizing an MI355X kernel written in HIP

```python
import math
import jax
import jax.numpy as jnp
from jax import lax
import numpy as np

D_MODEL = 1024
BATCH = 2
SEQ = 16384
DEPTH = 1

N_MEM = 256
ATTN_HEADS = 8
ATTN_HEAD_DIM = D_MODEL // 16
DILATED_PATTERNS = ((128, 1), (512, 4), (2048, 16))
RET_HEADS = 4
RET_QK_DIM = D_MODEL // 16
RET_V_DIM = D_MODEL // 8
RET_CHUNK = 128
RET_BASE_EXP = 5
ATTN_WIDTH = ATTN_HEADS * ATTN_HEAD_DIM
RET_QK_WIDTH = RET_HEADS * RET_QK_DIM
RET_V_WIDTH = RET_HEADS * RET_V_DIM
MIX_WIDTH = ATTN_WIDTH + RET_V_WIDTH
IN_PROJ_COLS = 3 * ATTN_WIDTH + 2 * RET_QK_WIDTH + 2 * RET_V_WIDTH
MEM_HEADS = 4
MEM_HEAD_DIM = D_MODEL // MEM_HEADS
N_GROUPS = 4
EXPERTS_PER_GROUP = 8
N_EXPERTS = N_GROUPS * EXPERTS_PER_GROUP
EXPERT_TOP_K = 2
EXPERT_FF = D_MODEL // 2
MOE_BLOCK = 128
NORM_EPS = 1e-6
GN_EPS = 1e-5
NEG_INF = -1e30

kernel_name = 'hybrid_dilated_retention_hmoe_encoder'


def rms_norm(x, w, eps=NORM_EPS):
    xf = x.astype(jnp.float32)
    y = xf * lax.rsqrt(jnp.mean(xf * xf, axis=-1, keepdims=True) + eps)
    return (y * w.astype(jnp.float32)).astype(x.dtype)


def split_heads(t, n_heads, head_dim):
    b, s, _ = t.shape
    return t.reshape(b, s, n_heads, head_dim).transpose(0, 2, 1, 3)


def merge_heads(t):
    b, h, s, d = t.shape
    return t.transpose(0, 2, 1, 3).reshape(b, s, h * d)


def alibi_slopes(n_heads):
    exps = jnp.arange(1, n_heads + 1, dtype=jnp.float32)
    return jnp.exp2(-8.0 * exps / n_heads)


def dilated_window_attention(q, k, v, slopes, window, dilation):
    B, H, S, hd = q.shape
    half = window // (2 * dilation)
    L = S // dilation
    nb = -(-L // half)
    Lp = nb * half

    def to_sub(t):
        return t.reshape(B, H, L, dilation, hd).transpose(0, 1, 3, 2, 4)

    qs, ks, vs = to_sub(q), to_sub(k), to_sub(v)
    qb = jnp.pad(qs, ((0, 0), (0, 0), (0, 0), (0, Lp - L), (0, 0))).reshape(B, H, dilation, nb, half, hd)
    kv_pad = ((0, 0), (0, 0), (0, 0), (half, Lp - L + half), (0, 0))
    kp = jnp.pad(ks, kv_pad).reshape(B, H, dilation, nb + 2, half, hd)
    vp = jnp.pad(vs, kv_pad).reshape(B, H, dilation, nb + 2, half, hd)

    def band(t):
        return jnp.concatenate([t[:, :, :, 0:nb], t[:, :, :, 1:nb + 1], t[:, :, :, 2:nb + 2]], axis=4)

    kb, vb = band(kp), band(vp)
    s = jnp.einsum('bhrnqd,bhrnkd->bhrnqk', qb, kb, preferred_element_type=jnp.float32)
    qi = jnp.arange(half)
    kc = jnp.arange(3 * half)
    delta = kc[None, :] - half - qi[:, None]
    key_pos = jnp.arange(nb)[:, None] * half - half + kc[None, :]
    allowed = (jnp.abs(delta) <= half)[None] & ((key_pos >= 0) & (key_pos < L))[:, None, :]
    bias = -slopes[:, None, None] * (dilation * jnp.abs(delta)).astype(jnp.float32)
    s = s + bias[None, :, None, None]
    s = jnp.where(allowed[None, None, None], s, NEG_INF)
    m = jnp.max(s, axis=-1, keepdims=True)
    p = jnp.exp(s - m)
    denom = jnp.sum(p, axis=-1, keepdims=True)
    o = jnp.einsum('bhrnqk,bhrnkd->bhrnqd', p.astype(v.dtype), vb, preferred_element_type=jnp.float32) / denom
    lse = (m + jnp.log(denom))[..., 0]

    def from_sub(t):
        t = t.reshape((B, H, dilation, Lp) + t.shape[5:])[:, :, :, :L]
        t = jnp.moveaxis(t, 2, 3)
        return t.reshape((B, H, S) + t.shape[4:])

    return from_sub(o), from_sub(lse)


def retention_chunkwise(q, k, v, log_gamma, inclusive):
    B, H, S, dk = q.shape
    dv = v.shape[-1]
    C = RET_CHUNK
    nC = S // C
    qc = q.reshape(B, H, nC, C, dk)
    kc = k.reshape(B, H, nC, C, dk)
    vc = v.reshape(B, H, nC, C, dv)
    i = jnp.arange(C)
    lg = log_gamma[:, None]
    diff = i[:, None] - i[None, :]
    mask = diff >= 0 if inclusive else diff > 0
    decay_mat = jnp.where(mask[None], jnp.exp(lg[:, :, None] * jnp.maximum(diff, 0)[None]), 0.0)
    scores = jnp.einsum('bhnid,bhnjd->bhnij', qc, kc) * decay_mat[None, :, None]
    y_intra = jnp.einsum('bhnij,bhnje->bhnie', scores, vc)
    k_dec = jnp.exp(lg * (C - 1 - i)[None])
    chunk_kv = jnp.einsum('bhnjd,hj,bhnje->bhnde', kc, k_dec, vc)
    chunk_decay = jnp.exp(log_gamma * C)[None, :, None, None]

    def step(state, kv_n):
        return state * chunk_decay + kv_n, state

    _, prev = lax.scan(step, jnp.zeros((B, H, dk, dv), q.dtype), jnp.moveaxis(chunk_kv, 2, 0))
    prev = jnp.moveaxis(prev, 0, 2)
    q_dec = jnp.exp(lg * (i + 1)[None])
    y_cross = jnp.einsum('bhnid,hi,bhnde->bhnie', qc, q_dec, prev)
    return (y_intra + y_cross).reshape(B, H, S, dv)


def head_group_norm(y, w, eps=GN_EPS):
    mu = jnp.mean(y, axis=-1, keepdims=True)
    var = jnp.mean(jnp.square(y - mu), axis=-1, keepdims=True)
    return merge_heads((y - mu) * lax.rsqrt(var + eps)) * w.astype(jnp.float32)


def parallel_mixer(h, w_in, q_norm_w, k_norm_w, decay_f, decay_b, gn_w, w_out):
    f32 = jnp.float32
    proj = h @ w_in
    a3 = 3 * ATTN_WIDTH
    cuts = [ATTN_WIDTH, 2 * ATTN_WIDTH, a3, a3 + RET_QK_WIDTH, a3 + 2 * RET_QK_WIDTH,
            a3 + 2 * RET_QK_WIDTH + RET_V_WIDTH]
    aq, ak, av, rq, rk, rv, rg = jnp.split(proj, cuts, axis=-1)
    q = rms_norm(split_heads(aq, ATTN_HEADS, ATTN_HEAD_DIM), q_norm_w) * (ATTN_HEAD_DIM ** -0.5)
    k = rms_norm(split_heads(ak, ATTN_HEADS, ATTN_HEAD_DIM), k_norm_w)
    v = split_heads(av, ATTN_HEADS, ATTN_HEAD_DIM)
    slopes = alibi_slopes(ATTN_HEADS)
    outs, lses = [], []
    for window, dilation in DILATED_PATTERNS:
        o, lse = dilated_window_attention(q, k, v, slopes, window, dilation)
        outs.append(o)
        lses.append(lse)
    mix_w = jax.nn.softmax(jnp.stack(lses), axis=0)
    attn = jnp.einsum('pbhs,pbhsd->bhsd', mix_w, jnp.stack(outs))
    attn = merge_heads(attn).astype(h.dtype)
    qr = split_heads(rq, RET_HEADS, RET_QK_DIM).astype(f32)
    kr = split_heads(rk, RET_HEADS, RET_QK_DIM).astype(f32) * (RET_QK_DIM ** -0.5)
    vr = split_heads(rv, RET_HEADS, RET_V_DIM).astype(f32)
    lg_f = jax.nn.log_sigmoid(decay_f.astype(f32))
    lg_b = jax.nn.log_sigmoid(decay_b.astype(f32))
    y_f = retention_chunkwise(qr, kr, vr, lg_f, inclusive=True)
    flip = lambda t: jnp.flip(t, axis=2)
    y_b = flip(retention_chunkwise(flip(qr), flip(kr), flip(vr), lg_b, inclusive=False))
    ret = head_group_norm(y_f + y_b, gn_w)
    ret = (jax.nn.silu(rg.astype(f32)) * ret).astype(h.dtype)
    return jnp.concatenate([attn, ret], axis=-1) @ w_out


def memory_cross_attention(h, mem_h, w_mq, w_mkv, q_norm_w, k_norm_w, w_mo):
    q = rms_norm(split_heads(h @ w_mq, MEM_HEADS, MEM_HEAD_DIM), q_norm_w) * (MEM_HEAD_DIM ** -0.5)
    mk, mv = jnp.split(mem_h @ w_mkv, 2, axis=-1)
    k = rms_norm(split_heads(mk, MEM_HEADS, MEM_HEAD_DIM), k_norm_w)
    v = split_heads(mv, MEM_HEADS, MEM_HEAD_DIM)
    s = jnp.einsum('bhsd,bhmd->bhsm', q, k, preferred_element_type=jnp.float32)
    p = jax.nn.softmax(s, axis=-1)
    o = jnp.einsum('bhsm,bhmd->bhsd', p.astype(v.dtype), v)
    return merge_heads(o) @ w_mo


def hierarchical_moe(h, w_group, w_router, w1, w3, w2):
    B, S, D = h.shape
    N = B * S
    t = h.reshape(N, D)
    g_logits = jnp.einsum('nd,dg->ng', t, w_group, preferred_element_type=jnp.float32)
    g_prob = jax.nn.softmax(g_logits, axis=-1)
    grp = jnp.argmax(g_logits, axis=-1)
    g_gate = jnp.take_along_axis(g_prob, grp[:, None], axis=-1)
    e_logits = jnp.einsum('nd,gde->nge', t, w_router, preferred_element_type=jnp.float32)
    e_logits = jnp.take_along_axis(e_logits, grp[:, None, None], axis=1)[:, 0]
    top_vals, top_idx = lax.top_k(e_logits, EXPERT_TOP_K)
    gates = g_gate * jax.nn.softmax(top_vals, axis=-1)
    expert_id = grp[:, None] * EXPERTS_PER_GROUP + top_idx
    A = N * EXPERT_TOP_K
    e_flat = expert_id.reshape(A)
    tok_flat = jnp.repeat(jnp.arange(N, dtype=jnp.int32), EXPERT_TOP_K)
    gate_flat = gates.reshape(A)
    order = jnp.argsort(e_flat)
    e_sorted = e_flat[order]
    counts = jnp.bincount(e_flat, length=N_EXPERTS)
    starts = jnp.cumsum(counts) - counts
    pcounts = (counts + MOE_BLOCK - 1) // MOE_BLOCK * MOE_BLOCK
    pends = jnp.cumsum(pcounts)
    pstarts = pends - pcounts
    dest = pstarts[e_sorted] + jnp.arange(A) - starts[e_sorted]
    n_blocks = -(-(A + N_EXPERTS * MOE_BLOCK) // MOE_BLOCK)
    n_slots = n_blocks * MOE_BLOCK
    slot_tok = jnp.full((n_slots,), N, dtype=jnp.int32).at[dest].set(tok_flat[order])
    slot_gate = jnp.zeros((n_slots,), jnp.float32).at[dest].set(gate_flat[order])
    block_expert = jnp.clip(jnp.searchsorted(pends, jnp.arange(n_blocks) * MOE_BLOCK, side='right'),
                            0, N_EXPERTS - 1)
    t_pad = jnp.concatenate([t, jnp.zeros((1, D), t.dtype)], axis=0)

    def expert_block(args):
        toks, e = args
        xb = t_pad[toks]
        return (jax.nn.silu(xb @ w1[e]) * (xb @ w3[e])) @ w2[e]

    y_slots = lax.map(expert_block, (slot_tok.reshape(n_blocks, MOE_BLOCK), block_expert))
    y_slots = y_slots.reshape(n_slots, D) * slot_gate[:, None]
    y = jax.ops.segment_sum(y_slots, slot_tok, num_segments=N + 1)[:N]
    return y.astype(h.dtype).reshape(B, S, D)


def setup_inputs(seed: int = 0) -> dict:
    key = jax.random.key(seed)
    ks = jax.random.split(key, 24)
    f32 = jnp.float32

    def normal(k, shape, scale):
        return jax.random.normal(k, shape, f32) * scale

    def gain(k, shape):
        return 1.0 + 0.05 * jax.random.normal(k, shape, f32)

    base_logit = jnp.log(jnp.exp2(RET_BASE_EXP + jnp.arange(RET_HEADS, dtype=f32)) - 1.0)
    return {
        'x': normal(ks[0], (BATCH, SEQ, D_MODEL), 1.0),
        'mem': normal(ks[1], (BATCH, N_MEM, D_MODEL), 1.0),
        'norm_mix_w': gain(ks[2], (DEPTH, D_MODEL)),
        'w_in': normal(ks[3], (DEPTH, D_MODEL, IN_PROJ_COLS), D_MODEL ** -0.5),
        'attn_q_norm_w': gain(ks[4], (DEPTH, ATTN_HEAD_DIM)),
        'attn_k_norm_w': gain(ks[5], (DEPTH, ATTN_HEAD_DIM)),
        'ret_decay_f': base_logit + 0.1 * jax.random.normal(ks[6], (DEPTH, RET_HEADS), f32),
        'ret_decay_b': base_logit + 0.1 * jax.random.normal(ks[7], (DEPTH, RET_HEADS), f32),
        'ret_gn_w': gain(ks[8], (DEPTH, RET_V_WIDTH)),
        'w_out': normal(ks[9], (DEPTH, MIX_WIDTH, D_MODEL), MIX_WIDTH ** -0.5),
        'norm_mem_w': gain(ks[10], (DEPTH, D_MODEL)),
        'norm_memkv_w': gain(ks[11], (DEPTH, D_MODEL)),
        'w_mq': normal(ks[12], (DEPTH, D_MODEL, D_MODEL), D_MODEL ** -0.5),
        'w_mkv': normal(ks[13], (DEPTH, D_MODEL, 2 * D_MODEL), D_MODEL ** -0.5),
        'mem_q_norm_w': gain(ks[14], (DEPTH, MEM_HEAD_DIM)),
        'mem_k_norm_w': gain(ks[15], (DEPTH, MEM_HEAD_DIM)),
        'w_mo': normal(ks[16], (DEPTH, D_MODEL, D_MODEL), D_MODEL ** -0.5),
        'norm_moe_w': gain(ks[17], (DEPTH, D_MODEL)),
        'w_group': normal(ks[18], (DEPTH, D_MODEL, N_GROUPS), D_MODEL ** -0.5),
        'w_router': normal(ks[19], (DEPTH, N_GROUPS, D_MODEL, EXPERTS_PER_GROUP), D_MODEL ** -0.5),
        'w_exp_gate': normal(ks[20], (DEPTH, N_EXPERTS, D_MODEL, EXPERT_FF), D_MODEL ** -0.5),
        'w_exp_up': normal(ks[21], (DEPTH, N_EXPERTS, D_MODEL, EXPERT_FF), D_MODEL ** -0.5),
        'w_exp_down': normal(ks[22], (DEPTH, N_EXPERTS, EXPERT_FF, D_MODEL), EXPERT_FF ** -0.5),
    }


def reference(x, mem, norm_mix_w, w_in, attn_q_norm_w, attn_k_norm_w, ret_decay_f, ret_decay_b,
              ret_gn_w, w_out, norm_mem_w, norm_memkv_w, w_mq, w_mkv, mem_q_norm_w, mem_k_norm_w,
              w_mo, norm_moe_w, w_group, w_router, w_exp_gate, w_exp_up, w_exp_down):
    for l in range(DEPTH):
        x = x + parallel_mixer(rms_norm(x, norm_mix_w[l]), w_in[l], attn_q_norm_w[l], attn_k_norm_w[l],
                               ret_decay_f[l], ret_decay_b[l], ret_gn_w[l], w_out[l])
        x = x + memory_cross_attention(rms_norm(x, norm_mem_w[l]), rms_norm(mem, norm_memkv_w[l]),
                                       w_mq[l], w_mkv[l], mem_q_norm_w[l], mem_k_norm_w[l], w_mo[l])
        x = x + hierarchical_moe(rms_norm(x, norm_moe_w[l]), w_group[l], w_router[l],
                                 w_exp_gate[l], w_exp_up[l], w_exp_down[l])
    return x
```

```cpp
#include <hip/hip_runtime.h>
#include <hip/hip_cooperative_groups.h>
#include <cstdio>
#include <cstdint>
namespace cg = cooperative_groups;
#ifndef ATT_VAR
#define ATT_VAR 0
#endif
#ifndef GEMM_WGM
#define GEMM_WGM 4
#endif
#ifndef REP
#define REP 0
#endif
#ifndef DBG_P7
#define DBG_P7 0
#endif

#define LAS __attribute__((address_space(3)))
#define GAS __attribute__((address_space(1)))
typedef unsigned short bf16_t;
typedef short bf16x8 __attribute__((ext_vector_type(8)));
typedef short bf16x4 __attribute__((ext_vector_type(4)));
typedef float f32x4 __attribute__((ext_vector_type(4)));
typedef float f32x2 __attribute__((ext_vector_type(2)));
typedef unsigned u32x4 __attribute__((ext_vector_type(4)));
typedef unsigned u32x2 __attribute__((ext_vector_type(2)));

constexpr int NB = 2, SEQ = 16384, NT = NB * SEQ, DM = 1024;
constexpr int NMEM = 256;
constexpr int NEXP = 32, FF = 512;
constexpr int NWAVES = 8, NTHR = 512;
constexpr int MAX_TILES = 288, MAX_SLOTS = MAX_TILES * 256;

constexpr size_t MiB = 1u << 20;
constexpr size_t WS_CTL = 0, CTL_ZERO_BYTES = 64 * 1024;
constexpr size_t WS_SUMSQ1 = 64 * 1024, WS_SUMSQ2 = 192 * 1024, WS_HSQ = 320 * 1024;
constexpr int CW_CNT = 2048, CW_FILL = 2048 + 64, CW_NTILES = 2048 + 128;
constexpr size_t WS_WIN = 2 * MiB, WS_WOUT = 8 * MiB, WS_WMQ = 10 * MiB, WS_WMKV = 12 * MiB, WS_WMO = 16 * MiB, WS_W13 = 18 * MiB, WS_W2 = 82 * MiB;
constexpr size_t WS_MEMH = 114 * MiB, WS_MK = 115 * MiB, WS_MVT = 116 * MiB, WS_ROUTE = 117 * MiB, WS_SLOTTOK = 118 * MiB, WS_SLOTGATE = 118 * MiB + 512 * 1024, WS_TILEEXP = 119 * MiB;
constexpr size_t WS_AQ = 128 * MiB, WS_AK = 160 * MiB, WS_AV = 192 * MiB, WS_RQ = 224 * MiB, WS_RK = 240 * MiB, WS_RV = 256 * MiB, WS_RG = 288 * MiB;
constexpr size_t WS_X1B = 128 * MiB, WS_QM = 192 * MiB, WS_OM = 256 * MiB, WS_Y = 128 * MiB;
constexpr size_t WS_XB = 320 * MiB, WS_MIX = 320 * MiB, WS_X2B = 320 * MiB;
constexpr size_t WS_KV = 384 * MiB, WS_ST = 448 * MiB, WS_H = 384 * MiB;
constexpr size_t WS_WRT = 119 * MiB + 64 * 1024;
constexpr size_t WS_X1L = 384 * MiB, WS_X2L = 192 * MiB;
constexpr size_t WS_RSTD0 = 125 * MiB;
constexpr size_t WS_X2Q = 192 * MiB;
constexpr size_t WS_END = 512 * MiB;

constexpr int LDS_BYTES = 147456;

__device__ __forceinline__ unsigned cvt_pk_bf16(float lo, float hi) { unsigned r; asm volatile("s_nop 0\n\tv_cvt_pk_bf16_f32 %0, %1, %2" : "=v"(r) : "v"(lo), "v"(hi)); return r; }
typedef __bf16 bf16v2_t __attribute__((ext_vector_type(2)));
__device__ __forceinline__ unsigned cvt_pk_bf16_c(float lo, float hi) { f32x2 v = {lo, hi}; bf16v2_t r = __builtin_convertvector(v, bf16v2_t); return __builtin_bit_cast(unsigned, r); }
__device__ __forceinline__ float bf2f(unsigned short b) { return __uint_as_float(((unsigned)b) << 16); }
__device__ __forceinline__ float bflo(unsigned w) { return __uint_as_float(w << 16); }
__device__ __forceinline__ float bfhi(unsigned w) { return __uint_as_float(w & 0xffff0000u); }
__device__ __forceinline__ float xl_dpp_quad1(float v) { return __builtin_bit_cast(float, __builtin_amdgcn_update_dpp(0, __builtin_bit_cast(int, v), 0xB1, 0xF, 0xF, true)); }
__device__ __forceinline__ float xl_dpp_quad2(float v) { return __builtin_bit_cast(float, __builtin_amdgcn_update_dpp(0, __builtin_bit_cast(int, v), 0x4E, 0xF, 0xF, true)); }
__device__ __forceinline__ float xl_dpp_ror4(float v)  { return __builtin_bit_cast(float, __builtin_amdgcn_update_dpp(0, __builtin_bit_cast(int, v), 0x124, 0xF, 0xF, true)); }
__device__ __forceinline__ float xl_dpp_ror8(float v)  { return __builtin_bit_cast(float, __builtin_amdgcn_update_dpp(0, __builtin_bit_cast(int, v), 0x128, 0xF, 0xF, true)); }
__device__ __forceinline__ float xl_swz16(float v)     { return __builtin_bit_cast(float, __builtin_amdgcn_ds_swizzle(__builtin_bit_cast(int, v), 0x401F)); }
__device__ __forceinline__ void xl_swap32(float& a, float& b) { asm volatile("s_nop 1\n\tv_permlane32_swap_b32 %0, %1\n\ts_nop 1" : "+v"(a), "+v"(b)); }
__device__ __forceinline__ float sum_g4(float v) { v += xl_swz16(v); float a = v, b = v; xl_swap32(a, b); return a + b; }
__device__ __forceinline__ float max_g4(float v) { v = fmaxf(v, xl_swz16(v)); float a = v, b = v; xl_swap32(a, b); return fmaxf(a, b); }
__device__ __forceinline__ float sum_row16(float v) { v += xl_dpp_quad1(v); v += xl_dpp_quad2(v); v += xl_dpp_ror4(v); v += xl_dpp_ror8(v); return v; }
__device__ __forceinline__ float max_row16(float v) { v = fmaxf(v, xl_dpp_quad1(v)); v = fmaxf(v, xl_dpp_quad2(v)); v = fmaxf(v, xl_dpp_ror4(v)); v = fmaxf(v, xl_dpp_ror8(v)); return v; }
__device__ __forceinline__ float wave_sum(float v) { return sum_g4(sum_row16(v)); }
__device__ __forceinline__ float wave_max(float v) { return max_g4(max_row16(v)); }
__device__ __forceinline__ float fast_exp(float x) { return __builtin_amdgcn_exp2f(x * 1.44269504089f); }
__device__ __forceinline__ float silu_f(float x) { return x * __builtin_amdgcn_rcpf(1.0f + fast_exp(-x)); }
#define LDS_WAIT() asm volatile("s_waitcnt lgkmcnt(0)" ::: "memory")
#define VM_WAIT() asm volatile("s_waitcnt vmcnt(0)" ::: "memory")

namespace pg8 {
constexpr int BM = 256, BK = 64, HALF = 128, HTB = HALF * BK * 2, STAGE_BYTES = 8 * HTB, NXCD = 8, WGM = 8;
__host__ __device__ __forceinline__ int lds_byte(int r, int c) { const int st = (r >> 4) * 2 + (c >> 5), rr = r & 15, cc = c & 31, ob = rr * 64 + cc * 2; return st * 1024 + (ob ^ (((ob >> 9) & 1) << 5)); }
__host__ __device__ __forceinline__ void stage_rc(int b, int& R, int& C) { const int st = b / 1024, sb = b % 1024, swz = sb ^ (((sb >> 9) & 1) << 5); R = (st >> 1) * 16 + swz / 64; C = (st & 1) * 32 + (swz % 64) / 2; }
__host__ __device__ __forceinline__ int perm32(int rho) { const int n = rho >> 4, i = rho & 15; return 8 * (i >> 2) + 4 * n + (i & 3); }

struct Unit { int pm, pn; const char* A; const char* B; int aux; };

struct DenseOrder {
    static constexpr bool GATHER = false;
    const char* A; const char* Bt; int nM, nN, nwg, G, c, wgm; size_t tstep;
    __device__ void init(const void* A_, const void* Bt_, int M, int N, int K, int G_, int c_, int wgm_ = WGM) { A = (const char*)A_; Bt = (const char*)Bt_; nM = M / BM; nN = N / BM; nwg = nM * nN; G = G_; c = c_; wgm = wgm_; tstep = (size_t)BM * K * 2; }
    __device__ bool next(int i, Unit& u) const {
        const long L = (long)i * G + c; if (L >= nwg) return false;
        int wgid = (int)L; { const int q = nwg / NXCD, r = nwg % NXCD, xcd = wgid % NXCD, off = wgid / NXCD; wgid = (xcd < r ? xcd * (q + 1) : r * (q + 1) + (xcd - r) * q) + off; }
        const int nig = wgm * nN, gid = wgid / nig, fm = gid * wgm, gsz = (nM - fm) < wgm ? (nM - fm) : wgm;
        u.pm = fm + ((wgid % nig) % gsz); u.pn = (wgid % nig) / gsz; u.A = A + (size_t)u.pm * tstep; u.B = Bt + (size_t)u.pn * tstep; u.aux = 0; return true;
    }
    __device__ __forceinline__ void gather(const Unit&, int, int, int, int, unsigned (&)[2][2]) const {}
};

template <class Epi, class Sched, bool FP8 = false, int SCA = 127, int SCB = 127>
__device__ __forceinline__ void gemm_phase(LAS unsigned char* lds, const int K, const Sched& S, const Epi& E) {
    constexpr bool GATHER = Sched::GATHER;
    int tid = threadIdx.x; asm volatile("" : "+v"(tid));
    const int wid = __builtin_amdgcn_readfirstlane(tid >> 6), lane = tid & 63, wr = wid >> 2, wc = wid & 3, fr = lane & 15, fq = lane >> 4;
    const int nt = K / BK;
    unsigned voffA[2], voffB[2]; int sR[2], sC[2];
#pragma unroll
    for (int i = 0; i < 2; ++i) { int R, C; stage_rc(tid * 16 + i * 8192, R, C); const int Rb = Epi::PERM ? ((R & ~31) + perm32(R & 31)) : R;
        sR[i] = R; sC[i] = C; voffA[i] = (unsigned)(R * K + C) * 2u; voffB[i] = (unsigned)(Rb * K + C) * 2u; }
    const size_t kstep = (size_t)(BK * 2);
    const size_t hstep = (size_t)HALF * K * 2;
    const unsigned ldsw = (unsigned)wid * 1024u;
    const int aoff = lds_byte(wr * 64 + fr, fq * 8), boff = lds_byte(wc * 32 + fr, fq * 8);
#define PG8_SA(b, h) (((b) * 2 + (h)) * HTB)
#define PG8_SB(b, h) ((4 + (b) * 2 + (h)) * HTB)
#define PG8_STAGE2(bufoff, gbase, o0, o1) do { \
        __builtin_amdgcn_global_load_lds((const unsigned*)((const char*)(gbase) + (o0)), (LAS unsigned*)(lds + (bufoff) + ldsw), 16, 0, 0); \
        __builtin_amdgcn_global_load_lds((const unsigned*)((const char*)(gbase) + (o1)), (LAS unsigned*)(lds + (bufoff) + ldsw + 8192), 16, 0, 0); } while (0)
#define PG8_STAGE_B(bufoff, gbase) PG8_STAGE2(bufoff, gbase, voffB[0], voffB[1])
#define PG8_STAGE_A(bufoff, gbase, h, VA) PG8_STAGE2(bufoff, (gbase) + (GATHER ? (size_t)0 : (size_t)(h) * hstep), VA[GATHER ? (h) : 0][0], VA[GATHER ? (h) : 0][1])
#define PG8_LDA(dst, b, h) do { _Pragma("unroll") for (int m = 0; m < 4; ++m) _Pragma("unroll") for (int k = 0; k < 2; ++k) dst[m][k] = *(const LAS bf16x8*)(lds + PG8_SA(b, h) + aoff + m * 2048 + k * 1024); } while (0)
#define PG8_LDB(dst, b, h) do { _Pragma("unroll") for (int n = 0; n < 2; ++n) _Pragma("unroll") for (int k = 0; k < 2; ++k) dst[n][k] = *(const LAS bf16x8*)(lds + PG8_SB(b, h) + boff + n * 2048 + k * 1024); } while (0)
#define PG8_MMA(ai, bj, At, Bt) do { __builtin_amdgcn_s_setprio(1); _Pragma("unroll") for (int m = 0; m < 4; ++m) _Pragma("unroll") for (int n = 0; n < 2; ++n) { \
        if constexpr (FP8) { typedef int i32x4_ __attribute__((ext_vector_type(4))); typedef int i32x8_ __attribute__((ext_vector_type(8))); \
            const i32x8_ bq = __builtin_shufflevector(__builtin_bit_cast(i32x4_, Bt[n][0]), __builtin_bit_cast(i32x4_, Bt[n][1]), 0, 1, 2, 3, 4, 5, 6, 7); \
            const i32x8_ aq = __builtin_shufflevector(__builtin_bit_cast(i32x4_, At[m][0]), __builtin_bit_cast(i32x4_, At[m][1]), 0, 1, 2, 3, 4, 5, 6, 7); \
            asm volatile("v_mfma_scale_f32_16x16x128_f8f6f4 %0, %1, %2, %0, %3, %4 op_sel_hi:[0,0,0]" : "+v"(acc[ai][bj][m][n]) : "v"(bq), "v"(aq), "v"(scb_), "v"(sca_)); } \
        else { _Pragma("unroll") for (int k = 0; k < 2; ++k) acc[ai][bj][m][n] = __builtin_amdgcn_mfma_f32_16x16x32_bf16(Bt[n][k], At[m][k], acc[ai][bj][m][n], 0, 0, 0); } } \
        __builtin_amdgcn_s_setprio(0); } while (0)
#define PG8_WAIT_V(n) asm volatile("s_waitcnt vmcnt(" #n ")" ::: "memory")
#define PG8_WAIT_L(n) asm volatile("s_waitcnt lgkmcnt(" #n ")" ::: "memory")
#define PG8_BAR __builtin_amdgcn_s_barrier()
#define PG8_SCHED __builtin_amdgcn_sched_barrier(0)
    Unit cur, nxt; int ui = 0;
    if (!S.next(0, cur)) return;
    f32x4 acc[2][2][4][2];
#pragma unroll
    for (int a = 0; a < 2; ++a)
#pragma unroll
        for (int b = 0; b < 2; ++b)
#pragma unroll
            for (int m = 0; m < 4; ++m)
#pragma unroll
                for (int n = 0; n < 2; ++n) acc[a][b][m][n] = (f32x4){0.f, 0.f, 0.f, 0.f};
    bf16x8 At[4][2], B0[2][2], B1[2][2];
    int sca_ = SCA * 0x01010101, scb_ = SCB * 0x01010101;
    unsigned vAc[2][2], vAn[2][2];
    if constexpr (GATHER) { S.gather(cur, sR[0], sR[1], sC[0], sC[1], vAc); }
    else { vAc[0][0] = voffA[0]; vAc[0][1] = voffA[1]; vAc[1][0] = voffA[0]; vAc[1][1] = voffA[1]; }
#pragma unroll
    for (int h = 0; h < 2; ++h) { vAn[h][0] = vAc[h][0]; vAn[h][1] = vAc[h][1]; }
    const char* cA = cur.A; const char* cB = cur.B;
    PG8_STAGE_B(PG8_SB(0, 0), cB); PG8_STAGE_A(PG8_SA(0, 0), cA, 0, vAc); PG8_STAGE_B(PG8_SB(0, 1), cB + hstep); PG8_STAGE_A(PG8_SA(0, 1), cA, 1, vAc);
    if (wr == 1) PG8_BAR;
    PG8_WAIT_V(4); PG8_BAR;
    PG8_STAGE_B(PG8_SB(1, 0), cB + kstep); PG8_STAGE_A(PG8_SA(1, 0), cA + kstep, 0, vAc); PG8_STAGE_B(PG8_SB(1, 1), cB + hstep + kstep);
    PG8_WAIT_V(6); PG8_BAR;
    for (;;) {
        const bool has_next = S.next(ui + 1, nxt);
        const char* nA = has_next ? nxt.A : cA; const char* nB = has_next ? nxt.B : cB;
        if constexpr (GATHER) { if (has_next) S.gather(nxt, sR[0], sR[1], sC[0], sC[1], vAn); }
        for (int t = 0; t < nt; t += 2) {
            const bool last = (t == nt - 2);
            const char* a1 = cA + (size_t)(t + 1) * kstep;
            const char* a2 = last ? nA : cA + (size_t)(t + 2) * kstep; const char* b2 = last ? nB : cB + (size_t)(t + 2) * kstep;
            const char* a3 = a2 + kstep; const char* b3 = b2 + kstep;
            unsigned vA2[2][2];
#pragma unroll
            for (int h = 0; h < 2; ++h) { vA2[h][0] = (GATHER && last) ? vAn[h][0] : vAc[h][0]; vA2[h][1] = (GATHER && last) ? vAn[h][1] : vAc[h][1]; }
            PG8_LDB(B0, 0, 0); PG8_SCHED; PG8_LDA(At, 0, 0); PG8_STAGE_A(PG8_SA(1, 1), a1, 1, vAc);
            PG8_WAIT_L(8); PG8_BAR; PG8_WAIT_L(0); PG8_MMA(0, 0, At, B0); PG8_BAR; PG8_SCHED;
            PG8_LDB(B1, 0, 1); PG8_STAGE_B(PG8_SB(0, 0), b2);
            PG8_BAR; PG8_WAIT_L(0); PG8_MMA(0, 1, At, B1); PG8_BAR;
            PG8_LDA(At, 0, 1); PG8_STAGE_A(PG8_SA(0, 0), a2, 0, vA2);
            PG8_BAR; PG8_WAIT_L(0); PG8_MMA(1, 0, At, B0); PG8_BAR; PG8_SCHED;
            PG8_STAGE_B(PG8_SB(0, 1), b2 + hstep);
            PG8_WAIT_V(6); PG8_BAR; PG8_MMA(1, 1, At, B1); PG8_BAR;
            PG8_LDB(B0, 1, 0); PG8_SCHED; PG8_LDA(At, 1, 0); PG8_STAGE_A(PG8_SA(0, 1), a2, 1, vA2);
            PG8_WAIT_L(8); PG8_BAR; PG8_WAIT_L(0); PG8_MMA(0, 0, At, B0); PG8_BAR; PG8_SCHED;
            PG8_LDB(B1, 1, 1); PG8_STAGE_B(PG8_SB(1, 0), b3);
            PG8_BAR; PG8_WAIT_L(0); PG8_MMA(0, 1, At, B1); PG8_BAR;
            PG8_LDA(At, 1, 1); PG8_STAGE_A(PG8_SA(1, 0), a3, 0, vA2);
            PG8_BAR; PG8_WAIT_L(0); PG8_MMA(1, 0, At, B0); PG8_BAR; PG8_SCHED;
            PG8_STAGE_B(PG8_SB(1, 1), b3 + hstep);
            PG8_WAIT_V(6); PG8_BAR; PG8_MMA(1, 1, At, B1); PG8_BAR;
        }
        if constexpr (FP8) asm volatile("s_nop 15\n\ts_nop 15" ::: "memory");
        E(acc, cur, wr, wc, fr, fq);
        if (!has_next) break;
#pragma unroll
        for (int a = 0; a < 2; ++a)
#pragma unroll
            for (int b = 0; b < 2; ++b)
#pragma unroll
                for (int m = 0; m < 4; ++m)
#pragma unroll
                    for (int n = 0; n < 2; ++n) acc[a][b][m][n] = (f32x4){0.f, 0.f, 0.f, 0.f};
        cur = nxt; cA = nA; cB = nB; ++ui;
        if constexpr (GATHER) {
#pragma unroll
            for (int h = 0; h < 2; ++h) { vAc[h][0] = vAn[h][0]; vAc[h][1] = vAn[h][1]; }
        }
    }
    PG8_WAIT_V(0);
    if (wr == 0) PG8_BAR;
    PG8_BAR;
#undef PG8_SA
#undef PG8_SB
#undef PG8_STAGE2
#undef PG8_STAGE_A
#undef PG8_STAGE_B
#undef PG8_LDA
#undef PG8_LDB
#undef PG8_MMA
#undef PG8_WAIT_V
#undef PG8_WAIT_L
#undef PG8_BAR
#undef PG8_SCHED
}
}


#define XB_TMO      128
#define XB_XCNT(j)  (256  + 64 * (j))
#define XB_XSUB(j)  (1280 + 64 * (j))
#define XB_XGEN(j)  (2304 + 64 * (j))
#define XB_TOP      3328
#define XB_TOPGEN   3392
#define XCD_BAR_WORDS 3456
#define XB_SPIN_CAP (1u << 20)
constexpr int CW_BAR = 4096;
constexpr int LDS_MISC_OFF = 147456 - 64;
__device__ __forceinline__ unsigned xb_ld(unsigned* p)              { return __hip_atomic_load(p, __ATOMIC_RELAXED, __HIP_MEMORY_SCOPE_AGENT); }
__device__ __forceinline__ unsigned xb_add(unsigned* p, unsigned v) { return __hip_atomic_fetch_add(p, v, __ATOMIC_RELAXED, __HIP_MEMORY_SCOPE_AGENT); }
__device__ __forceinline__ unsigned xb_xcc_id() { return (unsigned)__builtin_amdgcn_s_getreg((3 << 11) | 20) & 0xFu; }
#define XB_SPIN(cond, bar) do { unsigned _sp = 0; while (cond) { __builtin_amdgcn_s_sleep(1); \
    if ((++_sp & 255u) == 0u) { if (xb_ld(&(bar)[XB_TMO])) break; if (_sp > XB_SPIN_CAP) { atomicAdd(&(bar)[XB_TMO], 1u); break; } } } } while (0)
struct XcdBarrier { unsigned* bar; unsigned x; volatile LAS unsigned* st; };
__device__ __forceinline__ XcdBarrier xcd_barrier_post(unsigned* bar, volatile LAS unsigned* st) {
    XcdBarrier b; b.bar = bar; b.x = xb_xcc_id(); b.st = st;
    if (threadIdx.x == 0) (void)xb_add(&bar[XB_XCNT(b.x)], 1u);
    return b;
}
__device__ __forceinline__ void xcd_barrier_complete(unsigned* bar, unsigned x, unsigned& nloc, unsigned& nx) {
    const unsigned G = gridDim.x * gridDim.y * gridDim.z;
    unsigned sum, cnt, mine, sp = 0u;
    for (;;) {
        sum = 0u; cnt = 0u; mine = 0u;
#pragma unroll
        for (unsigned j = 0; j < 16; ++j) { const unsigned c = xb_ld(&bar[XB_XCNT(j)]); sum += c; cnt += (c > 0u) ? 1u : 0u; mine = (j == x) ? c : mine; }
        if (sum == G) break;
        __builtin_amdgcn_s_sleep(1);
        if ((++sp & 255u) == 0u) { if (xb_ld(&bar[XB_TMO])) break; if (sp > XB_SPIN_CAP) { atomicAdd(&bar[XB_TMO], 1u); break; } }
    }
    nloc = mine > 0u ? mine : 1u; nx = cnt > 0u ? cnt : 1u;
}
__device__ __forceinline__ void xcd_barrier(const XcdBarrier& b) {
    asm volatile("s_waitcnt vmcnt(0)" ::: "memory");
    __syncthreads();
    if (threadIdx.x == 0) {
        unsigned* bar = b.bar;
        __builtin_amdgcn_s_waitcnt(0);
        unsigned nloc = b.st[0], nx = b.st[1];
        if (nloc == 0u) { xcd_barrier_complete(bar, b.x, nloc, nx); b.st[0] = nloc; b.st[1] = nx; }
        const unsigned old = xb_add(&bar[XB_XSUB(b.x)], 1u);
        const unsigned gen = old / nloc;
        if (old + 1u == (gen + 1u) * nloc) {
            __builtin_amdgcn_fence(__ATOMIC_RELEASE, "agent");
            asm volatile("s_waitcnt vmcnt(0)" ::: "memory");
            const unsigned og = xb_add(&bar[XB_TOP], 1u);
            const unsigned tg = og / nx;
            if (og + 1u == (tg + 1u) * nx) xb_add(&bar[XB_TOPGEN], 1u);
            else XB_SPIN(xb_ld(&bar[XB_TOPGEN]) == tg, bar);
            __builtin_amdgcn_fence(__ATOMIC_ACQUIRE, "agent");
            xb_add(&bar[XB_XGEN(b.x)], 1u);
            asm volatile("s_waitcnt vmcnt(0)" ::: "memory");
        } else {
            XB_SPIN(xb_ld(&bar[XB_XGEN(b.x)]) == gen, bar);
            __builtin_amdgcn_fence(__ATOMIC_ACQUIRE, "agent");
            asm volatile("s_waitcnt vmcnt(0)" ::: "memory");
        }
    }
    __syncthreads();
}

struct Params {
    const float* in[23];
    float* out; unsigned char* ws;
};
struct Frame {
    LAS unsigned char* lds; int tid, lane, wave, vcu, G;
    const Params* p; unsigned char* ws;
};
#define IN_X 0
#define IN_MEM 1
#define IN_NORM_MIX 2
#define IN_W_IN 3
#define IN_AQN 4
#define IN_AKN 5
#define IN_DECF 6
#define IN_DECB 7
#define IN_GNW 8
#define IN_W_OUT 9
#define IN_NORM_MEM 10
#define IN_NORM_MEMKV 11
#define IN_W_MQ 12
#define IN_W_MKV 13
#define IN_MQN 14
#define IN_MKN 15
#define IN_W_MO 16
#define IN_NORM_MOE 17
#define IN_W_GROUP 18
#define IN_W_ROUTER 19
#define IN_W1 20
#define IN_W3 21
#define IN_W2 22

template <class RowMap>
__device__ __forceinline__ void p0_transpose_item(const float* W, int K, int N, bf16_t* WT, const RowMap& rm, const float* kscale, LAS float* scr, int item, int lane) {
    const int nblk = N / 64, kb = item / nblk, nb = item % nblk, k0 = 64 * kb, n0 = 64 * nb;
    const int lr = lane >> 4, lc = (lane & 15) * 4;
    f32x4 v[16];
#pragma unroll
    for (int i = 0; i < 16; ++i) v[i] = *(const f32x4*)(W + (size_t)(k0 + 4 * i + lr) * N + n0 + lc);
#pragma unroll
    for (int i = 0; i < 16; ++i) { const int kk = 4 * i + lr; f32x4 t = v[i]; if (kscale) t = t * kscale[k0 + kk];
        LAS float* d = scr + kk * 65 + lc; d[0] = t.x; d[1] = t.y; d[2] = t.z; d[3] = t.w; }
    LDS_WAIT(); asm volatile("" ::: "memory");
    const int c = lane & 7;
#pragma unroll
    for (int j = 0; j < 8; ++j) { const int n = (lane >> 3) + 8 * j; const LAS float* s = scr + (8 * c) * 65 + n;
        u32x4 o; o.x = cvt_pk_bf16(s[0 * 65], s[1 * 65]); o.y = cvt_pk_bf16(s[2 * 65], s[3 * 65]); o.z = cvt_pk_bf16(s[4 * 65], s[5 * 65]); o.w = cvt_pk_bf16(s[6 * 65], s[7 * 65]);
        *(u32x4*)(WT + (size_t)rm(n0 + n) * K + k0 + 8 * c) = o; }
    LDS_WAIT(); asm volatile("" ::: "memory");
}
template <class RowMap>
__device__ __forceinline__ void p0_transpose_item_fp8(const float* W, int K, int N, unsigned char* WT, const RowMap& rm, const float* kscale, float mul, LAS float* scr, int item, int lane) {
    const int nblk = N / 64, kb = item / nblk, nb = item % nblk, k0 = 64 * kb, n0 = 64 * nb;
    const int lr = lane >> 4, lc = (lane & 15) * 4;
    f32x4 v[16];
#pragma unroll
    for (int i = 0; i < 16; ++i) v[i] = *(const f32x4*)(W + (size_t)(k0 + 4 * i + lr) * N + n0 + lc);
#pragma unroll
    for (int i = 0; i < 16; ++i) { const int kk = 4 * i + lr; const f32x4 t = v[i] * (kscale ? kscale[k0 + kk] * mul : mul);
        LAS float* d = scr + kk * 65 + lc; d[0] = t.x; d[1] = t.y; d[2] = t.z; d[3] = t.w; }
    LDS_WAIT(); asm volatile("" ::: "memory");
    const int c = lane & 7;
#pragma unroll
    for (int j = 0; j < 8; ++j) { const int n = (lane >> 3) + 8 * j; const LAS float* s = scr + (8 * c) * 65 + n;
        int w0 = 0, w1 = 0;
        w0 = __builtin_amdgcn_cvt_pk_fp8_f32(s[0 * 65], s[1 * 65], w0, false); w0 = __builtin_amdgcn_cvt_pk_fp8_f32(s[2 * 65], s[3 * 65], w0, true);
        w1 = __builtin_amdgcn_cvt_pk_fp8_f32(s[4 * 65], s[5 * 65], w1, false); w1 = __builtin_amdgcn_cvt_pk_fp8_f32(s[6 * 65], s[7 * 65], w1, true);
        *(u32x2*)(WT + (size_t)rm(n0 + n) * K + k0 + 8 * c) = (u32x2){(unsigned)w0, (unsigned)w1}; }
    LDS_WAIT(); asm volatile("" ::: "memory");
}
struct RmId { __device__ __forceinline__ int operator()(int n) const { return n; } };
struct RmOff { int off; __device__ __forceinline__ int operator()(int n) const { return n + off; } };
struct RmIn { __device__ __forceinline__ int operator()(int n) const {
        if (n >= 1024) return n;
        const int seg = n >> 9, head = (n & 511) >> 6, dim = n & 63;
        return 256 * (seg * 2 + (head >> 2)) + 128 * (dim >> 5) + 32 * (head & 3) + (dim & 31); } };
struct RmGU { int up; __device__ __forceinline__ int operator()(int f) const { return 256 * (f >> 7) + 128 * up + (f & 127); } };

__device__ __forceinline__ void rms_row_to_bf16(const float* xrow, const float* w, bf16_t* orow, int lane, float* rstd_out = nullptr) {
    const f32x4* xr = (const f32x4*)xrow + lane; const f32x4* wr = (const f32x4*)w + lane;
    f32x4 v[4]; float s = 0.f;
#pragma unroll
    for (int j = 0; j < 4; ++j) { v[j] = xr[64 * j]; s += (v[j].x * v[j].x + v[j].y * v[j].y) + (v[j].z * v[j].z + v[j].w * v[j].w); }
    const float rstd = 1.0f / sqrtf(wave_sum(s) * (1.f / 1024.f) + 1e-6f);
    if (rstd_out && lane == 0) *rstd_out = rstd;
    u32x2* o8 = (u32x2*)orow + lane;
#pragma unroll
    for (int j = 0; j < 4; ++j) { const f32x4 ww = wr[64 * j]; u32x2 o; o.x = cvt_pk_bf16(v[j].x * rstd * ww.x, v[j].y * rstd * ww.y); o.y = cvt_pk_bf16(v[j].z * rstd * ww.z, v[j].w * rstd * ww.w); o8[64 * j] = o; }
}

template <int PART>
__device__ __forceinline__ void p0_prologue(Frame& F) {
    const Params& P = *F.p;
    LAS float* scr = (LAS float*)(F.lds + F.wave * 16640);
    const int gw = F.vcu * NWAVES + F.wave, NGW = F.G * NWAVES;
    constexpr int I_IN = 16 * 48, I_SQ = 16 * 16, I_MKV = 16 * 32, I_E1 = 16 * 8, I_E2 = 8 * 16;
    constexpr int NDENSE = I_IN, NITEMS = I_IN + 3 * I_SQ + I_MKV + NEXP * (2 * I_E1 + I_E2);
    unsigned char* ws = F.ws;
    for (int it = (PART ? NDENSE : 0) + gw; it < (PART ? NITEMS : NDENSE); it += NGW) {
        int r = it;
        if (r < I_IN) { p0_transpose_item(P.in[IN_W_IN], 1024, 3072, (bf16_t*)(ws + WS_WIN), RmIn{}, nullptr, scr, r, F.lane); continue; } r -= I_IN;
        if (r < I_SQ) { p0_transpose_item(P.in[IN_W_OUT], 1024, 1024, (bf16_t*)(ws + WS_WOUT), RmId{}, nullptr, scr, r, F.lane); continue; } r -= I_SQ;
        if (r < I_SQ) { p0_transpose_item(P.in[IN_W_MQ], 1024, 1024, (bf16_t*)(ws + WS_WMQ), RmId{}, P.in[IN_NORM_MEM], scr, r, F.lane); continue; } r -= I_SQ;
        if (r < I_SQ) { p0_transpose_item(P.in[IN_W_MO], 1024, 1024, (bf16_t*)(ws + WS_WMO), RmId{}, nullptr, scr, r, F.lane); continue; } r -= I_SQ;
        if (r < I_MKV) { p0_transpose_item(P.in[IN_W_MKV], 1024, 2048, (bf16_t*)(ws + WS_WMKV), RmId{}, nullptr, scr, r, F.lane); continue; } r -= I_MKV;
        const int e = r / (2 * I_E1 + I_E2); r -= e * (2 * I_E1 + I_E2);
        if (r < I_E1) { p0_transpose_item_fp8(P.in[IN_W1] + (size_t)e * 1024 * 512, 1024, 512, (unsigned char*)(ws + WS_W13) + (size_t)e * 1024 * 1024, RmGU{0}, P.in[IN_NORM_MOE], 32.f, scr, r, F.lane); continue; } r -= I_E1;
        if (r < I_E1) { p0_transpose_item_fp8(P.in[IN_W3] + (size_t)e * 1024 * 512, 1024, 512, (unsigned char*)(ws + WS_W13) + (size_t)e * 1024 * 1024, RmGU{1}, P.in[IN_NORM_MOE], 32.f, scr, r, F.lane); continue; } r -= I_E1;
        p0_transpose_item_fp8(P.in[IN_W2] + (size_t)e * 512 * 1024, 512, 1024, (unsigned char*)(ws + WS_W2) + (size_t)e * 1024 * 512, RmId{}, nullptr, 16.f, scr, r, F.lane);
    }
    if (PART) return;
    for (int i = blockIdx.x * NTHR + F.tid; i < (int)((WS_HSQ + (size_t)NT * 16 - WS_SUMSQ1) / 16); i += F.G * NTHR) ((u32x4*)(ws + WS_SUMSQ1))[i] = (u32x4){0u, 0u, 0u, 0u};
    for (int i = blockIdx.x * NTHR + F.tid; i < 48 * 1024; i += F.G * NTHR) { const int c = i >> 10, k = i & 1023; float v = 0.f;
        if (c < 4) v = P.in[IN_W_GROUP][(size_t)k * 4 + c]; else if (c < 36) v = P.in[IN_W_ROUTER][((size_t)((c - 4) >> 3) * 1024 + k) * 8 + ((c - 4) & 7)];
        v *= P.in[IN_NORM_MOE][k];
        const unsigned hi = cvt_pk_bf16(v, 0.f) & 0xffffu; const float rem = v - __uint_as_float(hi << 16);
        ((bf16_t*)(ws + WS_WRT))[i] = (bf16_t)hi; ((bf16_t*)(ws + WS_WRT))[48 * 1024 + i] = (bf16_t)(cvt_pk_bf16(rem, 0.f) & 0xffffu); }
    for (int m = gw; m < NT; m += NGW) rms_row_to_bf16(P.in[IN_X] + (size_t)m * DM, P.in[IN_NORM_MIX], (bf16_t*)P.out + (size_t)m * DM, F.lane, (float*)(ws + WS_RSTD0) + m);
    for (int m = gw; m < NB * NMEM; m += NGW) rms_row_to_bf16(P.in[IN_MEM] + (size_t)m * DM, P.in[IN_NORM_MEMKV], (bf16_t*)(ws + WS_MEMH) + (size_t)m * DM, F.lane);
}

struct EpiInProj {
    static constexpr bool PERM = true;
    unsigned char* ws; const float* qnw; const float* knw;
    __device__ __forceinline__ void operator()(const f32x4 (&acc)[2][2][4][2], const pg8::Unit& u, int wr, int wc, int fr, int fq) const {
        const int pn = u.pn; const int row0 = u.pm * 256 + wr * 64 + fr;
        if (pn < 4) {
            const float* nw = pn < 2 ? qnw : knw; const float sc = pn < 2 ? 0.125f * 1.44269504089f : 1.0f;
            bf16_t* dst = (bf16_t*)(ws + (pn < 2 ? WS_AQ : WS_AK)); const int head = 4 * (pn & 1) + wc;
            f32x4 w4[2][2];
#pragma unroll
            for (int bj = 0; bj < 2; ++bj)
#pragma unroll
                for (int n = 0; n < 2; ++n) w4[bj][n] = *(const f32x4*)(nw + 32 * bj + 8 * fq + 4 * n);
#pragma unroll
            for (int ai = 0; ai < 2; ++ai)
#pragma unroll
                for (int m = 0; m < 4; ++m) {
                    float ss = 0.f;
#pragma unroll
                    for (int bj = 0; bj < 2; ++bj)
#pragma unroll
                        for (int n = 0; n < 2; ++n) { const f32x4 v = acc[ai][bj][m][n]; ss += (v.x * v.x + v.y * v.y) + (v.z * v.z + v.w * v.w); }
                    ss = sum_g4(ss);
                    const float rs = sc / sqrtf(ss * (1.f / 64.f) + 1e-6f);
                    bf16_t* rowp = dst + (size_t)(row0 + ai * 128 + m * 16) * 512 + head * 64 + 8 * fq;
#pragma unroll
                    for (int bj = 0; bj < 2; ++bj) { const f32x4 v0 = acc[ai][bj][m][0] * rs * w4[bj][0], v1 = acc[ai][bj][m][1] * rs * w4[bj][1];
                        u32x4 w; w.x = cvt_pk_bf16(v0.x, v0.y); w.y = cvt_pk_bf16(v0.z, v0.w); w.z = cvt_pk_bf16(v1.x, v1.y); w.w = cvt_pk_bf16(v1.z, v1.w);
                        *(u32x4*)(rowp + 32 * bj) = w; }
                }
        } else {
            bf16_t* dst; int ld, c0; float sc = 1.f; bool act = false;
            if (pn < 6) { dst = (bf16_t*)(ws + WS_AV); ld = 512; c0 = (pn - 4) * 256; }
            else if (pn == 6) { dst = (bf16_t*)(ws + WS_RQ); ld = 256; c0 = 0; }
            else if (pn == 7) { dst = (bf16_t*)(ws + WS_RK); ld = 256; c0 = 0; sc = 0.125f; }
            else if (pn < 10) { dst = (bf16_t*)(ws + WS_RV); ld = 512; c0 = (pn - 8) * 256; }
            else { dst = (bf16_t*)(ws + WS_RG); ld = 512; c0 = (pn - 10) * 256; act = true; }
#pragma unroll
            for (int ai = 0; ai < 2; ++ai)
#pragma unroll
                for (int m = 0; m < 4; ++m) {
                    bf16_t* rowp = dst + (size_t)(row0 + ai * 128 + m * 16) * ld + c0 + wc * 32 + 8 * fq;
#pragma unroll
                    for (int bj = 0; bj < 2; ++bj) { f32x4 v0 = acc[ai][bj][m][0] * sc, v1 = acc[ai][bj][m][1] * sc;
                        if (act) { v0.x = silu_f(v0.x); v0.y = silu_f(v0.y); v0.z = silu_f(v0.z); v0.w = silu_f(v0.w); v1.x = silu_f(v1.x); v1.y = silu_f(v1.y); v1.z = silu_f(v1.z); v1.w = silu_f(v1.w); }
                        u32x4 w; w.x = cvt_pk_bf16(v0.x, v0.y); w.y = cvt_pk_bf16(v0.z, v0.w); w.z = cvt_pk_bf16(v1.x, v1.y); w.w = cvt_pk_bf16(v1.z, v1.w);
                        *(u32x4*)(rowp + 128 * bj) = w; }
                }
        }
    }
};


__device__ __forceinline__ void tr_read8(unsigned addr, bf16x4 (&r)[8]) {
    asm volatile("ds_read_b64_tr_b16 %0, %8\n\tds_read_b64_tr_b16 %1, %8 offset:32\n\tds_read_b64_tr_b16 %2, %8 offset:64\n\tds_read_b64_tr_b16 %3, %8 offset:96\n\t"
                 "ds_read_b64_tr_b16 %4, %8 offset:2048\n\tds_read_b64_tr_b16 %5, %8 offset:2080\n\tds_read_b64_tr_b16 %6, %8 offset:2112\n\tds_read_b64_tr_b16 %7, %8 offset:2144\n\t"
                 "s_waitcnt lgkmcnt(0)"
                 : "=&v"(r[0]), "=&v"(r[1]), "=&v"(r[2]), "=&v"(r[3]), "=&v"(r[4]), "=&v"(r[5]), "=&v"(r[6]), "=&v"(r[7]) : "v"(addr) : "memory");
}
__device__ __forceinline__ void tr_read8_issue(unsigned addr, bf16x4 (&r)[8]) {
    asm volatile("ds_read_b64_tr_b16 %0, %8\n\tds_read_b64_tr_b16 %1, %8 offset:32\n\tds_read_b64_tr_b16 %2, %8 offset:64\n\tds_read_b64_tr_b16 %3, %8 offset:96\n\t"
                 "ds_read_b64_tr_b16 %4, %8 offset:2048\n\tds_read_b64_tr_b16 %5, %8 offset:2080\n\tds_read_b64_tr_b16 %6, %8 offset:2112\n\tds_read_b64_tr_b16 %7, %8 offset:2144"
                 : "=&v"(r[0]), "=&v"(r[1]), "=&v"(r[2]), "=&v"(r[3]), "=&v"(r[4]), "=&v"(r[5]), "=&v"(r[6]), "=&v"(r[7]) : "v"(addr) : "memory");
}
__device__ __forceinline__ void tr_read8_wait(bf16x4 (&r)[8]) {
    asm volatile("s_waitcnt lgkmcnt(0)" : "+v"(r[0]), "+v"(r[1]), "+v"(r[2]), "+v"(r[3]), "+v"(r[4]), "+v"(r[5]), "+v"(r[6]), "+v"(r[7]) :: "memory");
}
__device__ __forceinline__ bf16x8 cat4(bf16x4 a, bf16x4 b) { return __builtin_shufflevector(a, b, 0, 1, 2, 3, 4, 5, 6, 7); }
constexpr int ACC_LD = 136;
constexpr int ATT_TOK = 512;
constexpr int ATT_ACC_BYTES = ATT_TOK * ACC_LD;
constexpr int ATT_VBUF_OFF = ATT_ACC_BYTES;

struct AttRing { bf16x8 kf[2][2][2]; u32x4 vst[2][4]; bf16x8 qn[2][2]; };
struct AttItem { const bf16_t* Qb; int d, r, jq0, L; };
constexpr size_t ATT_K_OFF = (WS_AK - WS_AQ) / 2, ATT_V_OFF = (WS_AV - WS_AQ) / 2;
template <int B>
__device__ __forceinline__ void att_ring_load(AttRing& R, const AttItem& it, int P, int lane) {
    asm volatile("" : "+v"(lane));
    const int g = lane >> 4, li = lane & 15, sc = lane & 7, sr = lane >> 3;
    const bf16_t* Kb = it.Qb + ATT_K_OFF; const bf16_t* Vb = it.Qb + ATT_V_OFF; const int jb = it.jq0 - 64 + 32 * P;
#pragma unroll
    for (int t = 0; t < 2; ++t) { int jk = jb + 16 * t + li; jk = jk < 0 ? 0 : (jk >= it.L ? it.L - 1 : jk); const bf16_t* kp = Kb + (size_t)(it.r + it.d * jk) * 512 + 8 * g;
        R.kf[B][t][0] = *(const bf16x8*)kp; R.kf[B][t][1] = *(const bf16x8*)(kp + 32); }
#pragma unroll
    for (int i = 0; i < 4; ++i) { int jk = jb + sr + 8 * i; jk = jk < 0 ? 0 : (jk >= it.L ? it.L - 1 : jk); R.vst[B][i] = *(const u32x4*)(Vb + (size_t)(it.r + it.d * jk) * 512 + 8 * sc); }
}
template <int NQ>
__device__ __forceinline__ void att_q_load(AttRing& R, const AttItem& it, int lane) {
    asm volatile("" : "+v"(lane));
    const int g = lane >> 4, li = lane & 15;
#pragma unroll
    for (int q = 0; q < NQ; ++q)
#pragma unroll
        for (int ks = 0; ks < 2; ++ks) R.qn[q][ks] = *(const bf16x8*)(it.Qb + (size_t)(it.r + it.d * (it.jq0 + 16 * q + li)) * 512 + 32 * ks + 8 * g);
}
template <int NQ, bool EDGE, int mode, int PAR, int NQN>
__device__ __forceinline__ void attn_item_r(AttRing& R, const AttItem& it, const AttItem& nx, float slope2  , unsigned m2w  ,
                                            LAS float* ACC, int T0, LAS unsigned char* vbuf  , bf16_t* mixrow0  , int lane) {
    asm volatile("" : "+v"(lane));
    const int g = lane >> 4, li = lane & 15;
    const int jq0 = it.jq0, L = it.L;
    const unsigned s2b = cvt_pk_bf16(slope2, 0.f) & 0xffffu;
    const float s2r = __builtin_bit_cast(float, s2b << 16);
    const unsigned gm = g == 0 ? 0xffffffffu : 0u;
    int tq[NQ]; bf16x8 qf[NQ][2], qa[NQ]; f32x4 o[NQ][4], ol[NQ];
#pragma unroll
    for (int q = 0; q < NQ; ++q) { tq[q] = it.r + it.d * (jq0 + 16 * q + li); qf[q][0] = R.qn[q][0]; qf[q][1] = R.qn[q][1];
        u32x4 a; a.x = ((__builtin_bit_cast(unsigned, (float)(16 * q + li)) >> 16) | (s2b << 16)) & gm; a.y = 0x3F80u & gm; a.z = 0u; a.w = 0u; qa[q] = __builtin_bit_cast(bf16x8, a);
#pragma unroll
        for (int dt = 0; dt < 4; ++dt) o[q][dt] = (f32x4){0.f, 0.f, 0.f, 0.f};
        ol[q] = (f32x4){0.f, 0.f, 0.f, 0.f}; }
    float kbase = (float)(li - 64), delta0 = (float)(4 * g - li); asm volatile("" : "+v"(kbase), "+v"(delta0));
    const unsigned kw0 = (s2b | 0x8000u) & gm, kmask = 0xffff0000u & gm, kflip = 0x80008000u & gm, kw1 = m2w & gm;
    u32x4 onesw; onesw.x = 0x3F803F80u; onesw.y = 0x3F803F80u; onesw.z = 0x3F803F80u; onesw.w = 0x3F803F80u; const bf16x8 ones = __builtin_bit_cast(bf16x8, onesw);
    const unsigned vaddr = (unsigned)(size_t)vbuf + (unsigned)((4 * g + (li >> 2)) * 128 + (li & 3) * 8);
    const int sc = lane & 7, sr = lane >> 3;
#pragma unroll
    for (int P = 0; P < 5; ++P) {
        const int B = (P + PAR) & 1; const int jb = jq0 - 64 + 32 * P;
        if (P < 4) { if (B) att_ring_load<0>(R, it, P + 1, lane); else att_ring_load<1>(R, it, P + 1, lane); }
        else if (NQN) { if (B) att_ring_load<0>(R, nx, 0, lane); else att_ring_load<1>(R, nx, 0, lane); att_q_load<NQN ? NQN : 1>(R, nx, lane); }
        bf16x4 vr[8]; tr_read8_issue(vaddr + B * 4096, vr);
        bf16x8 pb[NQ];
#pragma unroll
        for (int q = 0; q < NQ; ++q) {
            float p[8];
#pragma unroll
            for (int t = 0; t < 2; ++t) {
                const int c = 2 * P + t - q;
                if (c < 0 || c > 8) {
#pragma unroll
                    for (int e = 0; e < 4; ++e) p[t * 4 + e] = 0.f;
                } else {
                    u32x4 kw; kw.x = (__builtin_bit_cast(unsigned, kbase + (float)(32 * P + 16 * t)) & kmask) | kw0; if (c >= 5) kw.x ^= kflip;
                    kw.y = kw1; kw.z = 0u; kw.w = 0u;
                    f32x4 st = __builtin_amdgcn_mfma_f32_16x16x32_bf16(R.kf[B][t][0], qf[q][0], (f32x4){0.f, 0.f, 0.f, 0.f}, 0, 0, 0);
                    st = __builtin_amdgcn_mfma_f32_16x16x32_bf16(R.kf[B][t][1], qf[q][1], st, 0, 0, 0);
                    st = __builtin_amdgcn_mfma_f32_16x16x32_bf16(__builtin_bit_cast(bf16x8, kw), qa[q], st, 0, 0, 0);
#pragma unroll
                    for (int e = 0; e < 4; ++e) { float x = st[e];
                        if (c == 4) x = __builtin_fmaf(__builtin_fmaxf(delta0 + (float)e, 0.f), -2.f * s2r, x);
                        float v = __builtin_amdgcn_exp2f(x);
                        if (c == 0) v = (delta0 + (float)e < 0.f) ? 0.f : v;
                        if (c == 8) v = (delta0 + (float)e > 0.f) ? 0.f : v;
                        if (EDGE) { const int jk = jb + 16 * t + 4 * g + e; v = ((unsigned)jk < (unsigned)L) ? v : 0.f; }
                        p[t * 4 + e] = v; }
                }
            }
            u32x4 pw; pw.x = cvt_pk_bf16(p[0], p[1]); pw.y = cvt_pk_bf16(p[2], p[3]); pw.z = cvt_pk_bf16(p[4], p[5]); pw.w = cvt_pk_bf16(p[6], p[7]);
            pb[q] = __builtin_bit_cast(bf16x8, pw);
        }
        tr_read8_wait(vr);
        __builtin_amdgcn_sched_barrier(0);
#pragma unroll
        for (int dt = 0; dt < 4; ++dt) { const bf16x8 vf = cat4(vr[dt], vr[4 + dt]);
#pragma unroll
            for (int q = 0; q < NQ; ++q) o[q][dt] = __builtin_amdgcn_mfma_f32_16x16x32_bf16(vf, pb[q], o[q][dt], 0, 0, 0); }
#pragma unroll
        for (int q = 0; q < NQ; ++q) ol[q] = __builtin_amdgcn_mfma_f32_16x16x32_bf16(ones, pb[q], ol[q], 0, 0, 0);
        if (P < 4 || NQN) {
#pragma unroll
            for (int i = 0; i < 4; ++i) *(LAS u32x4*)(vbuf + (B ^ 1) * 4096 + (sr + 8 * i) * 128 + sc * 16) = R.vst[B ^ 1][i]; }
    }
#pragma unroll
    for (int q = 0; q < NQ; ++q) {
        const float ls = ol[q][0];
        LAS unsigned char* arow = (LAS unsigned char*)ACC + (tq[q] - T0) * ACC_LD;
        if (mode == 0) {
#pragma unroll
            for (int dt = 0; dt < 4; ++dt) { u32x2 w; w.x = cvt_pk_bf16_c(o[q][dt].x, o[q][dt].y); w.y = cvt_pk_bf16_c(o[q][dt].z, o[q][dt].w); *(LAS u32x2*)(arow + 32 * dt + 8 * g) = w; }
            if (g == 0) *(LAS float*)(arow + 128) = ls;
        } else if (mode == 1) {
#pragma unroll
            for (int dt = 0; dt < 4; ++dt) { const u32x2 a = *(LAS u32x2*)(arow + 32 * dt + 8 * g);
                u32x2 w; w.x = cvt_pk_bf16_c(bflo(a.x) + o[q][dt].x, bfhi(a.x) + o[q][dt].y); w.y = cvt_pk_bf16_c(bflo(a.y) + o[q][dt].z, bfhi(a.y) + o[q][dt].w); *(LAS u32x2*)(arow + 32 * dt + 8 * g) = w; }
            if (g == 0) *(LAS float*)(arow + 128) += ls;
        } else {
            const float inv = 1.0f / (*(LAS float*)(arow + 128) + ls);
            bf16_t* orow = mixrow0 + (size_t)tq[q] * 1024;
#pragma unroll
            for (int dt = 0; dt < 4; ++dt) { const u32x2 a = *(LAS u32x2*)(arow + 32 * dt + 8 * g);
                u32x2 w; w.x = cvt_pk_bf16_c((bflo(a.x) + o[q][dt].x) * inv, (bfhi(a.x) + o[q][dt].y) * inv); w.y = cvt_pk_bf16_c((bflo(a.y) + o[q][dt].z) * inv, (bfhi(a.y) + o[q][dt].w) * inv);
                *(u32x2*)(orow + 16 * dt + 4 * g) = w; }
        }
    }
}
template <int NQ, int mode, int PAR, int NQN>
__device__ __forceinline__ void attn_item_d(AttRing& R, const AttItem& it, const AttItem& nx, float slope2, unsigned M2, LAS float* ACC, int T0, LAS unsigned char* vbuf, bf16_t* mixrow0, int lane) {
    if (it.jq0 - 64 < 0 || it.jq0 + 96 > it.L) attn_item_r<NQ, true, mode, PAR, NQN>(R, it, nx, slope2, M2, ACC, T0, vbuf, mixrow0, lane);
    else attn_item_r<NQ, false, mode, PAR, NQN>(R, it, nx, slope2, M2, ACC, T0, vbuf, mixrow0, lane);
}

template <int VAR>
__device__ __forceinline__ void p2_attention(Frame& F, bf16_t* mixbase) {
    const Params& P = *F.p; const int lane = F.lane, w = F.wave;
    LAS float* ACC = (LAS float*)F.lds; LAS unsigned char* vbuf = F.lds + ATT_VBUF_OFF + w * 8192;
    float mq = fabsf(P.in[IN_AQN][lane]), mk = fabsf(P.in[IN_AKN][lane]);
    mq = wave_max(mq); mk = wave_max(mk);
    const unsigned M2 = cvt_pk_bf16(-8.0f * mq * mk * 1.44269504089f, 0.f) & 0xffffu;
    AttRing R;
#define ATT_BH(U_) ((((U_) >> 8) << 3) + (((U_) >> 5) & 6) + ((U_) & 1))
#define ATT_BLK(U_) ((((U_) & 31) >> 1) + 16 * (((U_) >> 5) & 1))
#define ATT_QB(U_) ((const bf16_t*)(F.ws + WS_AQ) + (size_t)(ATT_BH(U_) >> 3) * SEQ * 512 + (ATT_BH(U_) & 7) * 64)
#define ATT_L(n_) (VAR == 1 ? 32 : (n_))
    int U = F.vcu;
    if (U < 512) { const AttItem a0{ATT_QB(U), 16, 2 * w, (ATT_BLK(U) * ATT_TOK) / 16, ATT_L(SEQ / 16)}; att_ring_load<0>(R, a0, 0, lane); att_q_load<2>(R, a0, lane);
        const int sc = lane & 7, sr = lane >> 3;
#pragma unroll
        for (int i = 0; i < 4; ++i) *(LAS u32x4*)(vbuf + (sr + 8 * i) * 128 + sc * 16) = R.vst[0][i]; }
    for (; U < 512; U += F.G) {
        const int bh = ATT_BH(U), blk = ATT_BLK(U), b = bh >> 3, h = bh & 7, T0 = blk * ATT_TOK;
        const bf16_t* Qb = ATT_QB(U);
        bf16_t* mix = mixbase + (size_t)b * SEQ * 1024 + h * 64;
        const float slope = __builtin_amdgcn_exp2f(-(float)(h + 1)) * 1.44269504089f;
        const AttItem iA{Qb, 16, 2 * w, T0 / 16, ATT_L(SEQ / 16)}, iB{Qb, 16, 2 * w + 1, T0 / 16, ATT_L(SEQ / 16)};
        const AttItem iC{Qb, 4, w >> 1, T0 / 4 + 64 * (w & 1), ATT_L(SEQ / 4)}, iD{Qb, 4, w >> 1, T0 / 4 + 64 * (w & 1) + 32, ATT_L(SEQ / 4)};
        const AttItem iE{Qb, 1, 0, T0 + 64 * w, ATT_L(SEQ)}, iF{Qb, 1, 0, T0 + 64 * w + 32, ATT_L(SEQ)};
        const int Un = (U + F.G < 512) ? U + F.G : U;
        const AttItem nA{ATT_QB(Un), 16, 2 * w, (ATT_BLK(Un) * ATT_TOK) / 16, ATT_L(SEQ / 16)};
        attn_item_d<2, 0, 0, 2>(R, iA, iB, slope * 16.f, M2, ACC, T0, vbuf, mix, lane);
        attn_item_d<2, 0, 1, 2>(R, iB, iC, slope * 16.f, M2, ACC, T0, vbuf, mix, lane);
        __syncthreads();
        attn_item_d<2, 1, 0, 2>(R, iC, iD, slope * 4.f, M2, ACC, T0, vbuf, mix, lane);
        attn_item_d<2, 1, 1, 2>(R, iD, iE, slope * 4.f, M2, ACC, T0, vbuf, mix, lane);
        __syncthreads();
        attn_item_d<2, 2, 0, 2>(R, iE, iF, slope, M2, ACC, T0, vbuf, mix, lane);
        attn_item_d<2, 2, 1, 2>(R, iF, nA, slope, M2, ACC, T0, vbuf, mix, lane);
        __syncthreads();
    }
#undef ATT_QB
#undef ATT_BH
#undef ATT_BLK
#undef ATT_L
}

template <int ROWB>
__device__ __forceinline__ bf16x8 tr_read2(unsigned addr) {
    bf16x4 a, b;
    asm volatile("ds_read_b64_tr_b16 %0, %2\n\tds_read_b64_tr_b16 %1, %2 offset:%3\n\ts_waitcnt lgkmcnt(0)" : "=&v"(a), "=&v"(b) : "v"(addr), "i"(16 * ROWB) : "memory");
    return cat4(a, b);
}
template <int ROWB, int STEP>
__device__ __forceinline__ void tr_read2x8(unsigned addr, bf16x8 (&f)[8]) {
    bf16x4 a[8], b[8];
    asm volatile("ds_read_b64_tr_b16 %0, %16\n\tds_read_b64_tr_b16 %8, %16 offset:%17\n\t"
                 "ds_read_b64_tr_b16 %1, %16 offset:%18\n\tds_read_b64_tr_b16 %9, %16 offset:%19\n\t"
                 "ds_read_b64_tr_b16 %2, %16 offset:%20\n\tds_read_b64_tr_b16 %10, %16 offset:%21\n\t"
                 "ds_read_b64_tr_b16 %3, %16 offset:%22\n\tds_read_b64_tr_b16 %11, %16 offset:%23\n\t"
                 "ds_read_b64_tr_b16 %4, %16 offset:%24\n\tds_read_b64_tr_b16 %12, %16 offset:%25\n\t"
                 "ds_read_b64_tr_b16 %5, %16 offset:%26\n\tds_read_b64_tr_b16 %13, %16 offset:%27\n\t"
                 "ds_read_b64_tr_b16 %6, %16 offset:%28\n\tds_read_b64_tr_b16 %14, %16 offset:%29\n\t"
                 "ds_read_b64_tr_b16 %7, %16 offset:%30\n\tds_read_b64_tr_b16 %15, %16 offset:%31\n\t"
                 "s_waitcnt lgkmcnt(0)"
                 : "=&v"(a[0]), "=&v"(a[1]), "=&v"(a[2]), "=&v"(a[3]), "=&v"(a[4]), "=&v"(a[5]), "=&v"(a[6]), "=&v"(a[7]),
                   "=&v"(b[0]), "=&v"(b[1]), "=&v"(b[2]), "=&v"(b[3]), "=&v"(b[4]), "=&v"(b[5]), "=&v"(b[6]), "=&v"(b[7])
                 : "v"(addr), "i"(16 * ROWB), "i"(1 * STEP), "i"(1 * STEP + 16 * ROWB), "i"(2 * STEP), "i"(2 * STEP + 16 * ROWB), "i"(3 * STEP), "i"(3 * STEP + 16 * ROWB),
                   "i"(4 * STEP), "i"(4 * STEP + 16 * ROWB), "i"(5 * STEP), "i"(5 * STEP + 16 * ROWB), "i"(6 * STEP), "i"(6 * STEP + 16 * ROWB), "i"(7 * STEP), "i"(7 * STEP + 16 * ROWB)
                 : "memory");
#pragma unroll
    for (int i = 0; i < 8; ++i) f[i] = cat4(a[i], b[i]);
}
template <int ROWB, int STEP>
__device__ __forceinline__ void tr_read2x4(unsigned addr, bf16x8 (&f)[4]) {
    bf16x4 a[4], b[4];
    asm volatile("ds_read_b64_tr_b16 %0, %8\n\tds_read_b64_tr_b16 %4, %8 offset:%9\n\t"
                 "ds_read_b64_tr_b16 %1, %8 offset:%10\n\tds_read_b64_tr_b16 %5, %8 offset:%11\n\t"
                 "ds_read_b64_tr_b16 %2, %8 offset:%12\n\tds_read_b64_tr_b16 %6, %8 offset:%13\n\t"
                 "ds_read_b64_tr_b16 %3, %8 offset:%14\n\tds_read_b64_tr_b16 %7, %8 offset:%15\n\t"
                 "s_waitcnt lgkmcnt(0)"
                 : "=&v"(a[0]), "=&v"(a[1]), "=&v"(a[2]), "=&v"(a[3]), "=&v"(b[0]), "=&v"(b[1]), "=&v"(b[2]), "=&v"(b[3])
                 : "v"(addr), "i"(16 * ROWB), "i"(1 * STEP), "i"(1 * STEP + 16 * ROWB), "i"(2 * STEP), "i"(2 * STEP + 16 * ROWB), "i"(3 * STEP), "i"(3 * STEP + 16 * ROWB)
                 : "memory");
#pragma unroll
    for (int i = 0; i < 4; ++i) f[i] = cat4(a[i], b[i]);
}
__device__ __forceinline__ float log2_sigmoid(float x) { return -log2f(1.0f + expf(-x)); }

__device__ __forceinline__ void p2_chunk_kv(Frame& F) {
    const Params& P = *F.p; const int lane = F.lane, w = F.wave, tid = F.tid, g = lane >> 4, li = lane & 15;
    LAS unsigned char* Vl = F.lds;
    LAS unsigned char* Kf = F.lds + 32768;
    LAS unsigned char* Kbk = F.lds + 32768 + 16384;
    u32x4 rv[4], rk[2];
#define P2B_LOAD(U) do { const int bh_ = (U) >> 7, n_ = (U) & 127, b_ = bh_ >> 2, h_ = bh_ & 3; const size_t row0_ = (size_t)b_ * SEQ + (size_t)n_ * 128; \
        const bf16_t* Vg_ = (const bf16_t*)(F.ws + WS_RV) + row0_ * 512 + h_ * 128; const bf16_t* Kg_ = (const bf16_t*)(F.ws + WS_RK) + row0_ * 256 + h_ * 64; \
        _Pragma("unroll") for (int i = 0; i < 4; ++i) { const int c = tid + 512 * i; rv[i] = *(const u32x4*)(Vg_ + (size_t)(c >> 4) * 512 + (c & 15) * 8); } \
        _Pragma("unroll") for (int i = 0; i < 2; ++i) { const int c = tid + 512 * i; rk[i] = *(const u32x4*)(Kg_ + (size_t)(c >> 3) * 256 + (c & 7) * 8); } } while (0)
    int U = F.vcu;
    if (U < 1024) P2B_LOAD(U);
    for (; U < 1024; U += F.G) {
        const int bh = U >> 7, h = bh & 3;
        const float l2f = log2_sigmoid(P.in[IN_DECF][h]), l2b = log2_sigmoid(P.in[IN_DECB][h]);
#pragma unroll
        for (int i = 0; i < 4; ++i) { const int c = tid + 512 * i, j = c >> 4, cc = c & 15; *(LAS u32x4*)(Vl + j * 256 + cc * 16) = rv[i]; }
#pragma unroll
        for (int i = 0; i < 2; ++i) { const int c = tid + 512 * i, j = c >> 3, cc = c & 7; const u32x4 kv = rk[i];
            const float wf = __builtin_amdgcn_exp2f(l2f * (float)(127 - j)), wb = __builtin_amdgcn_exp2f(l2b * (float)j);
            u32x4 a, bq;
            a.x = cvt_pk_bf16(bflo(kv.x) * wf, bfhi(kv.x) * wf); a.y = cvt_pk_bf16(bflo(kv.y) * wf, bfhi(kv.y) * wf); a.z = cvt_pk_bf16(bflo(kv.z) * wf, bfhi(kv.z) * wf); a.w = cvt_pk_bf16(bflo(kv.w) * wf, bfhi(kv.w) * wf);
            bq.x = cvt_pk_bf16(bflo(kv.x) * wb, bfhi(kv.x) * wb); bq.y = cvt_pk_bf16(bflo(kv.y) * wb, bfhi(kv.y) * wb); bq.z = cvt_pk_bf16(bflo(kv.z) * wb, bfhi(kv.z) * wb); bq.w = cvt_pk_bf16(bflo(kv.w) * wb, bfhi(kv.w) * wb);
            *(LAS u32x4*)(Kf + j * 128 + cc * 16) = a; *(LAS u32x4*)(Kbk + j * 128 + cc * 16) = bq; }
        __syncthreads();
        const int Un = U + F.G;
        if (Un < 1024) P2B_LOAD(Un);
        f32x4 acc[2][4];
#pragma unroll
        for (int dir = 0; dir < 2; ++dir)
#pragma unroll
            for (int dt = 0; dt < 4; ++dt) acc[dir][dt] = (f32x4){0.f, 0.f, 0.f, 0.f};
        const unsigned va = (unsigned)(size_t)Vl + (unsigned)((4 * g + (li >> 2)) * 256 + (16 * w + 4 * (li & 3)) * 2);
        const unsigned kaf = (unsigned)(size_t)Kf + (unsigned)((4 * g + (li >> 2)) * 128 + (4 * (li & 3)) * 2);
        const unsigned kab = (unsigned)(size_t)Kbk + (unsigned)((4 * g + (li >> 2)) * 128 + (4 * (li & 3)) * 2);
#pragma unroll
        for (int ks = 0; ks < 4; ++ks) {
            const bf16x8 af = tr_read2<256>(va + ks * 32 * 256);
            bf16x8 b0[4], b1[4]; tr_read2x4<128, 32>(kaf + ks * 32 * 128, b0); tr_read2x4<128, 32>(kab + ks * 32 * 128, b1);
#pragma unroll
            for (int dt = 0; dt < 4; ++dt) {
                acc[0][dt] = __builtin_amdgcn_mfma_f32_16x16x32_bf16(af, b0[dt], acc[0][dt], 0, 0, 0);
                acc[1][dt] = __builtin_amdgcn_mfma_f32_16x16x32_bf16(af, b1[dt], acc[1][dt], 0, 0, 0);
            }
        }
#pragma unroll
        for (int dir = 0; dir < 2; ++dir) { float* dst = (float*)(F.ws + WS_KV) + ((size_t)dir * 1024 + U) * 8192;
#pragma unroll
            for (int dt = 0; dt < 4; ++dt)
#pragma unroll
                for (int e = 0; e < 4; ++e) dst[(16 * w + 4 * g + e) * 64 + 16 * dt + li] = acc[dir][dt][e]; }
        __syncthreads();
    }
#undef P2B_LOAD
}

__device__ __forceinline__ void p3_scan(Frame& F) {
    const Params& P = *F.p;
    for (int gt = blockIdx.x * NTHR + F.tid; gt < 2 * 8 * 8192; gt += F.G * NTHR) {
        const int dir = gt >> 16, bh = (gt >> 13) & 7, el = gt & 8191, h = bh & 3;
        const float dec = __builtin_amdgcn_exp2f(128.f * log2_sigmoid(P.in[dir ? IN_DECB : IN_DECF][h]));
        const float* kv = (const float*)(F.ws + WS_KV) + ((size_t)dir * 1024 + bh * 128) * 8192 + el;
        bf16_t* st = (bf16_t*)(F.ws + WS_ST) + ((size_t)dir * 1024 + bh * 128) * 8192 + el;
        float s = 0.f;
        for (int c0 = 0; c0 < 128; c0 += 64) {
            float v[64];
#pragma unroll
            for (int i = 0; i < 64; ++i) { const int n = dir ? 127 - (c0 + i) : c0 + i; v[i] = kv[(size_t)n * 8192]; }
#pragma unroll
            for (int i = 0; i < 64; ++i) { const int n = dir ? 127 - (c0 + i) : c0 + i; st[(size_t)n * 8192] = (bf16_t)(cvt_pk_bf16(s, 0.f) & 0xffffu); s = s * dec + v[i]; }
        }
    }
}

constexpr int P4_V = 0, P4_K = 32768, P4_SF = 49152, P4_SB = 65536;
__device__ __forceinline__ void p4_retention_out(Frame& F) {
    const Params& P = *F.p; const int lane = F.lane, w = F.wave, tid = F.tid, g = lane >> 4, li = lane & 15;
    LAS unsigned char* L = F.lds;
    u32x4 rv[4], rk[2], rf[2], rb[2]; bf16x8 qn[2];
    const int iq = 16 * w + li;
#define P4_LOAD(U) do { const int bh_ = (U) >> 7, n_ = (U) & 127, b_ = bh_ >> 2, h_ = bh_ & 3; const size_t row0_ = (size_t)b_ * SEQ + (size_t)n_ * 128; \
        const bf16_t* Vg_ = (const bf16_t*)(F.ws + WS_RV) + row0_ * 512 + h_ * 128; const bf16_t* Kg_ = (const bf16_t*)(F.ws + WS_RK) + row0_ * 256 + h_ * 64; \
        const bf16_t* Qg_ = (const bf16_t*)(F.ws + WS_RQ) + row0_ * 256 + h_ * 64; \
        const bf16_t* Sf_ = (const bf16_t*)(F.ws + WS_ST) + (size_t)(U) * 8192; const bf16_t* Sb_ = Sf_ + (size_t)1024 * 8192; \
        _Pragma("unroll") for (int i = 0; i < 4; ++i) { const int c = tid + 512 * i; rv[i] = *(const u32x4*)(Vg_ + (size_t)(c >> 4) * 512 + (c & 15) * 8); } \
        _Pragma("unroll") for (int i = 0; i < 2; ++i) { const int c = tid + 512 * i; rk[i] = *(const u32x4*)(Kg_ + (size_t)(c >> 3) * 256 + (c & 7) * 8); \
            rf[i] = *(const u32x4*)(Sf_ + (size_t)c * 8); rb[i] = *(const u32x4*)(Sb_ + (size_t)c * 8); } \
        _Pragma("unroll") for (int ks = 0; ks < 2; ++ks) qn[ks] = *(const bf16x8*)(Qg_ + (size_t)iq * 256 + 32 * ks + 8 * g); } while (0)
    int U = F.vcu;
    if (U < 1024) P4_LOAD(U);
    for (; U < 1024; U += F.G) {
        const int bh = U >> 7, n = U & 127, b = bh >> 2, h = bh & 3;
        const size_t row0 = (size_t)b * SEQ + (size_t)n * 128;
        const float l2f = log2_sigmoid(P.in[IN_DECF][h]), l2b = log2_sigmoid(P.in[IN_DECB][h]);
#pragma unroll
        for (int i = 0; i < 4; ++i) { const int c = tid + 512 * i; *(LAS u32x4*)(L + P4_V + (c >> 4) * 256 + (c & 15) * 16) = rv[i]; }
#pragma unroll
        for (int i = 0; i < 2; ++i) { const int c = tid + 512 * i, row = c >> 3, pos = ((c & 7) ^ ((row >> 1) & 7)) << 4;
            *(LAS u32x4*)(L + P4_K + row * 128 + pos) = rk[i]; *(LAS u32x4*)(L + P4_SF + row * 128 + pos) = rf[i]; *(LAS u32x4*)(L + P4_SB + row * 128 + pos) = rb[i]; }
        bf16x8 qf[2] = {qn[0], qn[1]};
        __syncthreads();
        const int Un = U + F.G;
        if (Un < 1024) P4_LOAD(Un);
        const bf16_t* gp = (const bf16_t*)(F.ws + WS_RG) + (row0 + iq) * 512 + h * 128;
        u32x2 gv[8];
#pragma unroll
        for (int et = 0; et < 8; ++et) gv[et] = *(const u32x2*)(gp + 16 * et + 4 * g);
        bf16x8 pb[4];
#pragma unroll
        for (int ks4 = 0; ks4 < 4; ++ks4) {
            float p[8];
#pragma unroll
            for (int t = 0; t < 2; ++t) { const int jt = 2 * ks4 + t, row = 16 * jt + li; const LAS unsigned char* kr = L + P4_K + row * 128;
                f32x4 s = __builtin_amdgcn_mfma_f32_16x16x32_bf16(*(const LAS bf16x8*)(kr + ((g ^ ((row >> 1) & 7)) << 4)), qf[0], (f32x4){0.f, 0.f, 0.f, 0.f}, 0, 0, 0);
                s = __builtin_amdgcn_mfma_f32_16x16x32_bf16(*(const LAS bf16x8*)(kr + (((g + 4) ^ ((row >> 1) & 7)) << 4)), qf[1], s, 0, 0, 0);
#pragma unroll
                for (int e = 0; e < 4; ++e) { const int j = 16 * jt + 4 * g + e, df = iq - j;
                    const float dcy = df >= 0 ? __builtin_amdgcn_exp2f(l2f * (float)df) : __builtin_amdgcn_exp2f(l2b * (float)(-df));
                    p[t * 4 + e] = s[e] * dcy; } }
            u32x4 pw; pw.x = cvt_pk_bf16(p[0], p[1]); pw.y = cvt_pk_bf16(p[2], p[3]); pw.z = cvt_pk_bf16(p[4], p[5]); pw.w = cvt_pk_bf16(p[6], p[7]);
            pb[ks4] = __builtin_bit_cast(bf16x8, pw);
        }
        f32x4 y[8];
#pragma unroll
        for (int et = 0; et < 8; ++et) y[et] = (f32x4){0.f, 0.f, 0.f, 0.f};
        const unsigned va = (unsigned)(size_t)(L + P4_V) + (unsigned)((4 * g + (li >> 2)) * 256 + (4 * (li & 3)) * 2);
#pragma unroll
        for (int ks4 = 0; ks4 < 4; ++ks4)
#pragma unroll
            for (int eh = 0; eh < 2; ++eh) { bf16x8 af[4]; tr_read2x4<256, 32>(va + ks4 * 32 * 256 + eh * 128, af);
#pragma unroll
                for (int et = 0; et < 4; ++et) y[4 * eh + et] = __builtin_amdgcn_mfma_f32_16x16x32_bf16(af[et], pb[ks4], y[4 * eh + et], 0, 0, 0); }
#pragma unroll
        for (int dir = 0; dir < 2; ++dir) {
            const float sc = dir ? __builtin_amdgcn_exp2f(l2b * (float)(128 - iq)) : __builtin_amdgcn_exp2f(l2f * (float)(iq + 1));
            const LAS unsigned char* sp = L + (dir ? P4_SB : P4_SF);
#pragma unroll
            for (int ks = 0; ks < 2; ++ks) {
                const u32x4 qv = __builtin_bit_cast(u32x4, qf[ks]); u32x4 qs;
                qs.x = cvt_pk_bf16(bflo(qv.x) * sc, bfhi(qv.x) * sc); qs.y = cvt_pk_bf16(bflo(qv.y) * sc, bfhi(qv.y) * sc); qs.z = cvt_pk_bf16(bflo(qv.z) * sc, bfhi(qv.z) * sc); qs.w = cvt_pk_bf16(bflo(qv.w) * sc, bfhi(qv.w) * sc);
                const bf16x8 qb = __builtin_bit_cast(bf16x8, qs);
#pragma unroll
                for (int et = 0; et < 8; ++et) { const int row = 16 * et + li; const bf16x8 af = *(const LAS bf16x8*)(sp + row * 128 + (((g + 4 * ks) ^ ((row >> 1) & 7)) << 4));
                    y[et] = __builtin_amdgcn_mfma_f32_16x16x32_bf16(af, qb, y[et], 0, 0, 0); }
            }
        }
        float s1 = 0.f;
#pragma unroll
        for (int et = 0; et < 8; ++et) s1 += (y[et].x + y[et].y) + (y[et].z + y[et].w);
        s1 = sum_g4(s1);
        const float mu = s1 * (1.f / 128.f); float s2 = 0.f;
#pragma unroll
        for (int et = 0; et < 8; ++et) { const f32x4 dv = y[et] - mu; s2 += (dv.x * dv.x + dv.y * dv.y) + (dv.z * dv.z + dv.w * dv.w); }
        s2 = sum_g4(s2);
        const float rstd = 1.0f / sqrtf(s2 * (1.f / 128.f) + 1e-5f);
        const float* gw = P.in[IN_GNW] + h * 128;
        bf16_t* op = (bf16_t*)(F.ws + WS_MIX) + (row0 + iq) * 1024 + 512 + h * 128;
#pragma unroll
        for (int et = 0; et < 8; ++et) { const int e0 = 16 * et + 4 * g; const f32x4 ww = *(const f32x4*)(gw + e0);
            const f32x4 v = (y[et] - mu) * rstd * ww; u32x2 o; o.x = cvt_pk_bf16(v.x * bflo(gv[et].x), v.y * bfhi(gv[et].x)); o.y = cvt_pk_bf16(v.z * bflo(gv[et].y), v.w * bfhi(gv[et].y));
            *(u32x2*)(op + e0) = o; }
        __syncthreads();
    }
#undef P4_LOAD
}

template <int VAR>
struct EpiResidT {
    static constexpr bool PERM = false;
    const float* base; float* out; bf16_t* ob; float* sumsq;
    __device__ __forceinline__ void operator()(const f32x4 (&acc)[2][2][4][2], const pg8::Unit& u, int wr, int wc, int fr, int fq) const {
        const int row0 = u.pm * 256 + wr * 64 + fr, col0 = u.pn * 256 + wc * 32 + 4 * fq;
#pragma unroll
        for (int ai = 0; ai < 2; ++ai)
#pragma unroll
            for (int m = 0; m < 4; ++m) { const int row = row0 + ai * 128 + m * 16; const size_t off = (size_t)row * DM + col0; float ss = 0.f;
#pragma unroll
                for (int bj = 0; bj < 2; ++bj)
#pragma unroll
                    for (int n = 0; n < 2; ++n) { const f32x4 v = (VAR == 3 ? (f32x4){0.f, 0.f, 0.f, 0.f} : *(const f32x4*)(base + off + bj * 128 + n * 16)) + acc[ai][bj][m][n];
                        if (VAR != 2) *(f32x4*)(out + off + bj * 128 + n * 16) = v; ss += (v.x * v.x + v.y * v.y) + (v.z * v.z + v.w * v.w);
                        u32x2 wv; wv.x = cvt_pk_bf16(v.x, v.y); wv.y = cvt_pk_bf16(v.z, v.w); *(u32x2*)(ob + off + bj * 128 + n * 16) = wv; }
                ss = sum_g4(ss);
                if (fq == 0 && VAR != 1) atomicAdd(sumsq + row, ss);
                asm volatile("" ::: "memory"); }
    }
};


__device__ __forceinline__ void memkv_item(Frame& F, int item) {
    const Params& P = *F.p; const int lane = F.lane, w = F.wave, g = lane >> 4, li = lane & 15;
    const int rt = item >> 3, hh = item & 7, row0 = rt * 16;
    const bf16_t* A = (const bf16_t*)(F.ws + WS_MEMH) + (size_t)(row0 + li) * 1024 + 8 * g;
    const bf16_t* Bw = (const bf16_t*)(F.ws + WS_WMKV) + (size_t)(hh * 256 + 32 * w + li) * 1024 + 8 * g;
    LAS float* part = (LAS float*)F.lds;
    f32x4 acc[2] = {(f32x4){0.f, 0.f, 0.f, 0.f}, (f32x4){0.f, 0.f, 0.f, 0.f}};
#pragma unroll 8
    for (int ks = 0; ks < 32; ++ks) { const bf16x8 af = *(const bf16x8*)(A + 32 * ks);
        acc[0] = __builtin_amdgcn_mfma_f32_16x16x32_bf16(af, *(const bf16x8*)(Bw + 32 * ks), acc[0], 0, 0, 0);
        acc[1] = __builtin_amdgcn_mfma_f32_16x16x32_bf16(af, *(const bf16x8*)(Bw + (size_t)16 * 1024 + 32 * ks), acc[1], 0, 0, 0); }
    const int b = row0 >> 8, key0 = (row0 & 255) + 4 * g;
    if (hh < 4) {
#pragma unroll
        for (int e = 0; e < 4; ++e) { const float s = sum_row16(acc[0][e] * acc[0][e] + acc[1][e] * acc[1][e]); if (li == 0) part[w * 16 + 4 * g + e] = s; }
    }
    __syncthreads();
    if (hh < 4) {
        float rs[4];
#pragma unroll
        for (int e = 0; e < 4; ++e) { float t = 0.f;
#pragma unroll
            for (int ww = 0; ww < 8; ++ww) t += part[ww * 16 + 4 * g + e];
            rs[e] = 0.0625f / sqrtf(t * (1.f / 256.f) + 1e-6f); }
        bf16_t* dst = (bf16_t*)(F.ws + WS_MK) + ((size_t)(b * 4 + hh) * 256 + key0) * 256;
#pragma unroll
        for (int c = 0; c < 2; ++c) { const int d = 32 * w + 16 * c + li; const float wv = P.in[IN_MKN][d] * P.in[IN_MQN][d];
#pragma unroll
            for (int e = 0; e < 4; ++e) dst[(size_t)e * 256 + d] = (bf16_t)(cvt_pk_bf16(acc[c][e] * rs[e] * wv, 0.f) & 0xffffu); }
    } else {
        bf16_t* dst = (bf16_t*)(F.ws + WS_MVT) + ((size_t)(b * 4 + (hh - 4)) * 256) * 256 + ((row0 & 255) & ~31) + 8 * g + 4 * ((row0 >> 4) & 1);
#pragma unroll
        for (int c = 0; c < 2; ++c) { const int d = 32 * w + 16 * c + li; u32x2 o; o.x = cvt_pk_bf16_c(acc[c][0], acc[c][1]); o.y = cvt_pk_bf16_c(acc[c][2], acc[c][3]); *(u32x2*)(dst + (size_t)d * 256) = o; }
    }
    __syncthreads();
}

#ifndef KEEP_LO
#define KEEP_LO 0
#endif
template <bool BASE_F32>
struct EpiResidHL {
    static constexpr bool PERM = true;
    const float* basef; const bf16_t* bhi; const float* blo_f; bf16_t* ohi; bf16_t* olo; float* sumsq; unsigned char* oq;
    __device__ __forceinline__ void load_base(int row, int col0, u32x4 (&bh)[2]) const {
        const size_t off = (size_t)row * DM + col0;
#pragma unroll
        for (int bj = 0; bj < 2; ++bj) bh[bj] = *(const u32x4*)(bhi + off + bj * 128);
    }
    __device__ __forceinline__ void operator()(const f32x4 (&acc)[2][2][4][2], const pg8::Unit& u, int wr, int wc, int fr, int fq) const {
        const int row0 = u.pm * 256 + wr * 64 + fr, col0 = u.pn * 256 + wc * 32 + 8 * fq;
        u32x4 bh[4][2];
#pragma unroll
        for (int i = 0; i < 3; ++i) load_base(row0 + (i >> 2) * 128 + (i & 3) * 16, col0, bh[i]);
        f32x4 iw[2][2]; float rr[8];
        if (BASE_F32) {
#pragma unroll
            for (int i = 0; i < 8; ++i) rr[i] = blo_f[row0 + (i >> 2) * 128 + (i & 3) * 16];
#pragma unroll
            for (int bj = 0; bj < 2; ++bj)
#pragma unroll
                for (int n = 0; n < 2; ++n) { const f32x4 w4 = *(const f32x4*)(basef + col0 + bj * 128 + 4 * n); iw[bj][n] = (f32x4){1.0f / w4.x, 1.0f / w4.y, 1.0f / w4.z, 1.0f / w4.w}; } }
#pragma unroll
        for (int i = 0; i < 8; ++i) { const int ai = i >> 2, m = i & 3; const int row = row0 + ai * 128 + m * 16; const size_t off = (size_t)row * DM + col0; float ss = 0.f;
            if (i < 5) load_base(row0 + ((i + 3) >> 2) * 128 + ((i + 3) & 3) * 16, col0, bh[(i + 3) & 3]);
            float rms = 1.f; if (BASE_F32) rms = 1.0f / rr[i];
#pragma unroll
            for (int bj = 0; bj < 2; ++bj) { f32x4 b0, b1;
                { const u32x4 h = bh[i & 3][bj];
                    b0 = (f32x4){bflo(h.x), bfhi(h.x), bflo(h.y), bfhi(h.y)}; b1 = (f32x4){bflo(h.z), bfhi(h.z), bflo(h.w), bfhi(h.w)}; }
                if (BASE_F32) { b0 = b0 * iw[bj][0] * rms; b1 = b1 * iw[bj][1] * rms; }
                const f32x4 v0 = b0 + acc[ai][bj][m][0], v1 = b1 + acc[ai][bj][m][1];
                ss += (v0.x * v0.x + v0.y * v0.y) + (v0.z * v0.z + v0.w * v0.w) + (v1.x * v1.x + v1.y * v1.y) + (v1.z * v1.z + v1.w * v1.w);
                u32x4 hw; hw.x = cvt_pk_bf16(v0.x, v0.y); hw.y = cvt_pk_bf16(v0.z, v0.w); hw.z = cvt_pk_bf16(v1.x, v1.y); hw.w = cvt_pk_bf16(v1.z, v1.w);
                *(u32x4*)(ohi + off + bj * 128) = hw;
                if (oq) { int q0 = 0, q1 = 0; q0 = __builtin_amdgcn_cvt_pk_fp8_f32(v0.x, v0.y, q0, false); q0 = __builtin_amdgcn_cvt_pk_fp8_f32(v0.z, v0.w, q0, true);
                    q1 = __builtin_amdgcn_cvt_pk_fp8_f32(v1.x, v1.y, q1, false); q1 = __builtin_amdgcn_cvt_pk_fp8_f32(v1.z, v1.w, q1, true);
                    *(u32x2*)(oq + off + bj * 128) = (u32x2){(unsigned)q0, (unsigned)q1}; } }
            ss = sum_g4(ss);
            if (fq == 0) atomicAdd(sumsq + row, ss);
        }
    }
};
struct EpiNull {
    static constexpr bool PERM = true;
    float* sink;
    __device__ __forceinline__ void operator()(const f32x4 (&acc)[2][2][4][2], const pg8::Unit& u, int wr, int wc, int fr, int fq) const {
        f32x4 s = (f32x4){0.f, 0.f, 0.f, 0.f};
#pragma unroll
        for (int a = 0; a < 2; ++a)
#pragma unroll
            for (int b = 0; b < 2; ++b)
#pragma unroll
                for (int m = 0; m < 4; ++m)
#pragma unroll
                    for (int n = 0; n < 2; ++n) s += acc[a][b][m][n];
        sink[(size_t)(u.pm * 4 + u.pn) * 512 + threadIdx.x] = s.x + s.y + s.z + s.w;
    }
};
typedef EpiResidT<0> EpiResid;
#ifndef EPI_VAR
#define EPI_VAR 0
#endif
struct EpiMemQ {
    static constexpr bool PERM = true;
    bf16_t* qm; const float* sumsq1; float* hsq;
    __device__ __forceinline__ void operator()(const f32x4 (&acc)[2][2][4][2], const pg8::Unit& u, int wr, int wc, int fr, int fq) const {
        const int row0 = u.pm * 256 + wr * 64 + fr, col0 = u.pn * 256 + wc * 32 + 8 * fq;
        float sq[8];
#pragma unroll
        for (int i = 0; i < 8; ++i) sq[i] = sumsq1[row0 + (i >> 2) * 128 + (i & 3) * 16];
#pragma unroll
        for (int ai = 0; ai < 2; ++ai)
#pragma unroll
            for (int m = 0; m < 4; ++m) { const int row = row0 + ai * 128 + m * 16; const float rs = 1.0f / sqrtf(sq[ai * 4 + m] * (1.f / 1024.f) + 1e-6f); float ss = 0.f;
                bf16_t* rowp = qm + (size_t)row * DM + col0;
#pragma unroll
                for (int bj = 0; bj < 2; ++bj) { const f32x4 v0 = acc[ai][bj][m][0] * rs, v1 = acc[ai][bj][m][1] * rs;
                    ss += (v0.x * v0.x + v0.y * v0.y) + (v0.z * v0.z + v0.w * v0.w) + (v1.x * v1.x + v1.y * v1.y) + (v1.z * v1.z + v1.w * v1.w);
                    u32x4 w; w.x = cvt_pk_bf16(v0.x, v0.y); w.y = cvt_pk_bf16(v0.z, v0.w); w.z = cvt_pk_bf16(v1.x, v1.y); w.w = cvt_pk_bf16(v1.z, v1.w);
                    *(u32x4*)(rowp + 128 * bj) = w; }
                ss = sum_g4(ss);
                if (fq == 0) atomicAdd(hsq + (size_t)row * 4 + u.pn, ss); }
    }
};

template <class Sched>
__device__ __forceinline__ void p7_mem_attention(Frame& F, const Sched& S) {
    const Params& P = *F.p; const int lane = F.lane, w = F.wave, tid = F.tid, g = lane >> 4, li = lane & 15;
    float mq = 0.f, mk = 0.f;
#pragma unroll
    for (int i = 0; i < 4; ++i) { mq = fmaxf(mq, fabsf(P.in[IN_MQN][lane + 64 * i])); mk = fmaxf(mk, fabsf(P.in[IN_MKN][lane + 64 * i])); }
    mq = wave_max(mq); mk = wave_max(mk);
    const float M2 = 16.0f * mq * mk * 1.44269504089f;
    LAS unsigned char* buf = F.lds;
    int kso[2], klo[2];
#pragma unroll
    for (int j = 0; j < 2; ++j) { const int o = tid * 16 + j * 8192, r = o >> 9, cpos = (o & 511) >> 4; klo[j] = o; kso[j] = r * 256 + ((cpos ^ (r & 15)) << 3); }
    const int vdim = tid >> 2, vseg = (tid & 3) ^ ((0 - (vdim >> 2)) & 3);
    pg8::Unit un;
    for (int ui = 0; S.next(ui, un); ++ui) {
        const int b = un.pm >> 6, qb = un.pm & 63, head = un.pn, bhd = b * 4 + head;
        const size_t tok0 = (size_t)b * SEQ + (size_t)qb * 256 + 32 * w;
        const bf16_t* Kp = (const bf16_t*)(F.ws + WS_MK) + (size_t)bhd * 65536;
        const bf16_t* Vt = (const bf16_t*)(F.ws + WS_MVT) + (size_t)bhd * 65536;
        bf16x8 qf[2][8]; float hs[2];
#pragma unroll
        for (int qt = 0; qt < 2; ++qt) { const size_t tok = tok0 + 16 * qt + li; const bf16_t* qp = (const bf16_t*)(F.ws + WS_QM) + tok * DM + head * 256 + 8 * g;
#pragma unroll
            for (int ks = 0; ks < 8; ++ks) qf[qt][ks] = *(const bf16x8*)(qp + 32 * ks);
            hs[qt] = 1.44269504089f / sqrtf(((const float*)(F.ws + WS_HSQ))[tok * 4 + head] * (1.f / 256.f) + 1e-6f); }
        bf16x8 pb[2][8]; float lsum[2] = {0.f, 0.f};
        u32x4 sreg[2][2];
#pragma unroll
        for (int j = 0; j < 2; ++j) { sreg[0][j] = *(const u32x4*)(Kp + kso[j]); sreg[1][j] = *(const u32x4*)(Kp + (size_t)8192 + kso[j]); }
        __syncthreads();
#pragma unroll
        for (int j = 0; j < 2; ++j) *(LAS u32x4*)(buf + klo[j]) = sreg[0][j];
        __syncthreads();
#pragma unroll
        for (int Pp = 0; Pp < 8; ++Pp) {
            LAS unsigned char* cb = buf + (Pp & 1) * 16384;
            if (Pp < 6) {
#pragma unroll
                for (int j = 0; j < 2; ++j) sreg[Pp & 1][j] = *(const u32x4*)(Kp + (size_t)(Pp + 2) * 8192 + kso[j]); }
            f32x4 st[2][2];
#pragma unroll
            for (int t = 0; t < 2; ++t) { const int rho = 16 * t + li;
                st[0][t] = (f32x4){0.f, 0.f, 0.f, 0.f}; st[1][t] = (f32x4){0.f, 0.f, 0.f, 0.f};
#pragma unroll
                for (int ks = 0; ks < 8; ++ks) { const bf16x8 kf = *(const LAS bf16x8*)(cb + rho * 512 + (((4 * ks + g) ^ li) << 4));
                    st[0][t] = __builtin_amdgcn_mfma_f32_16x16x32_bf16(kf, qf[0][ks], st[0][t], 0, 0, 0);
                    st[1][t] = __builtin_amdgcn_mfma_f32_16x16x32_bf16(kf, qf[1][ks], st[1][t], 0, 0, 0); } }
#pragma unroll
            for (int qt = 0; qt < 2; ++qt) { float p[8];
#pragma unroll
                for (int t = 0; t < 2; ++t)
#pragma unroll
                    for (int e = 0; e < 4; ++e) { p[t * 4 + e] = __builtin_amdgcn_exp2f(__builtin_fmaf(st[qt][t][e], hs[qt], -M2)); lsum[qt] += p[t * 4 + e]; }
                u32x4 pw; pw.x = cvt_pk_bf16(p[0], p[1]); pw.y = cvt_pk_bf16(p[2], p[3]); pw.z = cvt_pk_bf16(p[4], p[5]); pw.w = cvt_pk_bf16(p[6], p[7]);
                pb[qt][Pp] = __builtin_bit_cast(bf16x8, pw); }
            if (Pp < 7) {
#pragma unroll
                for (int j = 0; j < 2; ++j) *(LAS u32x4*)(buf + ((Pp + 1) & 1) * 16384 + klo[j]) = sreg[(Pp + 1) & 1][j]; }
            __syncthreads();
        }
        float inv[2];
#pragma unroll
        for (int qt = 0; qt < 2; ++qt) inv[qt] = 1.0f / sum_g4(lsum[qt]);
        u32x4 vreg[2];
        vreg[0] = *(const u32x4*)(Vt + (size_t)vdim * 256 + vseg * 8); vreg[1] = *(const u32x4*)(Vt + (size_t)vdim * 256 + 32 + vseg * 8);
        *(LAS u32x4*)(buf + tid * 16) = vreg[0];
        __syncthreads();
#pragma unroll 1
        for (int dh = 0; dh < 2; ++dh) {
            f32x4 o[2][8];
#pragma unroll
            for (int dt = 0; dt < 8; ++dt) { o[0][dt] = (f32x4){0.f, 0.f, 0.f, 0.f}; o[1][dt] = (f32x4){0.f, 0.f, 0.f, 0.f}; }
#pragma unroll
            for (int Pp = 0; Pp < 8; ++Pp) {
                const int c = dh * 8 + Pp; LAS unsigned char* cb = buf + (c & 1) * 8192;
                if (c < 14) { const int c2 = c + 2; vreg[Pp & 1] = *(const u32x4*)(Vt + (size_t)(128 * (c2 >> 3) + vdim) * 256 + 32 * (c2 & 7) + vseg * 8); }
#pragma unroll
                for (int dt = 0; dt < 8; ++dt) { const int dl = 16 * dt + li; const bf16x8 vf = *(const LAS bf16x8*)(cb + dl * 64 + ((g ^ ((0 - (dl >> 2)) & 3)) << 4));
                    o[0][dt] = __builtin_amdgcn_mfma_f32_16x16x32_bf16(vf, pb[0][Pp], o[0][dt], 0, 0, 0);
                    o[1][dt] = __builtin_amdgcn_mfma_f32_16x16x32_bf16(vf, pb[1][Pp], o[1][dt], 0, 0, 0); }
                if (c < 15) *(LAS u32x4*)(buf + ((c + 1) & 1) * 8192 + tid * 16) = vreg[(Pp + 1) & 1];
                __syncthreads();
            }
#pragma unroll
            for (int qt = 0; qt < 2; ++qt) { bf16_t* op = (bf16_t*)(F.ws + WS_OM) + (tok0 + 16 * qt + li) * DM + head * 256 + 128 * dh + 4 * g;
#pragma unroll
                for (int dt = 0; dt < 8; ++dt) { const f32x4 v = o[qt][dt] * inv[qt]; u32x2 wv; wv.x = cvt_pk_bf16(v.x, v.y); wv.y = cvt_pk_bf16(v.z, v.w); *(u32x2*)(op + 16 * dt) = wv; } }
        }
    }
}

constexpr size_t WS_TOKSLOT = 117 * MiB + 512 * 1024;

struct RouteRec { int e0, e1; float g0, g1; };
constexpr int P9_W_BYTES = 48 * 2048, P9_XROW = 288, P9_XT_OFF = P9_W_BYTES + 256;
__device__ __forceinline__ void p9_route(Frame& F, unsigned* gcnt) {
    const int lane = F.lane, w = F.wave, tid = F.tid, g = lane >> 4, li = lane & 15;
    LAS unsigned char* Wl = F.lds;
    LAS unsigned* lcnt = (LAS unsigned*)(F.lds + P9_W_BYTES);
    LAS unsigned char* xt = F.lds + P9_XT_OFF + w * (16 * P9_XROW);
    {
        const bf16_t* wg = (const bf16_t*)(F.ws + WS_WRT);
        u32x4 t[12];
#pragma unroll
        for (int i = 0; i < 12; ++i) { const int p = tid + 512 * i; t[i] = *(const u32x4*)(wg + (size_t)(p >> 7) * 1024 + (p & 127) * 8); }
#pragma unroll
        for (int i = 0; i < 12; ++i) { const int p = tid + 512 * i, row = p >> 7, ch = p & 127; *(LAS u32x4*)(Wl + row * 2048 + ((ch ^ (row & 15)) << 4)) = t[i]; }
    }
    if (tid < 32) lcnt[tid] = 0u;
    __syncthreads();
    const int gw = F.vcu * NWAVES + w, NGW = F.G * NWAVES;
    for (int tt = gw; tt < NT / 16; tt += NGW) {
        const int tok0 = tt * 16;
        const bf16_t* xg = (const bf16_t*)(F.ws + WS_X2B) + (size_t)(tok0 + g) * DM + 8 * li;
        f32x4 acc[3];
#pragma unroll
        for (int ct = 0; ct < 3; ++ct) acc[ct] = (f32x4){0.f, 0.f, 0.f, 0.f};
        u32x4 xr[4];
#pragma unroll
        for (int i = 0; i < 4; ++i) xr[i] = *(const u32x4*)(xg + (size_t)(4 * i) * DM);
#pragma unroll 1
        for (int c = 0; c < 8; ++c) {
#pragma unroll
            for (int i = 0; i < 4; ++i) *(LAS u32x4*)(xt + (4 * i + g) * P9_XROW + li * 16) = xr[i];
            if (c < 7) {
#pragma unroll
                for (int i = 0; i < 4; ++i) xr[i] = *(const u32x4*)(xg + (size_t)(4 * i) * DM + 128 * (c + 1)); }
            LDS_WAIT();
#pragma unroll
            for (int ks = 0; ks < 4; ++ks) {
                const bf16x8 ah = *(const LAS bf16x8*)(xt + li * P9_XROW + (32 * ks + 8 * g) * 2);
                const int chi = 16 * c + 4 * ks + g;
#pragma unroll
                for (int ct = 0; ct < 3; ++ct) { const bf16x8 bh = *(const LAS bf16x8*)(Wl + (16 * ct + li) * 2048 + ((chi ^ li) << 4));
                    acc[ct] = __builtin_amdgcn_mfma_f32_16x16x32_bf16(ah, bh, acc[ct], 0, 0, 0); }
            }
            LDS_WAIT();
        }
        LAS float* lg = (LAS float*)xt;
#pragma unroll
        for (int ct = 0; ct < 3; ++ct)
#pragma unroll
            for (int e = 0; e < 4; ++e) lg[(4 * g + e) * 52 + 16 * ct + li] = acc[ct][e];
        LDS_WAIT();
        if (lane < 16) {
            const int tok = tok0 + lane; const LAS float* a = lg + lane * 52;
            const float rstd = 1.0f / sqrtf(((const float*)(F.ws + WS_SUMSQ2))[tok] * (1.f / 1024.f) + 1e-6f);
            int grp = 0; float gm = a[0];
#pragma unroll
            for (int q = 1; q < 4; ++q) { const float v = a[q]; if (v > gm) { gm = v; grp = q; } }
            float gden = 0.f;
#pragma unroll
            for (int q = 0; q < 4; ++q) gden += expf((a[q] - gm) * rstd);
            const float ggate = 1.0f / gden;
            const LAS float* el = a + 4 + grp * 8;
            int i1 = 0; float v1 = el[0];
#pragma unroll
            for (int e = 1; e < 8; ++e) { const float v = el[e]; if (v > v1) { v1 = v; i1 = e; } }
            int i2 = -1; float v2 = -3.0e38f;
#pragma unroll
            for (int e = 0; e < 8; ++e) { const float v = el[e]; if (e != i1 && v > v2) { v2 = v; i2 = e; } }
            const float ex = expf((v2 - v1) * rstd);
            RouteRec r; r.e0 = grp * 8 + i1; r.e1 = grp * 8 + i2; r.g0 = ggate / (1.0f + ex); r.g1 = ggate * ex / (1.0f + ex);
            ((RouteRec*)(F.ws + WS_ROUTE))[tok] = r;
            __hip_atomic_fetch_add(&lcnt[r.e0], 1u, __ATOMIC_RELAXED, __HIP_MEMORY_SCOPE_WORKGROUP); __hip_atomic_fetch_add(&lcnt[r.e1], 1u, __ATOMIC_RELAXED, __HIP_MEMORY_SCOPE_WORKGROUP);
        }
        LDS_WAIT();
    }
    __syncthreads();
    if (tid < 32) atomicAdd(gcnt + tid, lcnt[tid]);
    __syncthreads();
}
__device__ __forceinline__ void p10_slots(Frame& F) {
    LAS unsigned* lcnt = (LAS unsigned*)F.lds; LAS unsigned* lbase = lcnt + 32; LAS unsigned* loff = lcnt + 64; LAS unsigned* lgc = lcnt + 128;
    unsigned* cnt = (unsigned*)(F.ws + WS_CTL) + CW_CNT; unsigned* fill = (unsigned*)(F.ws + WS_CTL) + CW_FILL;
    int* slot_tok = (int*)(F.ws + WS_SLOTTOK); float* slot_gate = (float*)(F.ws + WS_SLOTGATE); int* tile_exp = (int*)(F.ws + WS_TILEEXP);
    const int tid = F.tid, blk = blockIdx.x;
    if (tid < 32) { lcnt[tid] = 0u; lgc[tid] = __hip_atomic_load(cnt + tid, __ATOMIC_RELAXED, __HIP_MEMORY_SCOPE_AGENT); }
    __syncthreads();
    if (tid == 0) { unsigned o = 0; for (int e = 0; e < 32; ++e) { loff[e] = o; o += (lgc[e] + 255u) & ~255u; } loff[32] = o; }
    __syncthreads();
    int e = 0, tok = 0, rank = 0; float gate = 0.f; unsigned lpos = 0;
    if (tid < 256) { tok = blk * 128 + (tid >> 1); rank = tid & 1; const RouteRec r = ((const RouteRec*)(F.ws + WS_ROUTE))[tok]; e = rank ? r.e1 : r.e0; gate = rank ? r.g1 : r.g0; lpos = __hip_atomic_fetch_add(&lcnt[e], 1u, __ATOMIC_RELAXED, __HIP_MEMORY_SCOPE_WORKGROUP); }
    __syncthreads();
    if (tid < 32) lbase[tid] = lcnt[tid] ? atomicAdd(fill + tid, lcnt[tid]) : 0u;
    __syncthreads();
    if (tid < 256) { const unsigned slot = loff[e] + lbase[e] + lpos; slot_tok[slot] = tok; slot_gate[slot] = gate; ((int*)(F.ws + WS_TOKSLOT))[tok * 2 + rank] = (int)slot; }
    if (blk < 32) { const unsigned c = lgc[blk], cp = (c + 255u) & ~255u, o = loff[blk];
        for (unsigned s = c + tid; s < cp; s += NTHR) { slot_tok[o + s] = 0; slot_gate[o + s] = 0.f; }
        for (unsigned t = tid; t < cp / 256u; t += NTHR) tile_exp[o / 256u + t] = blk; }
    __syncthreads();
}
struct MoeOrder {
    const char* A; const char* W; const int* tile_exp; const int* slot_tok; int ntiles, G, c, kb; size_t wstride, tstepB, tstepA;
    __device__ bool next_(int i, pg8::Unit& u, bool gatherA) const {
        const int L = i * G + c, T = L >> 2; if (T >= ntiles) return false;
        const int e = tile_exp[T]; u.pm = T; u.pn = L & 3; u.aux = e;
        u.A = gatherA ? A : A + (size_t)T * tstepA; u.B = W + (size_t)e * wstride + (size_t)u.pn * tstepB; return true;
    }
};
struct MoeOrder1 : MoeOrder {
    static constexpr bool GATHER = true;
    __device__ bool next(int i, pg8::Unit& u) const { return next_(i, u, true); }
    __device__ __forceinline__ void gather(const pg8::Unit& u, int R0, int R1, int C0, int C1, unsigned (&vA)[2][2]) const {
#pragma unroll
        for (int h = 0; h < 2; ++h) { const int t0 = slot_tok[u.pm * 256 + R0 + 128 * h], t1 = slot_tok[u.pm * 256 + R1 + 128 * h];
            vA[h][0] = (unsigned)(t0 * kb + C0) * 2u; vA[h][1] = (unsigned)(t1 * kb + C1) * 2u; }
    }
};
struct MoeOrder2 : MoeOrder {
    static constexpr bool GATHER = false;
    __device__ bool next(int i, pg8::Unit& u) const { return next_(i, u, false); }
    __device__ __forceinline__ void gather(const pg8::Unit&, int, int, int, int, unsigned (&)[2][2]) const {}
};
struct EpiMoe1 {
    static constexpr bool PERM = true;
    unsigned char* H; const int* slot_tok; const float* slot_gate; const float* sumsq2;
    __device__ __forceinline__ void operator()(const f32x4 (&acc)[2][2][4][2], const pg8::Unit& u, int wr, int wc, int fr, int fq) const {
        const int row0 = u.pm * 256 + wr * 64 + fr;
        int tk[8]; float gts[8], sq[8];
#pragma unroll
        for (int i = 0; i < 8; ++i) { const int slot = row0 + (i >> 2) * 128 + (i & 3) * 16; tk[i] = slot_tok[slot]; gts[i] = slot_gate[slot]; }
#pragma unroll
        for (int i = 0; i < 8; ++i) sq[i] = sumsq2[tk[i]];
#pragma unroll
        for (int ai = 0; ai < 2; ++ai)
#pragma unroll
            for (int m = 0; m < 4; ++m) { const int slot = row0 + ai * 128 + m * 16; const float gt = gts[ai * 4 + m];
                const float rs = 1.0f / sqrtf(sq[ai * 4 + m] * (1.f / 1024.f) + 1e-6f);
                f32x4 h0, h1;
                { const f32x4 a = acc[ai][0][m][0] * rs, b = acc[ai][1][m][0] * (rs * gt * 8.0f); h0.x = silu_f(a.x) * b.x; h0.y = silu_f(a.y) * b.y; h0.z = silu_f(a.z) * b.z; h0.w = silu_f(a.w) * b.w; }
                { const f32x4 a = acc[ai][0][m][1] * rs, b = acc[ai][1][m][1] * (rs * gt * 8.0f); h1.x = silu_f(a.x) * b.x; h1.y = silu_f(a.y) * b.y; h1.z = silu_f(a.z) * b.z; h1.w = silu_f(a.w) * b.w; }
                int q0 = 0, q1 = 0; q0 = __builtin_amdgcn_cvt_pk_fp8_f32(h0.x, h0.y, q0, false); q0 = __builtin_amdgcn_cvt_pk_fp8_f32(h0.z, h0.w, q0, true);
                q1 = __builtin_amdgcn_cvt_pk_fp8_f32(h1.x, h1.y, q1, false); q1 = __builtin_amdgcn_cvt_pk_fp8_f32(h1.z, h1.w, q1, true);
                *(u32x2*)(H + (size_t)slot * FF + u.pn * 128 + wc * 32 + 8 * fq) = (u32x2){(unsigned)q0, (unsigned)q1}; }
    }
};
struct EpiMoe2 {
    static constexpr bool PERM = true;
    unsigned char* Y;
    __device__ __forceinline__ void operator()(const f32x4 (&acc)[2][2][4][2], const pg8::Unit& u, int wr, int wc, int fr, int fq) const {
        const int row0 = u.pm * 256 + wr * 64 + fr, col0 = u.pn * 256 + wc * 32 + 8 * fq;
#pragma unroll
        for (int ai = 0; ai < 2; ++ai)
#pragma unroll
            for (int m = 0; m < 4; ++m) { unsigned char* rowp = Y + (size_t)(row0 + ai * 128 + m * 16) * DM + col0;
#pragma unroll
                for (int bj = 0; bj < 2; ++bj) { const f32x4 v0 = acc[ai][bj][m][0] * 16.0f, v1 = acc[ai][bj][m][1] * 16.0f;
                    int q0 = 0, q1 = 0; q0 = __builtin_amdgcn_cvt_pk_fp8_f32(v0.x, v0.y, q0, false); q0 = __builtin_amdgcn_cvt_pk_fp8_f32(v0.z, v0.w, q0, true);
                    q1 = __builtin_amdgcn_cvt_pk_fp8_f32(v1.x, v1.y, q1, false); q1 = __builtin_amdgcn_cvt_pk_fp8_f32(v1.z, v1.w, q1, true);
                    *(u32x2*)(rowp + 128 * bj) = (u32x2){(unsigned)q0, (unsigned)q1}; } }
    }
};
__device__ __forceinline__ void p13_combine(Frame& F, float* outp) {
    const int lane = F.lane;
    const int gw = F.vcu * NWAVES + F.wave, NGW = F.G * NWAVES;
    const unsigned char* Y = (const unsigned char*)(F.ws + WS_Y); const int* ts = (const int*)(F.ws + WS_TOKSLOT);
    typedef float f32x2v __attribute__((ext_vector_type(2)));
    for (int tok0 = gw; tok0 < NT; tok0 += 4 * NGW) {
        int s0[4], s1[4];
#pragma unroll
        for (int t = 0; t < 4; ++t) { const int tok = tok0 + t * NGW; s0[t] = ts[tok * 2]; s1[t] = ts[tok * 2 + 1]; }
        const int c = lane * 16;
        u32x4 y0[4], y1[4], xa[4], xc[4];
#pragma unroll
        for (int t = 0; t < 4; ++t) { const int tok = tok0 + t * NGW; const bf16_t* xb = (const bf16_t*)(F.ws + WS_X2B) + (size_t)tok * DM;
            y0[t] = *(const u32x4*)(Y + (size_t)s0[t] * DM + c); y1[t] = *(const u32x4*)(Y + (size_t)s1[t] * DM + c); xa[t] = *(const u32x4*)(xb + c); xc[t] = *(const u32x4*)(xb + c + 8); }
#pragma unroll
        for (int t = 0; t < 4; ++t) { const int tok = tok0 + t * NGW; float* od = outp + (size_t)tok * DM;
            const unsigned yw0[4] = {y0[t].x, y0[t].y, y0[t].z, y0[t].w}, yw1[4] = {y1[t].x, y1[t].y, y1[t].z, y1[t].w};
            const unsigned xw[8] = {xa[t].x, xa[t].y, xa[t].z, xa[t].w, xc[t].x, xc[t].y, xc[t].z, xc[t].w};
#pragma unroll
            for (int j = 0; j < 4; ++j) {
                const f32x2v a0 = __builtin_amdgcn_cvt_pk_f32_fp8((int)yw0[j], false), a1 = __builtin_amdgcn_cvt_pk_f32_fp8((int)yw0[j], true);
                const f32x2v b0 = __builtin_amdgcn_cvt_pk_f32_fp8((int)yw1[j], false), b1 = __builtin_amdgcn_cvt_pk_f32_fp8((int)yw1[j], true);
                f32x4 o; o.x = bflo(xw[2 * j]) + (a0.x + b0.x) * 0.0625f; o.y = bfhi(xw[2 * j]) + (a0.y + b0.y) * 0.0625f;
                o.z = bflo(xw[2 * j + 1]) + (a1.x + b1.x) * 0.0625f; o.w = bfhi(xw[2 * j + 1]) + (a1.y + b1.y) * 0.0625f;
                *(f32x4*)(od + c + 4 * j) = o; } }
    }
}

constexpr int CW_DBG = 1024;
__device__ __forceinline__ void dbg_report(Frame& F, float got, float ref, float atol, float rtol) {
    const float err = fabsf(got - ref), tol = atol + rtol * fabsf(ref);
    unsigned code = 0;
    if (!(err <= tol)) { code = 1; if (!(err <= 3.f * tol)) code = 2; if (!(err <= 10.f * tol)) code = 3; if (!(err <= 100.f * tol)) code = 4; if (!(err == err)) code = 5; }
    if (code) atomicMax((unsigned*)(F.ws + WS_CTL) + CW_DBG, code);
}
__device__ __forceinline__ void dbg_finish(Frame& F, const XcdBarrier& xb) {
    xcd_barrier(xb);
    const unsigned code = __hip_atomic_load((unsigned*)(F.ws + WS_CTL) + CW_DBG, __ATOMIC_RELAXED, __HIP_MEMORY_SCOPE_AGENT);
    const float c = 1.0f - 0.2f * (float)code;
    const size_t gt = (size_t)blockIdx.x * NTHR + F.tid, NGT = (size_t)F.G * NTHR;
    for (size_t i = gt; i < (size_t)NT * DM; i += NGT) F.p->out[i] = F.p->in[IN_X][i] * c;
}
__device__ __forceinline__ void dbg_check_inproj(Frame& F, int s) {
    const Params& P = *F.p; const int lane = F.lane;
    const int row = (int)(((long)s * 7919 + 13) % NT), col = (int)(((long)s * 104729 + 7) % 3072);
    const float* x = P.in[IN_X] + (size_t)row * DM; const float* nw = P.in[IN_NORM_MIX]; const float* W = P.in[IN_W_IN];
    float ss = 0.f; for (int k = lane; k < DM; k += 64) ss += x[k] * x[k];
    const float rstd = 1.0f / sqrtf(wave_sum(ss) * (1.f / 1024.f) + 1e-6f);
    if (col < 1024) {
        const int hb = col & ~63; float v[64];
#pragma unroll
        for (int d = 0; d < 64; ++d) v[d] = 0.f;
        for (int k = lane; k < DM; k += 64) { const float h = x[k] * rstd * nw[k];
#pragma unroll
            for (int d = 0; d < 64; ++d) v[d] += h * W[(size_t)k * 3072 + hb + d]; }
        float q = 0.f, mine = 0.f;
#pragma unroll
        for (int d = 0; d < 64; ++d) { v[d] = wave_sum(v[d]); q += v[d] * v[d]; if (d == (col & 63)) mine = v[d]; }
        const float* hn = col < 512 ? P.in[IN_AQN] : P.in[IN_AKN];
        const float ref = mine / sqrtf(q * (1.f / 64.f) + 1e-6f) * hn[col & 63] * (col < 512 ? 0.125f : 1.f);
        const bf16_t* t = (const bf16_t*)(F.ws + (col < 512 ? WS_AQ : WS_AK));
        const float got = bf2f(t[(size_t)row * 512 + (col & 511)]);
        if (lane == 0) dbg_report(F, got, ref, 0.01f, 0.02f);
    } else {
        float d = 0.f; for (int k = lane; k < DM; k += 64) d += x[k] * rstd * nw[k] * W[(size_t)k * 3072 + col];
        d = wave_sum(d); float ref = d; const bf16_t* t; int ld, c;
        if (col < 1536) { t = (const bf16_t*)(F.ws + WS_AV); ld = 512; c = col - 1024; }
        else if (col < 1792) { t = (const bf16_t*)(F.ws + WS_RQ); ld = 256; c = col - 1536; }
        else if (col < 2048) { t = (const bf16_t*)(F.ws + WS_RK); ld = 256; c = col - 1792; ref = d * 0.125f; }
        else if (col < 2560) { t = (const bf16_t*)(F.ws + WS_RV); ld = 512; c = col - 2048; }
        else { t = (const bf16_t*)(F.ws + WS_RG); ld = 512; c = col - 2560; ref = d / (1.f + expf(-d)); }
        const float got = bf2f(t[(size_t)row * ld + c]);
        if (lane == 0) dbg_report(F, got, ref, 0.02f, 0.02f);
    }
}


__device__ __forceinline__ void dbg_check_attn(Frame& F, int s) {
    const int lane = F.lane;
    const int b = s & 1, h = (s >> 1) & 7; int t = (int)(((long)s * 7919 + 5) % SEQ); if ((s & 63) == 0) t = (s >> 6) % 70; if ((s & 63) == 1) t = SEQ - 1 - ((s >> 6) % 70);
    const bf16_t* Q = (const bf16_t*)(F.ws + WS_AQ) + (size_t)b * SEQ * 512 + h * 64;
    const bf16_t* K = (const bf16_t*)(F.ws + WS_AK) + (size_t)b * SEQ * 512 + h * 64;
    const bf16_t* V = (const bf16_t*)(F.ws + WS_AV) + (size_t)b * SEQ * 512 + h * 64;
    const float slope = exp2f(-(float)(h + 1));
    float oacc[3], lse[3];
    const int dils[3] = {1, 4, 16};
    for (int pi = 0; pi < 3; ++pi) {
        const int d = dils[pi], r = t % d, jq = t / d, L = SEQ / d;
        float sc[3]; float mx = -1e30f;
        for (int kk = 0; kk < 3; ++kk) { const int dl = -64 + lane + 64 * kk; const int jk = jq + dl; float v = -1e30f;
            if (dl <= 64 && jk >= 0 && jk < L) { const bf16_t* kr = K + (size_t)(r + d * jk) * 512; float a = 0.f; for (int c = 0; c < 64; ++c) a += bf2f(Q[(size_t)t * 512 + c]) * bf2f(kr[c]);
                v = a - slope * (float)(d * (dl < 0 ? -dl : dl)); }
            sc[kk] = v; mx = fmaxf(mx, v); }
#pragma unroll
        for (int o = 1; o < 64; o <<= 1) mx = fmaxf(mx, __shfl_xor(mx, o));
        float den = 0.f, pk[3];
        for (int kk = 0; kk < 3; ++kk) { pk[kk] = sc[kk] > -1e29f ? expf(sc[kk] - mx) : 0.f; den += pk[kk]; }
        den = wave_sum(den);
        float o = 0.f;
        for (int kk = 0; kk < 3; ++kk) for (int l2 = 0; l2 < 64; ++l2) { const float pp = __shfl(pk[kk], l2); const int dl = -64 + l2 + 64 * kk; const int jk = jq + dl;
            if (pp != 0.f) o += pp * bf2f(V[(size_t)(r + d * jk) * 512 + lane]); }
        oacc[pi] = o / den; lse[pi] = mx + logf(den);
    }
    const float ml = fmaxf(lse[0], fmaxf(lse[1], lse[2]));
    const float w0 = expf(lse[0] - ml), w1 = expf(lse[1] - ml), w2 = expf(lse[2] - ml);
    const float ref = (w0 * oacc[0] + w1 * oacc[1] + w2 * oacc[2]) / (w0 + w1 + w2);
    const float got = bf2f(((const bf16_t*)(F.ws + WS_MIX))[((size_t)b * SEQ + t) * 1024 + h * 64 + lane]);
    dbg_report(F, got, ref, 0.004f, 0.02f);
}
__device__ __forceinline__ void dbg_check_ret(Frame& F, int s) {
    const Params& P = *F.p; const int lane = F.lane;
    const int b = s & 1, h = (s >> 1) & 3; int t = (int)(((long)s * 7919 + 5) % SEQ); if ((s & 31) == 0) t = (s >> 5) % 200; if ((s & 31) == 1) t = SEQ - 1 - ((s >> 5) % 200);
    const bf16_t* Q = (const bf16_t*)(F.ws + WS_RQ) + (size_t)b * SEQ * 256 + h * 64;
    const bf16_t* K = (const bf16_t*)(F.ws + WS_RK) + (size_t)b * SEQ * 256 + h * 64;
    const bf16_t* V = (const bf16_t*)(F.ws + WS_RV) + (size_t)b * SEQ * 512 + h * 128;
    const float lgf = -logf(1.f + expf(-P.in[IN_DECF][h])), lgb = -logf(1.f + expf(-P.in[IN_DECB][h]));
    float y0 = 0.f, y1 = 0.f;
    const float qv = bf2f(Q[(size_t)t * 256 + lane]);
    for (int j = 0; j < SEQ; ++j) {
        const int df = t - j; const float lg = (df >= 0 ? lgf * (float)df : lgb * (float)(-df)); if (lg < -40.f) continue;
        float a = qv * bf2f(K[(size_t)j * 256 + lane]); a = wave_sum(a);
        const float wgt = a * expf(lg);
        y0 += wgt * bf2f(V[(size_t)j * 512 + lane]); y1 += wgt * bf2f(V[(size_t)j * 512 + 64 + lane]);
    }
    const float mu = wave_sum(y0 + y1) * (1.f / 128.f); const float d0 = y0 - mu, d1 = y1 - mu;
    const float var = wave_sum(d0 * d0 + d1 * d1) * (1.f / 128.f); const float rstd = 1.f / sqrtf(var + 1e-5f);
    const bf16_t* G = (const bf16_t*)(F.ws + WS_RG) + ((size_t)b * SEQ + t) * 512 + h * 128;
    const float r0 = d0 * rstd * P.in[IN_GNW][h * 128 + lane] * bf2f(G[lane]), r1 = d1 * rstd * P.in[IN_GNW][h * 128 + 64 + lane] * bf2f(G[64 + lane]);
    const bf16_t* M = (const bf16_t*)(F.ws + WS_MIX) + ((size_t)b * SEQ + t) * 1024 + 512 + h * 128;
    dbg_report(F, bf2f(M[lane]), r0, 0.02f, 0.03f); dbg_report(F, bf2f(M[64 + lane]), r1, 0.02f, 0.03f);
}
__device__ __forceinline__ void dbg_check_outproj(Frame& F, int s) {
    const Params& P = *F.p; const int lane = F.lane;
    const int row = (int)(((long)s * 7919 + 13) % NT), col = (int)(((long)s * 104729 + 7) % 1024);
    const bf16_t* M = (const bf16_t*)(F.ws + WS_MIX) + (size_t)row * 1024;
    float d = 0.f; for (int k = lane; k < 1024; k += 64) d += bf2f(M[k]) * P.in[IN_W_OUT][(size_t)k * 1024 + col];
    d = wave_sum(d) + P.in[IN_X][(size_t)row * 1024 + col];
    if (lane == 0) { dbg_report(F, P.out[(size_t)row * 1024 + col], d, 0.01f, 0.01f);
        dbg_report(F, bf2f(((const bf16_t*)(F.ws + WS_X1B))[(size_t)row * 1024 + col]), d, 0.02f, 0.01f); }
    if (s < 256) { float ss = 0.f; for (int k = lane; k < 1024; k += 64) { const float v = P.out[(size_t)row * 1024 + k]; ss += v * v; } ss = wave_sum(ss);
        if (lane == 0) dbg_report(F, ((const float*)(F.ws + WS_SUMSQ1))[row], ss, 0.5f, 0.01f); }
}


__device__ __forceinline__ void dbg_check_memattn(Frame& F, int s, LAS float* scr  ) {
    const Params& P = *F.p; const int lane = F.lane;
    const int tok = (int)(((long)s * 7919 + 13) % NT), head = s & 3, b = tok / SEQ;
    const float* x1 = P.out + (size_t)tok * DM;
    float ss = 0.f; for (int k = lane; k < DM; k += 64) ss += x1[k] * x1[k];
    const float rstd = 1.0f / sqrtf(wave_sum(ss) * (1.f / 1024.f) + 1e-6f);
    float q[4] = {0.f, 0.f, 0.f, 0.f};
    for (int k = 0; k < DM; ++k) { const float hk = x1[k] * rstd * P.in[IN_NORM_MEM][k];
#pragma unroll
        for (int i = 0; i < 4; ++i) q[i] += hk * P.in[IN_W_MQ][(size_t)k * 1024 + head * 256 + lane + 64 * i]; }
    float qs = 0.f;
#pragma unroll
    for (int i = 0; i < 4; ++i) qs += q[i] * q[i];
    const float qr = 1.0f / sqrtf(wave_sum(qs) * (1.f / 256.f) + 1e-6f);
#pragma unroll
    for (int i = 0; i < 4; ++i) scr[lane + 64 * i] = q[i] * qr * P.in[IN_MQN][lane + 64 * i] * 0.0625f;
    LDS_WAIT();
    float sc[4]; const bf16_t* mh = (const bf16_t*)(F.ws + WS_MEMH);
    float kd[4];
    for (int i = 0; i < 4; ++i) { const int key = lane + 64 * i; const bf16_t* mr = mh + (size_t)(b * 256 + key) * 1024; float dot = 0.f, kss = 0.f;
        for (int d = 0; d < 256; ++d) { float kv = 0.f; for (int k = 0; k < DM; ++k) kv += bf2f(mr[k]) * P.in[IN_W_MKV][(size_t)k * 2048 + head * 256 + d];
            kss += kv * kv; dot += kv * P.in[IN_MKN][d] * scr[d]; }
        sc[i] = dot / sqrtf(kss * (1.f / 256.f) + 1e-6f); kd[i] = 0.f; }
    float mx = fmaxf(fmaxf(sc[0], sc[1]), fmaxf(sc[2], sc[3]));
#pragma unroll
    for (int o = 1; o < 64; o <<= 1) mx = fmaxf(mx, __shfl_xor(mx, o));
    float den = 0.f; for (int i = 0; i < 4; ++i) { sc[i] = expf(sc[i] - mx); den += sc[i]; }
    den = wave_sum(den);
    for (int i = 0; i < 4; ++i) scr[1024 + lane + 64 * i] = sc[i] / den;
    LDS_WAIT();
    float o = 0.f;
    for (int key = 0; key < 256; ++key) { const bf16_t* mr = mh + (size_t)(b * 256 + key) * 1024; float vv = 0.f; for (int k = 0; k < DM; ++k) vv += bf2f(mr[k]) * P.in[IN_W_MKV][(size_t)k * 2048 + 1024 + head * 256 + lane]; o += scr[1024 + key] * vv; }
    const float got = bf2f(((const bf16_t*)(F.ws + WS_OM))[(size_t)tok * DM + head * 256 + lane]);
    dbg_report(F, got, o, 0.004f, 0.03f);
    (void)kd;
}


__device__ __forceinline__ void dbg_check_memkv(Frame& F, int s) {
    const Params& P = *F.p; const int lane = F.lane;
    const int b = s & 1, head = (s >> 1) & 3, key = (s * 37 + 11) & 255;
    const bf16_t* mr = (const bf16_t*)(F.ws + WS_MEMH) + (size_t)(b * 256 + key) * 1024;
    float kv[4], vv[4], kss = 0.f;
    for (int i = 0; i < 4; ++i) { const int d = lane + 64 * i; float a = 0.f, c = 0.f; for (int k = 0; k < DM; ++k) { const float m = bf2f(mr[k]); a += m * P.in[IN_W_MKV][(size_t)k * 2048 + head * 256 + d]; c += m * P.in[IN_W_MKV][(size_t)k * 2048 + 1024 + head * 256 + d]; }
        kv[i] = a; vv[i] = c; kss += a * a; }
    const float kr = 1.0f / sqrtf(wave_sum(kss) * (1.f / 256.f) + 1e-6f);
    for (int i = 0; i < 4; ++i) { const int d = lane + 64 * i;
        const float refk = kv[i] * kr * P.in[IN_MKN][d] * P.in[IN_MQN][d] * 0.0625f;
        dbg_report(F, bf2f(((const bf16_t*)(F.ws + WS_MK))[((size_t)(b * 4 + head) * 256 + key) * 256 + d]), refk, 0.002f, 0.02f);
        dbg_report(F, bf2f(((const bf16_t*)(F.ws + WS_MVT))[((size_t)(b * 4 + head) * 256 + d) * 256 + key]), vv[i], 0.02f, 0.02f); }
}
__device__ __forceinline__ void dbg_check_memq(Frame& F, int s) {
    const Params& P = *F.p; const int lane = F.lane;
    const int tok = (int)(((long)s * 7919 + 13) % NT), head = s & 3;
    const float* x1 = P.out + (size_t)tok * DM;
    float ss = 0.f; for (int k = lane; k < DM; k += 64) ss += x1[k] * x1[k];
    const float rstd = 1.0f / sqrtf(wave_sum(ss) * (1.f / 1024.f) + 1e-6f);
    float q[4] = {0.f, 0.f, 0.f, 0.f};
    for (int k = 0; k < DM; ++k) { const float hk = x1[k] * rstd * P.in[IN_NORM_MEM][k];
#pragma unroll
        for (int i = 0; i < 4; ++i) q[i] += hk * P.in[IN_W_MQ][(size_t)k * 1024 + head * 256 + lane + 64 * i]; }
    float qs = 0.f;
#pragma unroll
    for (int i = 0; i < 4; ++i) { qs += q[i] * q[i]; dbg_report(F, bf2f(((const bf16_t*)(F.ws + WS_QM))[(size_t)tok * DM + head * 256 + lane + 64 * i]), q[i], 0.02f, 0.02f); }
    qs = wave_sum(qs);
    dbg_report(F, ((const float*)(F.ws + WS_HSQ))[(size_t)tok * 4 + head], qs, 1.0f, 0.02f);
}
__device__ __forceinline__ void dbg_check_memo(Frame& F, int s, LAS float* scr) {
    const int lane = F.lane;
    const int tok = (int)(((long)s * 7919 + 13) % NT), head = s & 3, b = tok / SEQ;
    const bf16_t* q = (const bf16_t*)(F.ws + WS_QM) + (size_t)tok * DM + head * 256;
    const float hs = 1.0f / sqrtf(((const float*)(F.ws + WS_HSQ))[(size_t)tok * 4 + head] * (1.f / 256.f) + 1e-6f);
    const bf16_t* K = (const bf16_t*)(F.ws + WS_MK) + (size_t)(b * 4 + head) * 65536;
    const bf16_t* Vt = (const bf16_t*)(F.ws + WS_MVT) + (size_t)(b * 4 + head) * 65536;
    float sc[4], mx = -1e30f;
    for (int i = 0; i < 4; ++i) { const int key = lane + 64 * i; float a = 0.f; for (int d = 0; d < 256; ++d) a += bf2f(q[d]) * bf2f(K[(size_t)key * 256 + d]); sc[i] = a * hs; if (DBG_P7 == 4) sc[i] = logf(fmaxf(1e-30f, 1.0f + sc[i])); if (DBG_P7 == 1) sc[i] = 0.f; if (DBG_P7 == 2) sc[i] = logf(sc[i] * sc[i] + 1e-30f); mx = fmaxf(mx, sc[i]); }
#pragma unroll
    for (int o = 1; o < 64; o <<= 1) mx = fmaxf(mx, __shfl_xor(mx, o));
    float den = 0.f; for (int i = 0; i < 4; ++i) { sc[i] = expf(sc[i] - mx); den += sc[i]; }
    den = wave_sum(den);
    for (int i = 0; i < 4; ++i) scr[lane + 64 * i] = sc[i] / den;
    LDS_WAIT();
    for (int i = 0; i < 4; ++i) { const int d = lane + 64 * i; float o = 0.f; for (int key = 0; key < 256; ++key) o += scr[key] * bf2f(Vt[(size_t)d * 256 + key]);
        dbg_report(F, bf2f(((const bf16_t*)(F.ws + WS_OM))[(size_t)tok * DM + head * 256 + d]), o, 0.003f, 0.02f); }
    LDS_WAIT();
}

#ifndef DBG_STAGE
#define DBG_STAGE 99
#endif
__global__ void __launch_bounds__(NTHR, 2) fwd_megakernel(Params prm) {
    extern __shared__ __attribute__((aligned(16))) unsigned char lds_raw[];
    Frame F;
    F.lds = (LAS unsigned char*)lds_raw; F.tid = threadIdx.x; F.lane = F.tid & 63; F.wave = __builtin_amdgcn_readfirstlane(F.tid >> 6);
    F.G = gridDim.x; { const int bx = blockIdx.x; F.vcu = (F.G % 8 == 0) ? (bx % 8) * (F.G / 8) + bx / 8 : bx; }
    F.p = &prm; F.ws = prm.ws;
    if (F.tid < 16) ((LAS unsigned*)(F.lds + LDS_MISC_OFF))[F.tid] = 0u;
    __syncthreads();
    XcdBarrier xbar = xcd_barrier_post((unsigned*)(F.ws + WS_CTL) + CW_BAR, (volatile LAS unsigned*)(F.lds + LDS_MISC_OFF));
#define REFRESH() do { int t_ = threadIdx.x; asm volatile("" : "+v"(t_)); F.tid = t_; F.lane = t_ & 63; F.wave = __builtin_amdgcn_readfirstlane(t_ >> 6); } while (0)
#define GRID_BAR() do { xcd_barrier(xbar); REFRESH(); } while (0)

    p0_prologue<0>(F);
#if REP & 1
    p0_prologue<0>(F);
#endif
    GRID_BAR();
    {
        pg8::DenseOrder S; S.init(prm.out, F.ws + WS_WIN, NT, 3072, 1024, F.G, (int)blockIdx.x);
        EpiInProj E{F.ws, prm.in[IN_AQN], prm.in[IN_AKN]};
        if (F.vcu & 1) { p0_prologue<1>(F); __syncthreads(); }
        pg8::gemm_phase(F.lds, 1024, S, E);
        if (!(F.vcu & 1)) { __syncthreads(); p0_prologue<1>(F); }
#if REP & 256
        pg8::gemm_phase(F.lds, 1024, S, E);
#endif
    }
    GRID_BAR();
#if DBG_STAGE == 1
    {
        const int gw = blockIdx.x * NWAVES + F.wave, NGW = F.G * NWAVES;
        for (int s = gw; s < 4096; s += NGW) dbg_check_inproj(F, s);
        dbg_finish(F, xbar);
        return;
    }
#endif
    p2_attention<0>(F, (bf16_t*)(F.ws + WS_MIX));
    __syncthreads();
#if REP & 2
    p2_attention<ATT_VAR>(F, (bf16_t*)(F.ws + WS_ST));
    __syncthreads();
#endif
    p2_chunk_kv(F);
#if REP & 4
    p2_chunk_kv(F);
#endif
    GRID_BAR();
    memkv_item(F, F.vcu);
#if REP & 1024
    memkv_item(F, F.vcu);
#endif
    p3_scan(F);
#if REP & 8
    p3_scan(F);
#endif
    GRID_BAR();
    p4_retention_out(F);
#if REP & 16
    p4_retention_out(F);
#endif
    GRID_BAR();
#if DBG_STAGE == 2 || DBG_STAGE == 3
    {
        const int gw = blockIdx.x * NWAVES + F.wave, NGW = F.G * NWAVES;
        if (DBG_STAGE == 2) for (int s = gw; s < 8192; s += NGW) dbg_check_attn(F, s);
        if (DBG_STAGE == 3) for (int s = gw; s < 2048; s += NGW) dbg_check_ret(F, s);
        dbg_finish(F, xbar);
        return;
    }
#endif
    {
        pg8::DenseOrder S; S.init(F.ws + WS_MIX, F.ws + WS_WOUT, NT, 1024, 1024, F.G, (int)blockIdx.x, GEMM_WGM);
        EpiResidHL<true> E{prm.in[IN_NORM_MIX], (const bf16_t*)prm.out, (const float*)(F.ws + WS_RSTD0), (bf16_t*)(F.ws + WS_X1B), (bf16_t*)(F.ws + WS_X1L), (float*)(F.ws + WS_SUMSQ1), nullptr};
        pg8::gemm_phase(F.lds, 1024, S, E);
#if REP & 16384
        { EpiNull E3{(float*)(F.ws + WS_CTL + MiB)}; pg8::gemm_phase(F.lds, 1024, S, E3); }
#endif
#if REP & 512
        { EpiResidHL<true> E2{prm.in[IN_NORM_MIX], (const bf16_t*)prm.out, (const float*)(F.ws + WS_RSTD0), (bf16_t*)(F.ws + WS_X1B), (bf16_t*)(F.ws + WS_X1L), (float*)(F.ws + WS_CTL + MiB), nullptr}; pg8::gemm_phase(F.lds, 1024, S, E2); }
#endif
    }
    GRID_BAR();
#if DBG_STAGE == 4
    {
        const int gw = blockIdx.x * NWAVES + F.wave, NGW = F.G * NWAVES;
        for (int s = gw; s < 8192; s += NGW) dbg_check_outproj(F, s);
        dbg_finish(F, xbar);
        return;
    }
#endif
    {
        pg8::DenseOrder S; S.init(F.ws + WS_X1B, F.ws + WS_WMQ, NT, 1024, 1024, F.G, (int)blockIdx.x, GEMM_WGM);
        EpiMemQ E{(bf16_t*)(F.ws + WS_QM), (const float*)(F.ws + WS_SUMSQ1), (float*)(F.ws + WS_HSQ)};
        pg8::gemm_phase(F.lds, 1024, S, E);
#if REP & 8192
        { EpiMemQ E2{(bf16_t*)(F.ws + WS_QM), (const float*)(F.ws + WS_SUMSQ1), (float*)(F.ws + WS_CTL + MiB + 256 * 1024)}; pg8::gemm_phase(F.lds, 1024, S, E2); }
#endif
        asm volatile("s_waitcnt vmcnt(0)" ::: "memory");
        __syncthreads();
        __builtin_amdgcn_fence(__ATOMIC_ACQUIRE, "agent");
        REFRESH();
        p7_mem_attention(F, S);
#if REP & 32
        p7_mem_attention(F, S);
#endif
    }
    GRID_BAR();
#if DBG_STAGE >= 5 && DBG_STAGE <= 8
    {
        const int gw = blockIdx.x * NWAVES + F.wave, NGW = F.G * NWAVES;
        if (DBG_STAGE == 5) for (int s = gw; s < 2048; s += NGW) dbg_check_memattn(F, s, (LAS float*)(F.lds + F.wave * 8192));
        if (DBG_STAGE == 6) for (int s = gw; s < 2048; s += NGW) dbg_check_memkv(F, s);
        if (DBG_STAGE == 7) for (int s = gw; s < 2048; s += NGW) dbg_check_memq(F, s);
        if (DBG_STAGE == 8) for (int s = gw; s < 4096; s += NGW) dbg_check_memo(F, s, (LAS float*)(F.lds + F.wave * 8192));
        dbg_finish(F, xbar);
        return;
    }
#endif
    {
        pg8::DenseOrder S; S.init(F.ws + WS_OM, F.ws + WS_WMO, NT, 1024, 1024, F.G, (int)blockIdx.x, GEMM_WGM);
        EpiResidHL<false> E{nullptr, (const bf16_t*)(F.ws + WS_X1B), nullptr, (bf16_t*)(F.ws + WS_X2B), (bf16_t*)(F.ws + WS_X2L), (float*)(F.ws + WS_SUMSQ2), (unsigned char*)(F.ws + WS_X2Q)};
        pg8::gemm_phase(F.lds, 1024, S, E);
    }
    GRID_BAR();
#if DBG_STAGE == 9
    return;
#endif
    p9_route(F, (unsigned*)(F.ws + WS_CTL) + CW_CNT);
#if REP & 64
    p9_route(F, (unsigned*)(F.ws + WS_CTL) + 3000);
#endif
    GRID_BAR();
    p10_slots(F);
    GRID_BAR();
    {
        const unsigned* cnt = (const unsigned*)(F.ws + WS_CTL) + CW_CNT; int ntiles = 0;
        for (int e = 0; e < 32; ++e) ntiles += (int)((__hip_atomic_load(cnt + e, __ATOMIC_RELAXED, __HIP_MEMORY_SCOPE_AGENT) + 255u) >> 8);
        {
            MoeOrder1 S; S.A = (const char*)(F.ws + WS_X2Q); S.W = (const char*)(F.ws + WS_W13); S.tile_exp = (const int*)(F.ws + WS_TILEEXP); S.slot_tok = (const int*)(F.ws + WS_SLOTTOK);
            S.ntiles = ntiles; S.G = F.G; S.c = F.vcu; S.kb = 512; S.wstride = (size_t)1024 * 1024; S.tstepB = (size_t)256 * 1024; S.tstepA = 0;
            EpiMoe1 E{(unsigned char*)(F.ws + WS_H), (const int*)(F.ws + WS_SLOTTOK), (const float*)(F.ws + WS_SLOTGATE), (const float*)(F.ws + WS_SUMSQ2)};
            pg8::gemm_phase<EpiMoe1, MoeOrder1, true, 127, 122>(F.lds, 512, S, E);
#if REP & 32768
            { EpiNull E3{(float*)prm.out}; pg8::gemm_phase<EpiNull, MoeOrder1, true, 127, 122>(F.lds, 512, S, E3); }
#endif
#if REP & 2048
            pg8::gemm_phase<EpiMoe1, MoeOrder1, true, 127, 122>(F.lds, 512, S, E);
#endif
        }
        GRID_BAR();
        {
            MoeOrder2 S; S.A = (const char*)(F.ws + WS_H); S.W = (const char*)(F.ws + WS_W2); S.tile_exp = (const int*)(F.ws + WS_TILEEXP); S.slot_tok = nullptr;
            S.ntiles = ntiles; S.G = F.G; S.c = F.vcu; S.kb = 256; S.wstride = (size_t)1024 * 512; S.tstepB = (size_t)256 * 512; S.tstepA = (size_t)256 * 512;
            EpiMoe2 E{(unsigned char*)(F.ws + WS_Y)};
            pg8::gemm_phase<EpiMoe2, MoeOrder2, true, 124, 123>(F.lds, 256, S, E);
#if REP & 65536
            { EpiNull E3{(float*)prm.out}; pg8::gemm_phase<EpiNull, MoeOrder2, true, 124, 123>(F.lds, 256, S, E3); }
#endif
#if REP & 4096
            pg8::gemm_phase<EpiMoe2, MoeOrder2, true, 124, 123>(F.lds, 256, S, E);
#endif
        }
        GRID_BAR();
    }
#if REP & 128
    p13_combine(F, (float*)(F.ws + WS_H));
#endif
    p13_combine(F, prm.out);
}

extern "C" void kernel_launch(void* const* d_in, const int* in_sizes, int n_in, void* d_out, int out_size, void* d_ws, size_t ws_size, hipStream_t stream) {
    static int grid = 0;
    if (grid == 0) {
        if (n_in != 23 || out_size != NT * DM || ws_size < WS_END) { fprintf(stderr, "kernel_launch: unexpected shapes (n_in %d out %d ws %zu)\n", n_in, out_size, ws_size); grid = -1; return; }
        int dev = 0, cus = 0, per_cu = 0;
        hipGetDevice(&dev); hipDeviceGetAttribute(&cus, hipDeviceAttributeMultiprocessorCount, dev);
        if (hipFuncSetAttribute((const void*)fwd_megakernel, hipFuncAttributeMaxDynamicSharedMemorySize, LDS_BYTES) != hipSuccess) { fprintf(stderr, "hipFuncSetAttribute failed\n"); grid = -1; return; }
        if (hipOccupancyMaxActiveBlocksPerMultiprocessor(&per_cu, (const void*)fwd_megakernel, NTHR, LDS_BYTES) != hipSuccess || per_cu < 1) { fprintf(stderr, "occupancy query: %d\n", per_cu); grid = -1; return; }
        if (cus < 256) { fprintf(stderr, "kernel_launch: this kernel is laid out for a 256-CU device (got %d)\n", cus); grid = -1; return; }
        grid = 256;
        fprintf(stderr, "kernel_launch: grid %d (cus %d, per_cu %d)\n", grid, cus, per_cu);
    }
    if (grid < 0) return;
    hipMemsetAsync((char*)d_ws + WS_CTL, 0, CTL_ZERO_BYTES, stream);
    Params p{};
    for (int i = 0; i < 23; ++i) p.in[i] = (const float*)d_in[i];
    p.out = (float*)d_out; p.ws = (unsigned char*)d_ws;
    hipLaunchKernelGGL(fwd_megakernel, dim3(grid), dim3(NTHR), LDS_BYTES, stream, p);
    hipError_t e = hipPeekAtLastError();
    if (e != hipSuccess) fprintf(stderr, "launch failed: %s (grid %d)\n", hipGetErrorString(e), grid);
}
```

```cpp
#include <hip/hip_runtime.h>
#include <hip/hip_cooperative_groups.h>
#include <cstdio>
#include <cstdint>
namespace cg = cooperative_groups;
#ifndef ATT_VAR
#define ATT_VAR 0
#endif
#ifndef GEMM_WGM
#define GEMM_WGM 4
#endif
#ifndef REP
#define REP 0
#endif
#ifndef DBG_P7
#define DBG_P7 0
#endif

#define LAS __attribute__((address_space(3)))
#define GAS __attribute__((address_space(1)))
typedef unsigned short bf16_t;
typedef short bf16x8 __attribute__((ext_vector_type(8)));
typedef short bf16x4 __attribute__((ext_vector_type(4)));
typedef float f32x4 __attribute__((ext_vector_type(4)));
typedef float f32x2 __attribute__((ext_vector_type(2)));
typedef unsigned u32x4 __attribute__((ext_vector_type(4)));
typedef unsigned u32x2 __attribute__((ext_vector_type(2)));

constexpr int NB = 2, SEQ = 16384, NT = NB * SEQ, DM = 1024;
constexpr int NMEM = 256;
constexpr int NEXP = 32, FF = 512;
constexpr int NWAVES = 8, NTHR = 512;
constexpr int MAX_TILES = 288, MAX_SLOTS = MAX_TILES * 256;

constexpr size_t MiB = 1u << 20;
constexpr size_t WS_CTL = 0, CTL_ZERO_BYTES = 64 * 1024;
constexpr size_t WS_SUMSQ1 = 64 * 1024, WS_SUMSQ2 = 192 * 1024, WS_HSQ = 320 * 1024;
constexpr int CW_CNT = 2048, CW_FILL = 2048 + 64, CW_NTILES = 2048 + 128;
constexpr size_t WS_WIN = 2 * MiB, WS_WOUT = 8 * MiB, WS_WMQ = 10 * MiB, WS_WMKV = 12 * MiB, WS_WMO = 16 * MiB, WS_W13 = 18 * MiB, WS_W2 = 82 * MiB;
constexpr size_t WS_MEMH = 114 * MiB, WS_MK = 115 * MiB, WS_MVT = 116 * MiB, WS_ROUTE = 117 * MiB, WS_SLOTTOK = 118 * MiB, WS_SLOTGATE = 118 * MiB + 512 * 1024, WS_TILEEXP = 119 * MiB;
constexpr size_t WS_AQ = 128 * MiB, WS_AK = 160 * MiB, WS_AV = 192 * MiB, WS_RQ = 224 * MiB, WS_RK = 240 * MiB, WS_RV = 256 * MiB, WS_RG = 288 * MiB;
constexpr size_t WS_X1B = 128 * MiB, WS_QM = 192 * MiB, WS_OM = 256 * MiB, WS_Y = 128 * MiB;
constexpr size_t WS_XB = 320 * MiB, WS_MIX = 320 * MiB, WS_X2B = 320 * MiB;
constexpr size_t WS_KV = 384 * MiB, WS_ST = 448 * MiB, WS_H = 384 * MiB;
constexpr size_t WS_WRT = 119 * MiB + 64 * 1024;
constexpr size_t WS_X1L = 384 * MiB, WS_X2L = 192 * MiB;
constexpr size_t WS_RSTD0 = 125 * MiB;
constexpr size_t WS_X2Q = 192 * MiB;
constexpr size_t WS_END = 512 * MiB;

constexpr int LDS_BYTES = 147456;

__device__ __forceinline__ unsigned cvt_pk_bf16(float lo, float hi) { unsigned r; asm volatile("s_nop 0\n\tv_cvt_pk_bf16_f32 %0, %1, %2" : "=v"(r) : "v"(lo), "v"(hi)); return r; }
typedef __bf16 bf16v2_t __attribute__((ext_vector_type(2)));
__device__ __forceinline__ unsigned cvt_pk_bf16_c(float lo, float hi) { f32x2 v = {lo, hi}; bf16v2_t r = __builtin_convertvector(v, bf16v2_t); return __builtin_bit_cast(unsigned, r); }
__device__ __forceinline__ float bf2f(unsigned short b) { return __uint_as_float(((unsigned)b) << 16); }
__device__ __forceinline__ float bflo(unsigned w) { return __uint_as_float(w << 16); }
__device__ __forceinline__ float bfhi(unsigned w) { return __uint_as_float(w & 0xffff0000u); }
__device__ __forceinline__ float xl_dpp_quad1(float v) { return __builtin_bit_cast(float, __builtin_amdgcn_update_dpp(0, __builtin_bit_cast(int, v), 0xB1, 0xF, 0xF, true)); }
__device__ __forceinline__ float xl_dpp_quad2(float v) { return __builtin_bit_cast(float, __builtin_amdgcn_update_dpp(0, __builtin_bit_cast(int, v), 0x4E, 0xF, 0xF, true)); }
__device__ __forceinline__ float xl_dpp_ror4(float v)  { return __builtin_bit_cast(float, __builtin_amdgcn_update_dpp(0, __builtin_bit_cast(int, v), 0x124, 0xF, 0xF, true)); }
__device__ __forceinline__ float xl_dpp_ror8(float v)  { return __builtin_bit_cast(float, __builtin_amdgcn_update_dpp(0, __builtin_bit_cast(int, v), 0x128, 0xF, 0xF, true)); }
__device__ __forceinline__ float xl_swz16(float v)     { return __builtin_bit_cast(float, __builtin_amdgcn_ds_swizzle(__builtin_bit_cast(int, v), 0x401F)); }
__device__ __forceinline__ void xl_swap32(float& a, float& b) { asm volatile("s_nop 1\n\tv_permlane32_swap_b32 %0, %1\n\ts_nop 1" : "+v"(a), "+v"(b)); }
__device__ __forceinline__ float sum_g4(float v) { v += xl_swz16(v); float a = v, b = v; xl_swap32(a, b); return a + b; }
__device__ __forceinline__ float max_g4(float v) { v = fmaxf(v, xl_swz16(v)); float a = v, b = v; xl_swap32(a, b); return fmaxf(a, b); }
__device__ __forceinline__ float sum_row16(float v) { v += xl_dpp_quad1(v); v += xl_dpp_quad2(v); v += xl_dpp_ror4(v); v += xl_dpp_ror8(v); return v; }
__device__ __forceinline__ float max_row16(float v) { v = fmaxf(v, xl_dpp_quad1(v)); v = fmaxf(v, xl_dpp_quad2(v)); v = fmaxf(v, xl_dpp_ror4(v)); v = fmaxf(v, xl_dpp_ror8(v)); return v; }
__device__ __forceinline__ float wave_sum(float v) { return sum_g4(sum_row16(v)); }
__device__ __forceinline__ float wave_max(float v) { return max_g4(max_row16(v)); }
__device__ __forceinline__ float fast_exp(float x) { return __builtin_amdgcn_exp2f(x * 1.44269504089f); }
__device__ __forceinline__ float silu_f(float x) { return x * __builtin_amdgcn_rcpf(1.0f + fast_exp(-x)); }
#define LDS_WAIT() asm volatile("s_waitcnt lgkmcnt(0)" ::: "memory")
#define VM_WAIT() asm volatile("s_waitcnt vmcnt(0)" ::: "memory")

namespace pg8 {
constexpr int BM = 256, BK = 64, HALF = 128, HTB = HALF * BK * 2, STAGE_BYTES = 8 * HTB, NXCD = 8, WGM = 8;
__host__ __device__ __forceinline__ int lds_byte(int r, int c) { const int st = (r >> 4) * 2 + (c >> 5), rr = r & 15, cc = c & 31, ob = rr * 64 + cc * 2; return st * 1024 + (ob ^ (((ob >> 9) & 1) << 5)); }
__host__ __device__ __forceinline__ void stage_rc(int b, int& R, int& C) { const int st = b / 1024, sb = b % 1024, swz = sb ^ (((sb >> 9) & 1) << 5); R = (st >> 1) * 16 + swz / 64; C = (st & 1) * 32 + (swz % 64) / 2; }
__host__ __device__ __forceinline__ int perm32(int rho) { const int n = rho >> 4, i = rho & 15; return 8 * (i >> 2) + 4 * n + (i & 3); }

struct Unit { int pm, pn; const char* A; const char* B; int aux; };

struct DenseOrder {
    static constexpr bool GATHER = false;
    const char* A; const char* Bt; int nM, nN, nwg, G, c, wgm; size_t tstep;
    __device__ void init(const void* A_, const void* Bt_, int M, int N, int K, int G_, int c_, int wgm_ = WGM) { A = (const char*)A_; Bt = (const char*)Bt_; nM = M / BM; nN = N / BM; nwg = nM * nN; G = G_; c = c_; wgm = wgm_; tstep = (size_t)BM * K * 2; }
    __device__ bool next(int i, Unit& u) const {
        const long L = (long)i * G + c; if (L >= nwg) return false;
        int wgid = (int)L; { const int q = nwg / NXCD, r = nwg % NXCD, xcd = wgid % NXCD, off = wgid / NXCD; wgid = (xcd < r ? xcd * (q + 1) : r * (q + 1) + (xcd - r) * q) + off; }
        const int nig = wgm * nN, gid = wgid / nig, fm = gid * wgm, gsz = (nM - fm) < wgm ? (nM - fm) : wgm;
        u.pm = fm + ((wgid % nig) % gsz); u.pn = (wgid % nig) / gsz; u.A = A + (size_t)u.pm * tstep; u.B = Bt + (size_t)u.pn * tstep; u.aux = 0; return true;
    }
    __device__ __forceinline__ void gather(const Unit&, int, int, int, int, unsigned (&)[2][2]) const {}
};

template <class Epi, class Sched, bool FP8 = false, int SCA = 127, int SCB = 127>
__device__ __forceinline__ void gemm_phase(LAS unsigned char* lds, const int K, const Sched& S, const Epi& E) {
    constexpr bool GATHER = Sched::GATHER;
    int tid = threadIdx.x; asm volatile("" : "+v"(tid));
    const int wid = __builtin_amdgcn_readfirstlane(tid >> 6), lane = tid & 63, wr = wid >> 2, wc = wid & 3, fr = lane & 15, fq = lane >> 4;
    const int nt = K / BK;
    unsigned voffA[2], voffB[2]; int sR[2], sC[2];
#pragma unroll
    for (int i = 0; i < 2; ++i) { int R, C; stage_rc(tid * 16 + i * 8192, R, C); const int Rb = Epi::PERM ? ((R & ~31) + perm32(R & 31)) : R;
        sR[i] = R; sC[i] = C; voffA[i] = (unsigned)(R * K + C) * 2u; voffB[i] = (unsigned)(Rb * K + C) * 2u; }
    const size_t kstep = (size_t)(BK * 2);
    const size_t hstep = (size_t)HALF * K * 2;
    const unsigned ldsw = (unsigned)wid * 1024u;
    const int aoff = lds_byte(wr * 64 + fr, fq * 8), boff = lds_byte(wc * 32 + fr, fq * 8);
#define PG8_SA(b, h) (((b) * 2 + (h)) * HTB)
#define PG8_SB(b, h) ((4 + (b) * 2 + (h)) * HTB)
#define PG8_STAGE2(bufoff, gbase, o0, o1) do { \
        __builtin_amdgcn_global_load_lds((const unsigned*)((const char*)(gbase) + (o0)), (LAS unsigned*)(lds + (bufoff) + ldsw), 16, 0, 0); \
        __builtin_amdgcn_global_load_lds((const unsigned*)((const char*)(gbase) + (o1)), (LAS unsigned*)(lds + (bufoff) + ldsw + 8192), 16, 0, 0); } while (0)
#define PG8_STAGE_B(bufoff, gbase) PG8_STAGE2(bufoff, gbase, voffB[0], voffB[1])
#define PG8_STAGE_A(bufoff, gbase, h, VA) PG8_STAGE2(bufoff, (gbase) + (GATHER ? (size_t)0 : (size_t)(h) * hstep), VA[GATHER ? (h) : 0][0], VA[GATHER ? (h) : 0][1])
#define PG8_LDA(dst, b, h) do { _Pragma("unroll") for (int m = 0; m < 4; ++m) _Pragma("unroll") for (int k = 0; k < 2; ++k) dst[m][k] = *(const LAS bf16x8*)(lds + PG8_SA(b, h) + aoff + m * 2048 + k * 1024); } while (0)
#define PG8_LDB(dst, b, h) do { _Pragma("unroll") for (int n = 0; n < 2; ++n) _Pragma("unroll") for (int k = 0; k < 2; ++k) dst[n][k] = *(const LAS bf16x8*)(lds + PG8_SB(b, h) + boff + n * 2048 + k * 1024); } while (0)
#define PG8_MMA(ai, bj, At, Bt) do { __builtin_amdgcn_s_setprio(1); _Pragma("unroll") for (int m = 0; m < 4; ++m) _Pragma("unroll") for (int n = 0; n < 2; ++n) { \
        if constexpr (FP8) { typedef int i32x4_ __attribute__((ext_vector_type(4))); typedef int i32x8_ __attribute__((ext_vector_type(8))); \
            const i32x8_ bq = __builtin_shufflevector(__builtin_bit_cast(i32x4_, Bt[n][0]), __builtin_bit_cast(i32x4_, Bt[n][1]), 0, 1, 2, 3, 4, 5, 6, 7); \
            const i32x8_ aq = __builtin_shufflevector(__builtin_bit_cast(i32x4_, At[m][0]), __builtin_bit_cast(i32x4_, At[m][1]), 0, 1, 2, 3, 4, 5, 6, 7); \
            asm volatile("v_mfma_scale_f32_16x16x128_f8f6f4 %0, %1, %2, %0, %3, %4 op_sel_hi:[0,0,0]" : "+v"(acc[ai][bj][m][n]) : "v"(bq), "v"(aq), "v"(scb_), "v"(sca_)); } \
        else { _Pragma("unroll") for (int k = 0; k < 2; ++k) acc[ai][bj][m][n] = __builtin_amdgcn_mfma_f32_16x16x32_bf16(Bt[n][k], At[m][k], acc[ai][bj][m][n], 0, 0, 0); } } \
        __builtin_amdgcn_s_setprio(0); } while (0)
#define PG8_WAIT_V(n) asm volatile("s_waitcnt vmcnt(" #n ")" ::: "memory")
#define PG8_WAIT_L(n) asm volatile("s_waitcnt lgkmcnt(" #n ")" ::: "memory")
#define PG8_BAR __builtin_amdgcn_s_barrier()
#define PG8_SCHED __builtin_amdgcn_sched_barrier(0)
    Unit cur, nxt; int ui = 0;
    if (!S.next(0, cur)) return;
    f32x4 acc[2][2][4][2];
#pragma unroll
    for (int a = 0; a < 2; ++a)
#pragma unroll
        for (int b = 0; b < 2; ++b)
#pragma unroll
            for (int m = 0; m < 4; ++m)
#pragma unroll
                for (int n = 0; n < 2; ++n) acc[a][b][m][n] = (f32x4){0.f, 0.f, 0.f, 0.f};
    bf16x8 At[4][2], B0[2][2], B1[2][2];
    int sca_ = SCA * 0x01010101, scb_ = SCB * 0x01010101;
    unsigned vAc[2][2], vAn[2][2];
    if constexpr (GATHER) { S.gather(cur, sR[0], sR[1], sC[0], sC[1], vAc); }
    else { vAc[0][0] = voffA[0]; vAc[0][1] = voffA[1]; vAc[1][0] = voffA[0]; vAc[1][1] = voffA[1]; }
#pragma unroll
    for (int h = 0; h < 2; ++h) { vAn[h][0] = vAc[h][0]; vAn[h][1] = vAc[h][1]; }
    const char* cA = cur.A; const char* cB = cur.B;
    PG8_STAGE_B(PG8_SB(0, 0), cB); PG8_STAGE_A(PG8_SA(0, 0), cA, 0, vAc); PG8_STAGE_B(PG8_SB(0, 1), cB + hstep); PG8_STAGE_A(PG8_SA(0, 1), cA, 1, vAc);
    if (wr == 1) PG8_BAR;
    PG8_WAIT_V(4); PG8_BAR;
    PG8_STAGE_B(PG8_SB(1, 0), cB + kstep); PG8_STAGE_A(PG8_SA(1, 0), cA + kstep, 0, vAc); PG8_STAGE_B(PG8_SB(1, 1), cB + hstep + kstep);
    PG8_WAIT_V(6); PG8_BAR;
    for (;;) {
        const bool has_next = S.next(ui + 1, nxt);
        const char* nA = has_next ? nxt.A : cA; const char* nB = has_next ? nxt.B : cB;
        if constexpr (GATHER) { if (has_next) S.gather(nxt, sR[0], sR[1], sC[0], sC[1], vAn); }
        for (int t = 0; t < nt; t += 2) {
            const bool last = (t == nt - 2);
            const char* a1 = cA + (size_t)(t + 1) * kstep;
            const char* a2 = last ? nA : cA + (size_t)(t + 2) * kstep; const char* b2 = last ? nB : cB + (size_t)(t + 2) * kstep;
            const char* a3 = a2 + kstep; const char* b3 = b2 + kstep;
            unsigned vA2[2][2];
#pragma unroll
            for (int h = 0; h < 2; ++h) { vA2[h][0] = (GATHER && last) ? vAn[h][0] : vAc[h][0]; vA2[h][1] = (GATHER && last) ? vAn[h][1] : vAc[h][1]; }
            PG8_LDB(B0, 0, 0); PG8_SCHED; PG8_LDA(At, 0, 0); PG8_STAGE_A(PG8_SA(1, 1), a1, 1, vAc);
            PG8_WAIT_L(8); PG8_BAR; PG8_WAIT_L(0); PG8_MMA(0, 0, At, B0); PG8_BAR; PG8_SCHED;
            PG8_LDB(B1, 0, 1); PG8_STAGE_B(PG8_SB(0, 0), b2);
            PG8_BAR; PG8_WAIT_L(0); PG8_MMA(0, 1, At, B1); PG8_BAR;
            PG8_LDA(At, 0, 1); PG8_STAGE_A(PG8_SA(0, 0), a2, 0, vA2);
            PG8_BAR; PG8_WAIT_L(0); PG8_MMA(1, 0, At, B0); PG8_BAR; PG8_SCHED;
            PG8_STAGE_B(PG8_SB(0, 1), b2 + hstep);
            PG8_WAIT_V(6); PG8_BAR; PG8_MMA(1, 1, At, B1); PG8_BAR;
            PG8_LDB(B0, 1, 0); PG8_SCHED; PG8_LDA(At, 1, 0); PG8_STAGE_A(PG8_SA(0, 1), a2, 1, vA2);
            PG8_WAIT_L(8); PG8_BAR; PG8_WAIT_L(0); PG8_MMA(0, 0, At, B0); PG8_BAR; PG8_SCHED;
            PG8_LDB(B1, 1, 1); PG8_STAGE_B(PG8_SB(1, 0), b3);
            PG8_BAR; PG8_WAIT_L(0); PG8_MMA(0, 1, At, B1); PG8_BAR;
            PG8_LDA(At, 1, 1); PG8_STAGE_A(PG8_SA(1, 0), a3, 0, vA2);
            PG8_BAR; PG8_WAIT_L(0); PG8_MMA(1, 0, At, B0); PG8_BAR; PG8_SCHED;
            PG8_STAGE_B(PG8_SB(1, 1), b3 + hstep);
            PG8_WAIT_V(6); PG8_BAR; PG8_MMA(1, 1, At, B1); PG8_BAR;
        }
        if constexpr (FP8) asm volatile("s_nop 15\n\ts_nop 15" ::: "memory");
        E(acc, cur, wr, wc, fr, fq);
        if (!has_next) break;
#pragma unroll
        for (int a = 0; a < 2; ++a)
#pragma unroll
            for (int b = 0; b < 2; ++b)
#pragma unroll
                for (int m = 0; m < 4; ++m)
#pragma unroll
                    for (int n = 0; n < 2; ++n) acc[a][b][m][n] = (f32x4){0.f, 0.f, 0.f, 0.f};
        cur = nxt; cA = nA; cB = nB; ++ui;
        if constexpr (GATHER) {
#pragma unroll
            for (int h = 0; h < 2; ++h) { vAc[h][0] = vAn[h][0]; vAc[h][1] = vAn[h][1]; }
        }
    }
    PG8_WAIT_V(0);
    if (wr == 0) PG8_BAR;
    PG8_BAR;
#undef PG8_SA
#undef PG8_SB
#undef PG8_STAGE2
#undef PG8_STAGE_A
#undef PG8_STAGE_B
#undef PG8_LDA
#undef PG8_LDB
#undef PG8_MMA
#undef PG8_WAIT_V
#undef PG8_WAIT_L
#undef PG8_BAR
#undef PG8_SCHED
}
}


#define XB_TMO      128
#define XB_XCNT(j)  (256  + 64 * (j))
#define XB_XSUB(j)  (1280 + 64 * (j))
#define XB_XGEN(j)  (2304 + 64 * (j))
#define XB_TOP      3328
#define XB_TOPGEN   3392
#define XCD_BAR_WORDS 3456
#define XB_SPIN_CAP (1u << 20)
constexpr int CW_BAR = 4096;
constexpr int LDS_MISC_OFF = 147456 - 64;
__device__ __forceinline__ unsigned xb_ld(unsigned* p)              { return __hip_atomic_load(p, __ATOMIC_RELAXED, __HIP_MEMORY_SCOPE_AGENT); }
__device__ __forceinline__ unsigned xb_add(unsigned* p, unsigned v) { return __hip_atomic_fetch_add(p, v, __ATOMIC_RELAXED, __HIP_MEMORY_SCOPE_AGENT); }
__device__ __forceinline__ unsigned xb_xcc_id() { return (unsigned)__builtin_amdgcn_s_getreg((3 << 11) | 20) & 0xFu; }
#define XB_SPIN(cond, bar) do { unsigned _sp = 0; while (cond) { __builtin_amdgcn_s_sleep(1); \
    if ((++_sp & 255u) == 0u) { if (xb_ld(&(bar)[XB_TMO])) break; if (_sp > XB_SPIN_CAP) { atomicAdd(&(bar)[XB_TMO], 1u); break; } } } } while (0)
struct XcdBarrier { unsigned* bar; unsigned x; volatile LAS unsigned* st; };
__device__ __forceinline__ XcdBarrier xcd_barrier_post(unsigned* bar, volatile LAS unsigned* st) {
    XcdBarrier b; b.bar = bar; b.x = xb_xcc_id(); b.st = st;
    if (threadIdx.x == 0) (void)xb_add(&bar[XB_XCNT(b.x)], 1u);
    return b;
}
__device__ __forceinline__ void xcd_barrier_complete(unsigned* bar, unsigned x, unsigned& nloc, unsigned& nx) {
    const unsigned G = gridDim.x * gridDim.y * gridDim.z;
    unsigned sum, cnt, mine, sp = 0u;
    for (;;) {
        sum = 0u; cnt = 0u; mine = 0u;
#pragma unroll
        for (unsigned j = 0; j < 16; ++j) { const unsigned c = xb_ld(&bar[XB_XCNT(j)]); sum += c; cnt += (c > 0u) ? 1u : 0u; mine = (j == x) ? c : mine; }
        if (sum == G) break;
        __builtin_amdgcn_s_sleep(1);
        if ((++sp & 255u) == 0u) { if (xb_ld(&bar[XB_TMO])) break; if (sp > XB_SPIN_CAP) { atomicAdd(&bar[XB_TMO], 1u); break; } }
    }
    nloc = mine > 0u ? mine : 1u; nx = cnt > 0u ? cnt : 1u;
}
__device__ __forceinline__ void xcd_barrier(const XcdBarrier& b) {
    asm volatile("s_waitcnt vmcnt(0)" ::: "memory");
    __syncthreads();
    if (threadIdx.x == 0) {
        unsigned* bar = b.bar;
        __builtin_amdgcn_s_waitcnt(0);
        unsigned nloc = b.st[0], nx = b.st[1];
        if (nloc == 0u) { xcd_barrier_complete(bar, b.x, nloc, nx); b.st[0] = nloc; b.st[1] = nx; }
        const unsigned old = xb_add(&bar[XB_XSUB(b.x)], 1u);
        const unsigned gen = old / nloc;
        if (old + 1u == (gen + 1u) * nloc) {
            __builtin_amdgcn_fence(__ATOMIC_RELEASE, "agent");
            asm volatile("s_waitcnt vmcnt(0)" ::: "memory");
            const unsigned og = xb_add(&bar[XB_TOP], 1u);
            const unsigned tg = og / nx;
            if (og + 1u == (tg + 1u) * nx) xb_add(&bar[XB_TOPGEN], 1u);
            else XB_SPIN(xb_ld(&bar[XB_TOPGEN]) == tg, bar);
            __builtin_amdgcn_fence(__ATOMIC_ACQUIRE, "agent");
            xb_add(&bar[XB_XGEN(b.x)], 1u);
            asm volatile("s_waitcnt vmcnt(0)" ::: "memory");
        } else {
            XB_SPIN(xb_ld(&bar[XB_XGEN(b.x)]) == gen, bar);
            __builtin_amdgcn_fence(__ATOMIC_ACQUIRE, "agent");
            asm volatile("s_waitcnt vmcnt(0)" ::: "memory");
        }
    }
    __syncthreads();
}

struct Params {
    const float* in[23];
    float* out; unsigned char* ws;
};
struct Frame {
    LAS unsigned char* lds; int tid, lane, wave, vcu, G;
    const Params* p; unsigned char* ws;
};
#define IN_X 0
#define IN_MEM 1
#define IN_NORM_MIX 2
#define IN_W_IN 3
#define IN_AQN 4
#define IN_AKN 5
#define IN_DECF 6
#define IN_DECB 7
#define IN_GNW 8
#define IN_W_OUT 9
#define IN_NORM_MEM 10
#define IN_NORM_MEMKV 11
#define IN_W_MQ 12
#define IN_W_MKV 13
#define IN_MQN 14
#define IN_MKN 15
#define IN_W_MO 16
#define IN_NORM_MOE 17
#define IN_W_GROUP 18
#define IN_W_ROUTER 19
#define IN_W1 20
#define IN_W3 21
#define IN_W2 22

template <class RowMap>
__device__ __forceinline__ void p0_transpose_item(const float* W, int K, int N, bf16_t* WT, const RowMap& rm, const float* kscale, LAS float* scr, int item, int lane) {
    const int nblk = N / 64, kb = item / nblk, nb = item % nblk, k0 = 64 * kb, n0 = 64 * nb;
    const int lr = lane >> 4, lc = (lane & 15) * 4;
    f32x4 v[16];
#pragma unroll
    for (int i = 0; i < 16; ++i) v[i] = *(const f32x4*)(W + (size_t)(k0 + 4 * i + lr) * N + n0 + lc);
#pragma unroll
    for (int i = 0; i < 16; ++i) { const int kk = 4 * i + lr; f32x4 t = v[i]; if (kscale) t = t * kscale[k0 + kk];
        LAS float* d = scr + kk * 65 + lc; d[0] = t.x; d[1] = t.y; d[2] = t.z; d[3] = t.w; }
    LDS_WAIT(); asm volatile("" ::: "memory");
    const int c = lane & 7;
#pragma unroll
    for (int j = 0; j < 8; ++j) { const int n = (lane >> 3) + 8 * j; const LAS float* s = scr + (8 * c) * 65 + n;
        u32x4 o; o.x = cvt_pk_bf16(s[0 * 65], s[1 * 65]); o.y = cvt_pk_bf16(s[2 * 65], s[3 * 65]); o.z = cvt_pk_bf16(s[4 * 65], s[5 * 65]); o.w = cvt_pk_bf16(s[6 * 65], s[7 * 65]);
        *(u32x4*)(WT + (size_t)rm(n0 + n) * K + k0 + 8 * c) = o; }
    LDS_WAIT(); asm volatile("" ::: "memory");
}
template <class RowMap>
__device__ __forceinline__ void p0_transpose_item_fp8(const float* W, int K, int N, unsigned char* WT, const RowMap& rm, const float* kscale, float mul, LAS float* scr, int item, int lane) {
    const int nblk = N / 64, kb = item / nblk, nb = item % nblk, k0 = 64 * kb, n0 = 64 * nb;
    const int lr = lane >> 4, lc = (lane & 15) * 4;
    f32x4 v[16];
#pragma unroll
    for (int i = 0; i < 16; ++i) v[i] = *(const f32x4*)(W + (size_t)(k0 + 4 * i + lr) * N + n0 + lc);
#pragma unroll
    for (int i = 0; i < 16; ++i) { const int kk = 4 * i + lr; const f32x4 t = v[i] * (kscale ? kscale[k0 + kk] * mul : mul);
        LAS float* d = scr + kk * 65 + lc; d[0] = t.x; d[1] = t.y; d[2] = t.z; d[3] = t.w; }
    LDS_WAIT(); asm volatile("" ::: "memory");
    const int c = lane & 7;
#pragma unroll
    for (int j = 0; j < 8; ++j) { const int n = (lane >> 3) + 8 * j; const LAS float* s = scr + (8 * c) * 65 + n;
        int w0 = 0, w1 = 0;
        w0 = __builtin_amdgcn_cvt_pk_fp8_f32(s[0 * 65], s[1 * 65], w0, false); w0 = __builtin_amdgcn_cvt_pk_fp8_f32(s[2 * 65], s[3 * 65], w0, true);
        w1 = __builtin_amdgcn_cvt_pk_fp8_f32(s[4 * 65], s[5 * 65], w1, false); w1 = __builtin_amdgcn_cvt_pk_fp8_f32(s[6 * 65], s[7 * 65], w1, true);
        *(u32x2*)(WT + (size_t)rm(n0 + n) * K + k0 + 8 * c) = (u32x2){(unsigned)w0, (unsigned)w1}; }
    LDS_WAIT(); asm volatile("" ::: "memory");
}
struct RmId { __device__ __forceinline__ int operator()(int n) const { return n; } };
struct RmOff { int off; __device__ __forceinline__ int operator()(int n) const { return n + off; } };
struct RmIn { __device__ __forceinline__ int operator()(int n) const {
        if (n >= 1024) return n;
        const int seg = n >> 9, head = (n & 511) >> 6, dim = n & 63;
        return 256 * (seg * 2 + (head >> 2)) + 128 * (dim >> 5) + 32 * (head & 3) + (dim & 31); } };
struct RmGU { int up; __device__ __forceinline__ int operator()(int f) const { return 256 * (f >> 7) + 128 * up + (f & 127); } };

__device__ __forceinline__ void rms_row_to_bf16(const float* xrow, const float* w, bf16_t* orow, int lane, float* rstd_out = nullptr) {
    const f32x4* xr = (const f32x4*)xrow + lane; const f32x4* wr = (const f32x4*)w + lane;
    f32x4 v[4]; float s = 0.f;
#pragma unroll
    for (int j = 0; j < 4; ++j) { v[j] = xr[64 * j]; s += (v[j].x * v[j].x + v[j].y * v[j].y) + (v[j].z * v[j].z + v[j].w * v[j].w); }
    const float rstd = 1.0f / sqrtf(wave_sum(s) * (1.f / 1024.f) + 1e-6f);
    if (rstd_out && lane == 0) *rstd_out = rstd;
    u32x2* o8 = (u32x2*)orow + lane;
#pragma unroll
    for (int j = 0; j < 4; ++j) { const f32x4 ww = wr[64 * j]; u32x2 o; o.x = cvt_pk_bf16(v[j].x * rstd * ww.x, v[j].y * rstd * ww.y); o.y = cvt_pk_bf16(v[j].z * rstd * ww.z, v[j].w * rstd * ww.w); o8[64 * j] = o; }
}

template <int PART>
__device__ __forceinline__ void p0_prologue(Frame& F) {
    const Params& P = *F.p;
    LAS float* scr = (LAS float*)(F.lds + F.wave * 16640);
    const int gw = F.vcu * NWAVES + F.wave, NGW = F.G * NWAVES;
    constexpr int I_IN = 16 * 48, I_SQ = 16 * 16, I_MKV = 16 * 32, I_E1 = 16 * 8, I_E2 = 8 * 16;
    constexpr int NDENSE = I_IN, NITEMS = I_IN + 3 * I_SQ + I_MKV + NEXP * (2 * I_E1 + I_E2);
    unsigned char* ws = F.ws;
    for (int it = (PART ? NDENSE : 0) + gw; it < (PART ? NITEMS : NDENSE); it += NGW) {
        int r = it;
        if (r < I_IN) { p0_transpose_item(P.in[IN_W_IN], 1024, 3072, (bf16_t*)(ws + WS_WIN), RmIn{}, nullptr, scr, r, F.lane); continue; } r -= I_IN;
        if (r < I_SQ) { p0_transpose_item(P.in[IN_W_OUT], 1024, 1024, (bf16_t*)(ws + WS_WOUT), RmId{}, nullptr, scr, r, F.lane); continue; } r -= I_SQ;
        if (r < I_SQ) { p0_transpose_item(P.in[IN_W_MQ], 1024, 1024, (bf16_t*)(ws + WS_WMQ), RmId{}, P.in[IN_NORM_MEM], scr, r, F.lane); continue; } r -= I_SQ;
        if (r < I_SQ) { p0_transpose_item_fp8(P.in[IN_W_MO], 1024, 1024, (unsigned char*)(ws + WS_WMO), RmId{}, nullptr, 32.f, scr, r, F.lane); continue; } r -= I_SQ;
        if (r < I_MKV) { p0_transpose_item(P.in[IN_W_MKV], 1024, 2048, (bf16_t*)(ws + WS_WMKV), RmId{}, nullptr, scr, r, F.lane); continue; } r -= I_MKV;
        const int e = r / (2 * I_E1 + I_E2); r -= e * (2 * I_E1 + I_E2);
        if (r < I_E1) { p0_transpose_item_fp8(P.in[IN_W1] + (size_t)e * 1024 * 512, 1024, 512, (unsigned char*)(ws + WS_W13) + (size_t)e * 1024 * 1024, RmGU{0}, P.in[IN_NORM_MOE], 32.f, scr, r, F.lane); continue; } r -= I_E1;
        if (r < I_E1) { p0_transpose_item_fp8(P.in[IN_W3] + (size_t)e * 1024 * 512, 1024, 512, (unsigned char*)(ws + WS_W13) + (size_t)e * 1024 * 1024, RmGU{1}, P.in[IN_NORM_MOE], 32.f, scr, r, F.lane); continue; } r -= I_E1;
        p0_transpose_item_fp8(P.in[IN_W2] + (size_t)e * 512 * 1024, 512, 1024, (unsigned char*)(ws + WS_W2) + (size_t)e * 1024 * 512, RmId{}, nullptr, 16.f, scr, r, F.lane);
    }
    if (PART) return;
    for (int i = blockIdx.x * NTHR + F.tid; i < (int)((WS_HSQ + (size_t)NT * 16 - WS_SUMSQ1) / 16); i += F.G * NTHR) ((u32x4*)(ws + WS_SUMSQ1))[i] = (u32x4){0u, 0u, 0u, 0u};
    for (int i = blockIdx.x * NTHR + F.tid; i < 48 * 1024; i += F.G * NTHR) { const int c = i >> 10, k = i & 1023; float v = 0.f;
        if (c < 4) v = P.in[IN_W_GROUP][(size_t)k * 4 + c]; else if (c < 36) v = P.in[IN_W_ROUTER][((size_t)((c - 4) >> 3) * 1024 + k) * 8 + ((c - 4) & 7)];
        v *= P.in[IN_NORM_MOE][k];
        const unsigned hi = cvt_pk_bf16(v, 0.f) & 0xffffu; const float rem = v - __uint_as_float(hi << 16);
        ((bf16_t*)(ws + WS_WRT))[i] = (bf16_t)hi; ((bf16_t*)(ws + WS_WRT))[48 * 1024 + i] = (bf16_t)(cvt_pk_bf16(rem, 0.f) & 0xffffu); }
    for (int m = gw; m < NT; m += NGW) rms_row_to_bf16(P.in[IN_X] + (size_t)m * DM, P.in[IN_NORM_MIX], (bf16_t*)P.out + (size_t)m * DM, F.lane, (float*)(ws + WS_RSTD0) + m);
    for (int m = gw; m < NB * NMEM; m += NGW) rms_row_to_bf16(P.in[IN_MEM] + (size_t)m * DM, P.in[IN_NORM_MEMKV], (bf16_t*)(ws + WS_MEMH) + (size_t)m * DM, F.lane);
}

struct EpiInProj {
    static constexpr bool PERM = true;
    unsigned char* ws; const float* qnw; const float* knw;
    __device__ __forceinline__ void operator()(const f32x4 (&acc)[2][2][4][2], const pg8::Unit& u, int wr, int wc, int fr, int fq) const {
        const int pn = u.pn; const int row0 = u.pm * 256 + wr * 64 + fr;
        if (pn < 4) {
            const float* nw = pn < 2 ? qnw : knw; const float sc = pn < 2 ? 0.125f * 1.44269504089f : 1.0f;
            bf16_t* dst = (bf16_t*)(ws + (pn < 2 ? WS_AQ : WS_AK)); const int head = 4 * (pn & 1) + wc;
            f32x4 w4[2][2];
#pragma unroll
            for (int bj = 0; bj < 2; ++bj)
#pragma unroll
                for (int n = 0; n < 2; ++n) w4[bj][n] = *(const f32x4*)(nw + 32 * bj + 8 * fq + 4 * n);
#pragma unroll
            for (int ai = 0; ai < 2; ++ai)
#pragma unroll
                for (int m = 0; m < 4; ++m) {
                    float ss = 0.f;
#pragma unroll
                    for (int bj = 0; bj < 2; ++bj)
#pragma unroll
                        for (int n = 0; n < 2; ++n) { const f32x4 v = acc[ai][bj][m][n]; ss += (v.x * v.x + v.y * v.y) + (v.z * v.z + v.w * v.w); }
                    ss = sum_g4(ss);
                    const float rs = sc / sqrtf(ss * (1.f / 64.f) + 1e-6f);
                    bf16_t* rowp = dst + (size_t)(row0 + ai * 128 + m * 16) * 512 + head * 64 + 8 * fq;
#pragma unroll
                    for (int bj = 0; bj < 2; ++bj) { const f32x4 v0 = acc[ai][bj][m][0] * rs * w4[bj][0], v1 = acc[ai][bj][m][1] * rs * w4[bj][1];
                        u32x4 w; w.x = cvt_pk_bf16(v0.x, v0.y); w.y = cvt_pk_bf16(v0.z, v0.w); w.z = cvt_pk_bf16(v1.x, v1.y); w.w = cvt_pk_bf16(v1.z, v1.w);
                        *(u32x4*)(rowp + 32 * bj) = w; }
                }
        } else {
            bf16_t* dst; int ld, c0; float sc = 1.f; bool act = false;
            if (pn < 6) { dst = (bf16_t*)(ws + WS_AV); ld = 512; c0 = (pn - 4) * 256; }
            else if (pn == 6) { dst = (bf16_t*)(ws + WS_RQ); ld = 256; c0 = 0; }
            else if (pn == 7) { dst = (bf16_t*)(ws + WS_RK); ld = 256; c0 = 0; sc = 0.125f; }
            else if (pn < 10) { dst = (bf16_t*)(ws + WS_RV); ld = 512; c0 = (pn - 8) * 256; }
            else { dst = (bf16_t*)(ws + WS_RG); ld = 512; c0 = (pn - 10) * 256; act = true; }
#pragma unroll
            for (int ai = 0; ai < 2; ++ai)
#pragma unroll
                for (int m = 0; m < 4; ++m) {
                    bf16_t* rowp = dst + (size_t)(row0 + ai * 128 + m * 16) * ld + c0 + wc * 32 + 8 * fq;
#pragma unroll
                    for (int bj = 0; bj < 2; ++bj) { f32x4 v0 = acc[ai][bj][m][0] * sc, v1 = acc[ai][bj][m][1] * sc;
                        if (act) { v0.x = silu_f(v0.x); v0.y = silu_f(v0.y); v0.z = silu_f(v0.z); v0.w = silu_f(v0.w); v1.x = silu_f(v1.x); v1.y = silu_f(v1.y); v1.z = silu_f(v1.z); v1.w = silu_f(v1.w); }
                        u32x4 w; w.x = cvt_pk_bf16(v0.x, v0.y); w.y = cvt_pk_bf16(v0.z, v0.w); w.z = cvt_pk_bf16(v1.x, v1.y); w.w = cvt_pk_bf16(v1.z, v1.w);
                        *(u32x4*)(rowp + 128 * bj) = w; }
                }
        }
    }
};


__device__ __forceinline__ void tr_read8(unsigned addr, bf16x4 (&r)[8]) {
    asm volatile("ds_read_b64_tr_b16 %0, %8\n\tds_read_b64_tr_b16 %1, %8 offset:32\n\tds_read_b64_tr_b16 %2, %8 offset:64\n\tds_read_b64_tr_b16 %3, %8 offset:96\n\t"
                 "ds_read_b64_tr_b16 %4, %8 offset:2048\n\tds_read_b64_tr_b16 %5, %8 offset:2080\n\tds_read_b64_tr_b16 %6, %8 offset:2112\n\tds_read_b64_tr_b16 %7, %8 offset:2144\n\t"
                 "s_waitcnt lgkmcnt(0)"
                 : "=&v"(r[0]), "=&v"(r[1]), "=&v"(r[2]), "=&v"(r[3]), "=&v"(r[4]), "=&v"(r[5]), "=&v"(r[6]), "=&v"(r[7]) : "v"(addr) : "memory");
}
__device__ __forceinline__ void tr_read8_issue(unsigned addr, bf16x4 (&r)[8]) {
    asm volatile("ds_read_b64_tr_b16 %0, %8\n\tds_read_b64_tr_b16 %1, %8 offset:32\n\tds_read_b64_tr_b16 %2, %8 offset:64\n\tds_read_b64_tr_b16 %3, %8 offset:96\n\t"
                 "ds_read_b64_tr_b16 %4, %8 offset:2048\n\tds_read_b64_tr_b16 %5, %8 offset:2080\n\tds_read_b64_tr_b16 %6, %8 offset:2112\n\tds_read_b64_tr_b16 %7, %8 offset:2144"
                 : "=&v"(r[0]), "=&v"(r[1]), "=&v"(r[2]), "=&v"(r[3]), "=&v"(r[4]), "=&v"(r[5]), "=&v"(r[6]), "=&v"(r[7]) : "v"(addr) : "memory");
}
__device__ __forceinline__ void tr_read8_wait(bf16x4 (&r)[8]) {
    asm volatile("s_waitcnt lgkmcnt(0)" : "+v"(r[0]), "+v"(r[1]), "+v"(r[2]), "+v"(r[3]), "+v"(r[4]), "+v"(r[5]), "+v"(r[6]), "+v"(r[7]) :: "memory");
}
__device__ __forceinline__ bf16x8 cat4(bf16x4 a, bf16x4 b) { return __builtin_shufflevector(a, b, 0, 1, 2, 3, 4, 5, 6, 7); }
constexpr int ACC_LD = 136;
constexpr int ATT_TOK = 512;
constexpr int ATT_ACC_BYTES = ATT_TOK * ACC_LD;
constexpr int ATT_VBUF_OFF = ATT_ACC_BYTES;

struct AttRing { bf16x8 kf[2][2][2]; u32x4 vst[2][4]; bf16x8 qn[2][2]; };
struct AttItem { const bf16_t* Qb; int d, r, jq0, L; };
constexpr size_t ATT_K_OFF = (WS_AK - WS_AQ) / 2, ATT_V_OFF = (WS_AV - WS_AQ) / 2;
template <int B>
__device__ __forceinline__ void att_ring_load(AttRing& R, const AttItem& it, int P, int lane) {
    asm volatile("" : "+v"(lane));
    const int g = lane >> 4, li = lane & 15, sc = lane & 7, sr = lane >> 3;
    const bf16_t* Kb = it.Qb + ATT_K_OFF; const bf16_t* Vb = it.Qb + ATT_V_OFF; const int jb = it.jq0 - 64 + 32 * P;
#pragma unroll
    for (int t = 0; t < 2; ++t) { int jk = jb + 16 * t + li; jk = jk < 0 ? 0 : (jk >= it.L ? it.L - 1 : jk); const bf16_t* kp = Kb + (size_t)(it.r + it.d * jk) * 512 + 8 * g;
        R.kf[B][t][0] = *(const bf16x8*)kp; R.kf[B][t][1] = *(const bf16x8*)(kp + 32); }
#pragma unroll
    for (int i = 0; i < 4; ++i) { int jk = jb + sr + 8 * i; jk = jk < 0 ? 0 : (jk >= it.L ? it.L - 1 : jk); R.vst[B][i] = *(const u32x4*)(Vb + (size_t)(it.r + it.d * jk) * 512 + 8 * sc); }
}
template <int NQ>
__device__ __forceinline__ void att_q_load(AttRing& R, const AttItem& it, int lane) {
    asm volatile("" : "+v"(lane));
    const int g = lane >> 4, li = lane & 15;
#pragma unroll
    for (int q = 0; q < NQ; ++q)
#pragma unroll
        for (int ks = 0; ks < 2; ++ks) R.qn[q][ks] = *(const bf16x8*)(it.Qb + (size_t)(it.r + it.d * (it.jq0 + 16 * q + li)) * 512 + 32 * ks + 8 * g);
}
template <int NQ, bool EDGE, int mode, int PAR, int NQN>
__device__ __forceinline__ void attn_item_r(AttRing& R, const AttItem& it, const AttItem& nx, float slope2  , unsigned m2w  ,
                                            LAS float* ACC, int T0, LAS unsigned char* vbuf  , bf16_t* mixrow0  , int lane) {
    asm volatile("" : "+v"(lane));
    const int g = lane >> 4, li = lane & 15;
    const int jq0 = it.jq0, L = it.L;
    const unsigned s2b = cvt_pk_bf16(slope2, 0.f) & 0xffffu;
    const float s2r = __builtin_bit_cast(float, s2b << 16);
    const unsigned gm = g == 0 ? 0xffffffffu : 0u;
    int tq[NQ]; bf16x8 qf[NQ][2], qa[NQ]; f32x4 o[NQ][4], ol[NQ];
#pragma unroll
    for (int q = 0; q < NQ; ++q) { tq[q] = it.r + it.d * (jq0 + 16 * q + li); qf[q][0] = R.qn[q][0]; qf[q][1] = R.qn[q][1];
        u32x4 a; a.x = ((__builtin_bit_cast(unsigned, (float)(16 * q + li)) >> 16) | (s2b << 16)) & gm; a.y = 0x3F80u & gm; a.z = 0u; a.w = 0u; qa[q] = __builtin_bit_cast(bf16x8, a);
#pragma unroll
        for (int dt = 0; dt < 4; ++dt) o[q][dt] = (f32x4){0.f, 0.f, 0.f, 0.f};
        ol[q] = (f32x4){0.f, 0.f, 0.f, 0.f}; }
    float kbase = (float)(li - 64), delta0 = (float)(4 * g - li); asm volatile("" : "+v"(kbase), "+v"(delta0));
    const unsigned kw0 = (s2b | 0x8000u) & gm, kmask = 0xffff0000u & gm, kflip = 0x80008000u & gm, kw1 = m2w & gm;
    u32x4 onesw; onesw.x = 0x3F803F80u; onesw.y = 0x3F803F80u; onesw.z = 0x3F803F80u; onesw.w = 0x3F803F80u; const bf16x8 ones = __builtin_bit_cast(bf16x8, onesw);
    const unsigned vaddr = (unsigned)(size_t)vbuf + (unsigned)((4 * g + (li >> 2)) * 128 + (li & 3) * 8);
    const int sc = lane & 7, sr = lane >> 3;
#pragma unroll
    for (int P = 0; P < 5; ++P) {
        const int B = (P + PAR) & 1; const int jb = jq0 - 64 + 32 * P;
        if (P < 4) { if (B) att_ring_load<0>(R, it, P + 1, lane); else att_ring_load<1>(R, it, P + 1, lane); }
        else if (NQN) { if (B) att_ring_load<0>(R, nx, 0, lane); else att_ring_load<1>(R, nx, 0, lane); att_q_load<NQN ? NQN : 1>(R, nx, lane); }
        bf16x4 vr[8]; tr_read8_issue(vaddr + B * 4096, vr);
        bf16x8 pb[NQ];
#pragma unroll
        for (int q = 0; q < NQ; ++q) {
            float p[8];
#pragma unroll
            for (int t = 0; t < 2; ++t) {
                const int c = 2 * P + t - q;
                if (c < 0 || c > 8) {
#pragma unroll
                    for (int e = 0; e < 4; ++e) p[t * 4 + e] = 0.f;
                } else {
                    u32x4 kw; kw.x = (__builtin_bit_cast(unsigned, kbase + (float)(32 * P + 16 * t)) & kmask) | kw0; if (c >= 5) kw.x ^= kflip;
                    kw.y = kw1; kw.z = 0u; kw.w = 0u;
                    f32x4 st = __builtin_amdgcn_mfma_f32_16x16x32_bf16(R.kf[B][t][0], qf[q][0], (f32x4){0.f, 0.f, 0.f, 0.f}, 0, 0, 0);
                    st = __builtin_amdgcn_mfma_f32_16x16x32_bf16(R.kf[B][t][1], qf[q][1], st, 0, 0, 0);
                    st = __builtin_amdgcn_mfma_f32_16x16x32_bf16(__builtin_bit_cast(bf16x8, kw), qa[q], st, 0, 0, 0);
#pragma unroll
                    for (int e = 0; e < 4; ++e) { float x = st[e];
                        if (c == 4) x = __builtin_fmaf(__builtin_fmaxf(delta0 + (float)e, 0.f), -2.f * s2r, x);
                        float v = __builtin_amdgcn_exp2f(x);
                        if (c == 0) v = (delta0 + (float)e < 0.f) ? 0.f : v;
                        if (c == 8) v = (delta0 + (float)e > 0.f) ? 0.f : v;
                        if (EDGE) { const int jk = jb + 16 * t + 4 * g + e; v = ((unsigned)jk < (unsigned)L) ? v : 0.f; }
                        p[t * 4 + e] = v; }
                }
            }
            u32x4 pw; pw.x = cvt_pk_bf16(p[0], p[1]); pw.y = cvt_pk_bf16(p[2], p[3]); pw.z = cvt_pk_bf16(p[4], p[5]); pw.w = cvt_pk_bf16(p[6], p[7]);
            pb[q] = __builtin_bit_cast(bf16x8, pw);
        }
        tr_read8_wait(vr);
        __builtin_amdgcn_sched_barrier(0);
#pragma unroll
        for (int dt = 0; dt < 4; ++dt) { const bf16x8 vf = cat4(vr[dt], vr[4 + dt]);
#pragma unroll
            for (int q = 0; q < NQ; ++q) o[q][dt] = __builtin_amdgcn_mfma_f32_16x16x32_bf16(vf, pb[q], o[q][dt], 0, 0, 0); }
#pragma unroll
        for (int q = 0; q < NQ; ++q) ol[q] = __builtin_amdgcn_mfma_f32_16x16x32_bf16(ones, pb[q], ol[q], 0, 0, 0);
        if (P < 4 || NQN) {
#pragma unroll
            for (int i = 0; i < 4; ++i) *(LAS u32x4*)(vbuf + (B ^ 1) * 4096 + (sr + 8 * i) * 128 + sc * 16) = R.vst[B ^ 1][i]; }
    }
#pragma unroll
    for (int q = 0; q < NQ; ++q) {
        const float ls = ol[q][0];
        LAS unsigned char* arow = (LAS unsigned char*)ACC + (tq[q] - T0) * ACC_LD;
        if (mode == 0) {
#pragma unroll
            for (int dt = 0; dt < 4; ++dt) { u32x2 w; w.x = cvt_pk_bf16_c(o[q][dt].x, o[q][dt].y); w.y = cvt_pk_bf16_c(o[q][dt].z, o[q][dt].w); *(LAS u32x2*)(arow + 32 * dt + 8 * g) = w; }
            if (g == 0) *(LAS float*)(arow + 128) = ls;
        } else if (mode == 1) {
#pragma unroll
            for (int dt = 0; dt < 4; ++dt) { const u32x2 a = *(LAS u32x2*)(arow + 32 * dt + 8 * g);
                u32x2 w; w.x = cvt_pk_bf16_c(bflo(a.x) + o[q][dt].x, bfhi(a.x) + o[q][dt].y); w.y = cvt_pk_bf16_c(bflo(a.y) + o[q][dt].z, bfhi(a.y) + o[q][dt].w); *(LAS u32x2*)(arow + 32 * dt + 8 * g) = w; }
            if (g == 0) *(LAS float*)(arow + 128) += ls;
        } else {
            const float inv = 1.0f / (*(LAS float*)(arow + 128) + ls);
            bf16_t* orow = mixrow0 + (size_t)tq[q] * 1024;
#pragma unroll
            for (int dt = 0; dt < 4; ++dt) { const u32x2 a = *(LAS u32x2*)(arow + 32 * dt + 8 * g);
                u32x2 w; w.x = cvt_pk_bf16_c((bflo(a.x) + o[q][dt].x) * inv, (bfhi(a.x) + o[q][dt].y) * inv); w.y = cvt_pk_bf16_c((bflo(a.y) + o[q][dt].z) * inv, (bfhi(a.y) + o[q][dt].w) * inv);
                *(u32x2*)(orow + 16 * dt + 4 * g) = w; }
        }
    }
}
template <int NQ, int mode, int PAR, int NQN>
__device__ __forceinline__ void attn_item_d(AttRing& R, const AttItem& it, const AttItem& nx, float slope2, unsigned M2, LAS float* ACC, int T0, LAS unsigned char* vbuf, bf16_t* mixrow0, int lane) {
    if (it.jq0 - 64 < 0 || it.jq0 + 96 > it.L) attn_item_r<NQ, true, mode, PAR, NQN>(R, it, nx, slope2, M2, ACC, T0, vbuf, mixrow0, lane);
    else attn_item_r<NQ, false, mode, PAR, NQN>(R, it, nx, slope2, M2, ACC, T0, vbuf, mixrow0, lane);
}

template <int VAR>
__device__ __forceinline__ void p2_attention(Frame& F, bf16_t* mixbase) {
    const Params& P = *F.p; const int lane = F.lane, w = F.wave;
    LAS float* ACC = (LAS float*)F.lds; LAS unsigned char* vbuf = F.lds + ATT_VBUF_OFF + w * 8192;
    float mq = fabsf(P.in[IN_AQN][lane]), mk = fabsf(P.in[IN_AKN][lane]);
    mq = wave_max(mq); mk = wave_max(mk);
    const unsigned M2 = cvt_pk_bf16(-8.0f * mq * mk * 1.44269504089f, 0.f) & 0xffffu;
    AttRing R;
#define ATT_QB(U_) ((const bf16_t*)(F.ws + WS_AQ) + (size_t)((U_) >> 8) * SEQ * 512 + (((U_) >> 5) & 7) * 64)
#define ATT_L(n_) (VAR == 1 ? 32 : (n_))
    int U = F.vcu;
    if (U < 512) { const AttItem a0{ATT_QB(U), 16, 2 * w, ((U & 31) * ATT_TOK) / 16, ATT_L(SEQ / 16)}; att_ring_load<0>(R, a0, 0, lane); att_q_load<2>(R, a0, lane);
        const int sc = lane & 7, sr = lane >> 3;
#pragma unroll
        for (int i = 0; i < 4; ++i) *(LAS u32x4*)(vbuf + (sr + 8 * i) * 128 + sc * 16) = R.vst[0][i]; }
    for (; U < 512; U += F.G) {
        const int bh = U >> 5, blk = U & 31, b = bh >> 3, h = bh & 7, T0 = blk * ATT_TOK;
        const bf16_t* Qb = ATT_QB(U);
        bf16_t* mix = mixbase + (size_t)b * SEQ * 1024 + h * 64;
        const float slope = __builtin_amdgcn_exp2f(-(float)(h + 1)) * 1.44269504089f;
        const AttItem iA{Qb, 16, 2 * w, T0 / 16, ATT_L(SEQ / 16)}, iB{Qb, 16, 2 * w + 1, T0 / 16, ATT_L(SEQ / 16)};
        const AttItem iC{Qb, 4, w >> 1, T0 / 4 + 64 * (w & 1), ATT_L(SEQ / 4)}, iD{Qb, 4, w >> 1, T0 / 4 + 64 * (w & 1) + 32, ATT_L(SEQ / 4)};
        const AttItem iE{Qb, 1, 0, T0 + 64 * w, ATT_L(SEQ)}, iF{Qb, 1, 0, T0 + 64 * w + 32, ATT_L(SEQ)};
        const int Un = (U + F.G < 512) ? U + F.G : U;
        const AttItem nA{ATT_QB(Un), 16, 2 * w, ((Un & 31) * ATT_TOK) / 16, ATT_L(SEQ / 16)};
        attn_item_d<2, 0, 0, 2>(R, iA, iB, slope * 16.f, M2, ACC, T0, vbuf, mix, lane);
        attn_item_d<2, 0, 1, 2>(R, iB, iC, slope * 16.f, M2, ACC, T0, vbuf, mix, lane);
        __syncthreads();
        attn_item_d<2, 1, 0, 2>(R, iC, iD, slope * 4.f, M2, ACC, T0, vbuf, mix, lane);
        attn_item_d<2, 1, 1, 2>(R, iD, iE, slope * 4.f, M2, ACC, T0, vbuf, mix, lane);
        __syncthreads();
        attn_item_d<2, 2, 0, 2>(R, iE, iF, slope, M2, ACC, T0, vbuf, mix, lane);
        attn_item_d<2, 2, 1, 2>(R, iF, nA, slope, M2, ACC, T0, vbuf, mix, lane);
        __syncthreads();
    }
#undef ATT_QB
#undef ATT_L
}

template <int ROWB>
__device__ __forceinline__ bf16x8 tr_read2(unsigned addr) {
    bf16x4 a, b;
    asm volatile("ds_read_b64_tr_b16 %0, %2\n\tds_read_b64_tr_b16 %1, %2 offset:%3\n\ts_waitcnt lgkmcnt(0)" : "=&v"(a), "=&v"(b) : "v"(addr), "i"(16 * ROWB) : "memory");
    return cat4(a, b);
}
template <int ROWB, int STEP>
__device__ __forceinline__ void tr_read2x8(unsigned addr, bf16x8 (&f)[8]) {
    bf16x4 a[8], b[8];
    asm volatile("ds_read_b64_tr_b16 %0, %16\n\tds_read_b64_tr_b16 %8, %16 offset:%17\n\t"
                 "ds_read_b64_tr_b16 %1, %16 offset:%18\n\tds_read_b64_tr_b16 %9, %16 offset:%19\n\t"
                 "ds_read_b64_tr_b16 %2, %16 offset:%20\n\tds_read_b64_tr_b16 %10, %16 offset:%21\n\t"
                 "ds_read_b64_tr_b16 %3, %16 offset:%22\n\tds_read_b64_tr_b16 %11, %16 offset:%23\n\t"
                 "ds_read_b64_tr_b16 %4, %16 offset:%24\n\tds_read_b64_tr_b16 %12, %16 offset:%25\n\t"
                 "ds_read_b64_tr_b16 %5, %16 offset:%26\n\tds_read_b64_tr_b16 %13, %16 offset:%27\n\t"
                 "ds_read_b64_tr_b16 %6, %16 offset:%28\n\tds_read_b64_tr_b16 %14, %16 offset:%29\n\t"
                 "ds_read_b64_tr_b16 %7, %16 offset:%30\n\tds_read_b64_tr_b16 %15, %16 offset:%31\n\t"
                 "s_waitcnt lgkmcnt(0)"
                 : "=&v"(a[0]), "=&v"(a[1]), "=&v"(a[2]), "=&v"(a[3]), "=&v"(a[4]), "=&v"(a[5]), "=&v"(a[6]), "=&v"(a[7]),
                   "=&v"(b[0]), "=&v"(b[1]), "=&v"(b[2]), "=&v"(b[3]), "=&v"(b[4]), "=&v"(b[5]), "=&v"(b[6]), "=&v"(b[7])
                 : "v"(addr), "i"(16 * ROWB), "i"(1 * STEP), "i"(1 * STEP + 16 * ROWB), "i"(2 * STEP), "i"(2 * STEP + 16 * ROWB), "i"(3 * STEP), "i"(3 * STEP + 16 * ROWB),
                   "i"(4 * STEP), "i"(4 * STEP + 16 * ROWB), "i"(5 * STEP), "i"(5 * STEP + 16 * ROWB), "i"(6 * STEP), "i"(6 * STEP + 16 * ROWB), "i"(7 * STEP), "i"(7 * STEP + 16 * ROWB)
                 : "memory");
#pragma unroll
    for (int i = 0; i < 8; ++i) f[i] = cat4(a[i], b[i]);
}
template <int ROWB, int STEP>
__device__ __forceinline__ void tr_read2x4(unsigned addr, bf16x8 (&f)[4]) {
    bf16x4 a[4], b[4];
    asm volatile("ds_read_b64_tr_b16 %0, %8\n\tds_read_b64_tr_b16 %4, %8 offset:%9\n\t"
                 "ds_read_b64_tr_b16 %1, %8 offset:%10\n\tds_read_b64_tr_b16 %5, %8 offset:%11\n\t"
                 "ds_read_b64_tr_b16 %2, %8 offset:%12\n\tds_read_b64_tr_b16 %6, %8 offset:%13\n\t"
                 "ds_read_b64_tr_b16 %3, %8 offset:%14\n\tds_read_b64_tr_b16 %7, %8 offset:%15\n\t"
                 "s_waitcnt lgkmcnt(0)"
                 : "=&v"(a[0]), "=&v"(a[1]), "=&v"(a[2]), "=&v"(a[3]), "=&v"(b[0]), "=&v"(b[1]), "=&v"(b[2]), "=&v"(b[3])
                 : "v"(addr), "i"(16 * ROWB), "i"(1 * STEP), "i"(1 * STEP + 16 * ROWB), "i"(2 * STEP), "i"(2 * STEP + 16 * ROWB), "i"(3 * STEP), "i"(3 * STEP + 16 * ROWB)
                 : "memory");
#pragma unroll
    for (int i = 0; i < 4; ++i) f[i] = cat4(a[i], b[i]);
}
__device__ __forceinline__ float log2_sigmoid(float x) { return -log2f(1.0f + expf(-x)); }

__device__ __forceinline__ void p2_chunk_kv(Frame& F) {
    const Params& P = *F.p; const int lane = F.lane, w = F.wave, tid = F.tid, g = lane >> 4, li = lane & 15;
    LAS unsigned char* Vl = F.lds;
    LAS unsigned char* Kf = F.lds + 32768;
    LAS unsigned char* Kbk = F.lds + 32768 + 16384;
    u32x4 rv[4], rk[2];
#define P2B_LOAD(U) do { const int bh_ = (U) >> 7, n_ = (U) & 127, b_ = bh_ >> 2, h_ = bh_ & 3; const size_t row0_ = (size_t)b_ * SEQ + (size_t)n_ * 128; \
        const bf16_t* Vg_ = (const bf16_t*)(F.ws + WS_RV) + row0_ * 512 + h_ * 128; const bf16_t* Kg_ = (const bf16_t*)(F.ws + WS_RK) + row0_ * 256 + h_ * 64; \
        _Pragma("unroll") for (int i = 0; i < 4; ++i) { const int c = tid + 512 * i; rv[i] = *(const u32x4*)(Vg_ + (size_t)(c >> 4) * 512 + (c & 15) * 8); } \
        _Pragma("unroll") for (int i = 0; i < 2; ++i) { const int c = tid + 512 * i; rk[i] = *(const u32x4*)(Kg_ + (size_t)(c >> 3) * 256 + (c & 7) * 8); } } while (0)
    int U = F.vcu;
    if (U < 1024) P2B_LOAD(U);
    for (; U < 1024; U += F.G) {
        const int bh = U >> 7, h = bh & 3;
        const float l2f = log2_sigmoid(P.in[IN_DECF][h]), l2b = log2_sigmoid(P.in[IN_DECB][h]);
#pragma unroll
        for (int i = 0; i < 4; ++i) { const int c = tid + 512 * i, j = c >> 4, cc = c & 15; *(LAS u32x4*)(Vl + j * 256 + cc * 16) = rv[i]; }
#pragma unroll
        for (int i = 0; i < 2; ++i) { const int c = tid + 512 * i, j = c >> 3, cc = c & 7; const u32x4 kv = rk[i];
            const float wf = __builtin_amdgcn_exp2f(l2f * (float)(127 - j)), wb = __builtin_amdgcn_exp2f(l2b * (float)j);
            u32x4 a, bq;
            a.x = cvt_pk_bf16(bflo(kv.x) * wf, bfhi(kv.x) * wf); a.y = cvt_pk_bf16(bflo(kv.y) * wf, bfhi(kv.y) * wf); a.z = cvt_pk_bf16(bflo(kv.z) * wf, bfhi(kv.z) * wf); a.w = cvt_pk_bf16(bflo(kv.w) * wf, bfhi(kv.w) * wf);
            bq.x = cvt_pk_bf16(bflo(kv.x) * wb, bfhi(kv.x) * wb); bq.y = cvt_pk_bf16(bflo(kv.y) * wb, bfhi(kv.y) * wb); bq.z = cvt_pk_bf16(bflo(kv.z) * wb, bfhi(kv.z) * wb); bq.w = cvt_pk_bf16(bflo(kv.w) * wb, bfhi(kv.w) * wb);
            *(LAS u32x4*)(Kf + j * 128 + cc * 16) = a; *(LAS u32x4*)(Kbk + j * 128 + cc * 16) = bq; }
        __syncthreads();
        const int Un = U + F.G;
        if (Un < 1024) P2B_LOAD(Un);
        f32x4 acc[2][4];
#pragma unroll
        for (int dir = 0; dir < 2; ++dir)
#pragma unroll
            for (int dt = 0; dt < 4; ++dt) acc[dir][dt] = (f32x4){0.f, 0.f, 0.f, 0.f};
        const unsigned va = (unsigned)(size_t)Vl + (unsigned)((4 * g + (li >> 2)) * 256 + (16 * w + 4 * (li & 3)) * 2);
        const unsigned kaf = (unsigned)(size_t)Kf + (unsigned)((4 * g + (li >> 2)) * 128 + (4 * (li & 3)) * 2);
        const unsigned kab = (unsigned)(size_t)Kbk + (unsigned)((4 * g + (li >> 2)) * 128 + (4 * (li & 3)) * 2);
#pragma unroll
        for (int ks = 0; ks < 4; ++ks) {
            const bf16x8 af = tr_read2<256>(va + ks * 32 * 256);
            bf16x8 b0[4], b1[4]; tr_read2x4<128, 32>(kaf + ks * 32 * 128, b0); tr_read2x4<128, 32>(kab + ks * 32 * 128, b1);
#pragma unroll
            for (int dt = 0; dt < 4; ++dt) {
                acc[0][dt] = __builtin_amdgcn_mfma_f32_16x16x32_bf16(af, b0[dt], acc[0][dt], 0, 0, 0);
                acc[1][dt] = __builtin_amdgcn_mfma_f32_16x16x32_bf16(af, b1[dt], acc[1][dt], 0, 0, 0);
            }
        }
#pragma unroll
        for (int dir = 0; dir < 2; ++dir) { float* dst = (float*)(F.ws + WS_KV) + ((size_t)dir * 1024 + U) * 8192;
#pragma unroll
            for (int dt = 0; dt < 4; ++dt)
#pragma unroll
                for (int e = 0; e < 4; ++e) dst[(16 * w + 4 * g + e) * 64 + 16 * dt + li] = acc[dir][dt][e]; }
        __syncthreads();
    }
#undef P2B_LOAD
}

__device__ __forceinline__ void p3_scan(Frame& F) {
    const Params& P = *F.p;
    for (int gt = blockIdx.x * NTHR + F.tid; gt < 2 * 8 * 8192; gt += F.G * NTHR) {
        const int dir = gt >> 16, bh = (gt >> 13) & 7, el = gt & 8191, h = bh & 3;
        const float dec = __builtin_amdgcn_exp2f(128.f * log2_sigmoid(P.in[dir ? IN_DECB : IN_DECF][h]));
        const float* kv = (const float*)(F.ws + WS_KV) + ((size_t)dir * 1024 + bh * 128) * 8192 + el;
        bf16_t* st = (bf16_t*)(F.ws + WS_ST) + ((size_t)dir * 1024 + bh * 128) * 8192 + el;
        float s = 0.f;
        for (int c0 = 0; c0 < 128; c0 += 64) {
            float v[64];
#pragma unroll
            for (int i = 0; i < 64; ++i) { const int n = dir ? 127 - (c0 + i) : c0 + i; v[i] = kv[(size_t)n * 8192]; }
#pragma unroll
            for (int i = 0; i < 64; ++i) { const int n = dir ? 127 - (c0 + i) : c0 + i; st[(size_t)n * 8192] = (bf16_t)(cvt_pk_bf16(s, 0.f) & 0xffffu); s = s * dec + v[i]; }
        }
    }
}

constexpr int P4_V = 0, P4_K = 32768, P4_SF = 49152, P4_SB = 65536;
__device__ __forceinline__ void p4_retention_out(Frame& F) {
    const Params& P = *F.p; const int lane = F.lane, w = F.wave, tid = F.tid, g = lane >> 4, li = lane & 15;
    LAS unsigned char* L = F.lds;
    u32x4 rv[4], rk[2], rf[2], rb[2]; bf16x8 qn[2];
    const int iq = 16 * w + li;
#define P4_LOAD(U) do { const int bh_ = (U) >> 7, n_ = (U) & 127, b_ = bh_ >> 2, h_ = bh_ & 3; const size_t row0_ = (size_t)b_ * SEQ + (size_t)n_ * 128; \
        const bf16_t* Vg_ = (const bf16_t*)(F.ws + WS_RV) + row0_ * 512 + h_ * 128; const bf16_t* Kg_ = (const bf16_t*)(F.ws + WS_RK) + row0_ * 256 + h_ * 64; \
        const bf16_t* Qg_ = (const bf16_t*)(F.ws + WS_RQ) + row0_ * 256 + h_ * 64; \
        const bf16_t* Sf_ = (const bf16_t*)(F.ws + WS_ST) + (size_t)(U) * 8192; const bf16_t* Sb_ = Sf_ + (size_t)1024 * 8192; \
        _Pragma("unroll") for (int i = 0; i < 4; ++i) { const int c = tid + 512 * i; rv[i] = *(const u32x4*)(Vg_ + (size_t)(c >> 4) * 512 + (c & 15) * 8); } \
        _Pragma("unroll") for (int i = 0; i < 2; ++i) { const int c = tid + 512 * i; rk[i] = *(const u32x4*)(Kg_ + (size_t)(c >> 3) * 256 + (c & 7) * 8); \
            rf[i] = *(const u32x4*)(Sf_ + (size_t)c * 8); rb[i] = *(const u32x4*)(Sb_ + (size_t)c * 8); } \
        _Pragma("unroll") for (int ks = 0; ks < 2; ++ks) qn[ks] = *(const bf16x8*)(Qg_ + (size_t)iq * 256 + 32 * ks + 8 * g); } while (0)
    int U = F.vcu;
    if (U < 1024) P4_LOAD(U);
    for (; U < 1024; U += F.G) {
        const int bh = U >> 7, n = U & 127, b = bh >> 2, h = bh & 3;
        const size_t row0 = (size_t)b * SEQ + (size_t)n * 128;
        const float l2f = log2_sigmoid(P.in[IN_DECF][h]), l2b = log2_sigmoid(P.in[IN_DECB][h]);
#pragma unroll
        for (int i = 0; i < 4; ++i) { const int c = tid + 512 * i; *(LAS u32x4*)(L + P4_V + (c >> 4) * 256 + (c & 15) * 16) = rv[i]; }
#pragma unroll
        for (int i = 0; i < 2; ++i) { const int c = tid + 512 * i, row = c >> 3, pos = ((c & 7) ^ ((row >> 1) & 7)) << 4;
            *(LAS u32x4*)(L + P4_K + row * 128 + pos) = rk[i]; *(LAS u32x4*)(L + P4_SF + row * 128 + pos) = rf[i]; *(LAS u32x4*)(L + P4_SB + row * 128 + pos) = rb[i]; }
        bf16x8 qf[2] = {qn[0], qn[1]};
        __syncthreads();
        const int Un = U + F.G;
        if (Un < 1024) P4_LOAD(Un);
        const bf16_t* gp = (const bf16_t*)(F.ws + WS_RG) + (row0 + iq) * 512 + h * 128;
        u32x2 gv[8];
#pragma unroll
        for (int et = 0; et < 8; ++et) gv[et] = *(const u32x2*)(gp + 16 * et + 4 * g);
        bf16x8 pb[4];
#pragma unroll
        for (int ks4 = 0; ks4 < 4; ++ks4) {
            float p[8];
#pragma unroll
            for (int t = 0; t < 2; ++t) { const int jt = 2 * ks4 + t, row = 16 * jt + li; const LAS unsigned char* kr = L + P4_K + row * 128;
                f32x4 s = __builtin_amdgcn_mfma_f32_16x16x32_bf16(*(const LAS bf16x8*)(kr + ((g ^ ((row >> 1) & 7)) << 4)), qf[0], (f32x4){0.f, 0.f, 0.f, 0.f}, 0, 0, 0);
                s = __builtin_amdgcn_mfma_f32_16x16x32_bf16(*(const LAS bf16x8*)(kr + (((g + 4) ^ ((row >> 1) & 7)) << 4)), qf[1], s, 0, 0, 0);
#pragma unroll
                for (int e = 0; e < 4; ++e) { const int j = 16 * jt + 4 * g + e, df = iq - j;
                    const float dcy = df >= 0 ? __builtin_amdgcn_exp2f(l2f * (float)df) : __builtin_amdgcn_exp2f(l2b * (float)(-df));
                    p[t * 4 + e] = s[e] * dcy; } }
            u32x4 pw; pw.x = cvt_pk_bf16(p[0], p[1]); pw.y = cvt_pk_bf16(p[2], p[3]); pw.z = cvt_pk_bf16(p[4], p[5]); pw.w = cvt_pk_bf16(p[6], p[7]);
            pb[ks4] = __builtin_bit_cast(bf16x8, pw);
        }
        f32x4 y[8];
#pragma unroll
        for (int et = 0; et < 8; ++et) y[et] = (f32x4){0.f, 0.f, 0.f, 0.f};
        const unsigned va = (unsigned)(size_t)(L + P4_V) + (unsigned)((4 * g + (li >> 2)) * 256 + (4 * (li & 3)) * 2);
#pragma unroll
        for (int ks4 = 0; ks4 < 4; ++ks4)
#pragma unroll
            for (int eh = 0; eh < 2; ++eh) { bf16x8 af[4]; tr_read2x4<256, 32>(va + ks4 * 32 * 256 + eh * 128, af);
#pragma unroll
                for (int et = 0; et < 4; ++et) y[4 * eh + et] = __builtin_amdgcn_mfma_f32_16x16x32_bf16(af[et], pb[ks4], y[4 * eh + et], 0, 0, 0); }
#pragma unroll
        for (int dir = 0; dir < 2; ++dir) {
            const float sc = dir ? __builtin_amdgcn_exp2f(l2b * (float)(128 - iq)) : __builtin_amdgcn_exp2f(l2f * (float)(iq + 1));
            const LAS unsigned char* sp = L + (dir ? P4_SB : P4_SF);
#pragma unroll
            for (int ks = 0; ks < 2; ++ks) {
                const u32x4 qv = __builtin_bit_cast(u32x4, qf[ks]); u32x4 qs;
                qs.x = cvt_pk_bf16(bflo(qv.x) * sc, bfhi(qv.x) * sc); qs.y = cvt_pk_bf16(bflo(qv.y) * sc, bfhi(qv.y) * sc); qs.z = cvt_pk_bf16(bflo(qv.z) * sc, bfhi(qv.z) * sc); qs.w = cvt_pk_bf16(bflo(qv.w) * sc, bfhi(qv.w) * sc);
                const bf16x8 qb = __builtin_bit_cast(bf16x8, qs);
#pragma unroll
                for (int et = 0; et < 8; ++et) { const int row = 16 * et + li; const bf16x8 af = *(const LAS bf16x8*)(sp + row * 128 + (((g + 4 * ks) ^ ((row >> 1) & 7)) << 4));
                    y[et] = __builtin_amdgcn_mfma_f32_16x16x32_bf16(af, qb, y[et], 0, 0, 0); }
            }
        }
        float s1 = 0.f;
#pragma unroll
        for (int et = 0; et < 8; ++et) s1 += (y[et].x + y[et].y) + (y[et].z + y[et].w);
        s1 = sum_g4(s1);
        const float mu = s1 * (1.f / 128.f); float s2 = 0.f;
#pragma unroll
        for (int et = 0; et < 8; ++et) { const f32x4 dv = y[et] - mu; s2 += (dv.x * dv.x + dv.y * dv.y) + (dv.z * dv.z + dv.w * dv.w); }
        s2 = sum_g4(s2);
        const float rstd = 1.0f / sqrtf(s2 * (1.f / 128.f) + 1e-5f);
        const float* gw = P.in[IN_GNW] + h * 128;
        bf16_t* op = (bf16_t*)(F.ws + WS_MIX) + (row0 + iq) * 1024 + 512 + h * 128;
#pragma unroll
        for (int et = 0; et < 8; ++et) { const int e0 = 16 * et + 4 * g; const f32x4 ww = *(const f32x4*)(gw + e0);
            const f32x4 v = (y[et] - mu) * rstd * ww; u32x2 o; o.x = cvt_pk_bf16(v.x * bflo(gv[et].x), v.y * bfhi(gv[et].x)); o.y = cvt_pk_bf16(v.z * bflo(gv[et].y), v.w * bfhi(gv[et].y));
            *(u32x2*)(op + e0) = o; }
        __syncthreads();
    }
#undef P4_LOAD
}

template <int VAR>
struct EpiResidT {
    static constexpr bool PERM = false;
    const float* base; float* out; bf16_t* ob; float* sumsq;
    __device__ __forceinline__ void operator()(const f32x4 (&acc)[2][2][4][2], const pg8::Unit& u, int wr, int wc, int fr, int fq) const {
        const int row0 = u.pm * 256 + wr * 64 + fr, col0 = u.pn * 256 + wc * 32 + 4 * fq;
#pragma unroll
        for (int ai = 0; ai < 2; ++ai)
#pragma unroll
            for (int m = 0; m < 4; ++m) { const int row = row0 + ai * 128 + m * 16; const size_t off = (size_t)row * DM + col0; float ss = 0.f;
#pragma unroll
                for (int bj = 0; bj < 2; ++bj)
#pragma unroll
                    for (int n = 0; n < 2; ++n) { const f32x4 v = (VAR == 3 ? (f32x4){0.f, 0.f, 0.f, 0.f} : *(const f32x4*)(base + off + bj * 128 + n * 16)) + acc[ai][bj][m][n];
                        if (VAR != 2) *(f32x4*)(out + off + bj * 128 + n * 16) = v; ss += (v.x * v.x + v.y * v.y) + (v.z * v.z + v.w * v.w);
                        u32x2 wv; wv.x = cvt_pk_bf16(v.x, v.y); wv.y = cvt_pk_bf16(v.z, v.w); *(u32x2*)(ob + off + bj * 128 + n * 16) = wv; }
                ss = sum_g4(ss);
                if (fq == 0 && VAR != 1) atomicAdd(sumsq + row, ss);
                asm volatile("" ::: "memory"); }
    }
};


__device__ __forceinline__ void memkv_item(Frame& F, int item) {
    const Params& P = *F.p; const int lane = F.lane, w = F.wave, g = lane >> 4, li = lane & 15;
    const int rt = item >> 3, hh = item & 7, row0 = rt * 16;
    const bf16_t* A = (const bf16_t*)(F.ws + WS_MEMH) + (size_t)(row0 + li) * 1024 + 8 * g;
    const bf16_t* Bw = (const bf16_t*)(F.ws + WS_WMKV) + (size_t)(hh * 256 + 32 * w + li) * 1024 + 8 * g;
    LAS float* part = (LAS float*)F.lds;
    f32x4 acc[2] = {(f32x4){0.f, 0.f, 0.f, 0.f}, (f32x4){0.f, 0.f, 0.f, 0.f}};
#pragma unroll 8
    for (int ks = 0; ks < 32; ++ks) { const bf16x8 af = *(const bf16x8*)(A + 32 * ks);
        acc[0] = __builtin_amdgcn_mfma_f32_16x16x32_bf16(af, *(const bf16x8*)(Bw + 32 * ks), acc[0], 0, 0, 0);
        acc[1] = __builtin_amdgcn_mfma_f32_16x16x32_bf16(af, *(const bf16x8*)(Bw + (size_t)16 * 1024 + 32 * ks), acc[1], 0, 0, 0); }
    const int b = row0 >> 8, key0 = (row0 & 255) + 4 * g;
    if (hh < 4) {
#pragma unroll
        for (int e = 0; e < 4; ++e) { const float s = sum_row16(acc[0][e] * acc[0][e] + acc[1][e] * acc[1][e]); if (li == 0) part[w * 16 + 4 * g + e] = s; }
    }
    __syncthreads();
    if (hh < 4) {
        float rs[4];
#pragma unroll
        for (int e = 0; e < 4; ++e) { float t = 0.f;
#pragma unroll
            for (int ww = 0; ww < 8; ++ww) t += part[ww * 16 + 4 * g + e];
            rs[e] = 0.0625f / sqrtf(t * (1.f / 256.f) + 1e-6f); }
        bf16_t* dst = (bf16_t*)(F.ws + WS_MK) + ((size_t)(b * 4 + hh) * 256 + key0) * 256;
#pragma unroll
        for (int c = 0; c < 2; ++c) { const int d = 32 * w + 16 * c + li; const float wv = P.in[IN_MKN][d] * P.in[IN_MQN][d];
#pragma unroll
            for (int e = 0; e < 4; ++e) dst[(size_t)e * 256 + d] = (bf16_t)(cvt_pk_bf16(acc[c][e] * rs[e] * wv, 0.f) & 0xffffu); }
    } else {
        bf16_t* dst = (bf16_t*)(F.ws + WS_MVT) + ((size_t)(b * 4 + (hh - 4)) * 256) * 256 + ((row0 & 255) & ~31) + 8 * g + 4 * ((row0 >> 4) & 1);
#pragma unroll
        for (int c = 0; c < 2; ++c) { const int d = 32 * w + 16 * c + li; u32x2 o; o.x = cvt_pk_bf16_c(acc[c][0], acc[c][1]); o.y = cvt_pk_bf16_c(acc[c][2], acc[c][3]); *(u32x2*)(dst + (size_t)d * 256) = o; }
    }
    __syncthreads();
}

#ifndef KEEP_LO
#define KEEP_LO 0
#endif
template <bool BASE_F32>
struct EpiResidHL {
    static constexpr bool PERM = true;
    const float* basef; const bf16_t* bhi; const float* blo_f; bf16_t* ohi; bf16_t* olo; float* sumsq; unsigned char* oq;
    __device__ __forceinline__ void load_base(int row, int col0, u32x4 (&bh)[2]) const {
        const size_t off = (size_t)row * DM + col0;
#pragma unroll
        for (int bj = 0; bj < 2; ++bj) bh[bj] = *(const u32x4*)(bhi + off + bj * 128);
    }
    __device__ __forceinline__ void operator()(const f32x4 (&acc)[2][2][4][2], const pg8::Unit& u, int wr, int wc, int fr, int fq) const {
        const int row0 = u.pm * 256 + wr * 64 + fr, col0 = u.pn * 256 + wc * 32 + 8 * fq;
        u32x4 bh[4][2];
#pragma unroll
        for (int i = 0; i < 3; ++i) load_base(row0 + (i >> 2) * 128 + (i & 3) * 16, col0, bh[i]);
        f32x4 iw[2][2]; float rr[8];
        if (BASE_F32) {
#pragma unroll
            for (int i = 0; i < 8; ++i) rr[i] = blo_f[row0 + (i >> 2) * 128 + (i & 3) * 16];
#pragma unroll
            for (int bj = 0; bj < 2; ++bj)
#pragma unroll
                for (int n = 0; n < 2; ++n) { const f32x4 w4 = *(const f32x4*)(basef + col0 + bj * 128 + 4 * n); iw[bj][n] = (f32x4){1.0f / w4.x, 1.0f / w4.y, 1.0f / w4.z, 1.0f / w4.w}; } }
#pragma unroll
        for (int i = 0; i < 8; ++i) { const int ai = i >> 2, m = i & 3; const int row = row0 + ai * 128 + m * 16; const size_t off = (size_t)row * DM + col0; float ss = 0.f;
            if (i < 5) load_base(row0 + ((i + 3) >> 2) * 128 + ((i + 3) & 3) * 16, col0, bh[(i + 3) & 3]);
            float rms = 1.f; if (BASE_F32) rms = 1.0f / rr[i];
#pragma unroll
            for (int bj = 0; bj < 2; ++bj) { f32x4 b0, b1;
                { const u32x4 h = bh[i & 3][bj];
                    b0 = (f32x4){bflo(h.x), bfhi(h.x), bflo(h.y), bfhi(h.y)}; b1 = (f32x4){bflo(h.z), bfhi(h.z), bflo(h.w), bfhi(h.w)}; }
                if (BASE_F32) { b0 = b0 * iw[bj][0] * rms; b1 = b1 * iw[bj][1] * rms; }
                const f32x4 v0 = b0 + acc[ai][bj][m][0], v1 = b1 + acc[ai][bj][m][1];
                ss += (v0.x * v0.x + v0.y * v0.y) + (v0.z * v0.z + v0.w * v0.w) + (v1.x * v1.x + v1.y * v1.y) + (v1.z * v1.z + v1.w * v1.w);
                u32x4 hw; hw.x = cvt_pk_bf16(v0.x, v0.y); hw.y = cvt_pk_bf16(v0.z, v0.w); hw.z = cvt_pk_bf16(v1.x, v1.y); hw.w = cvt_pk_bf16(v1.z, v1.w);
                *(u32x4*)(ohi + off + bj * 128) = hw;
                if (oq) { int q0 = 0, q1 = 0; q0 = __builtin_amdgcn_cvt_pk_fp8_f32(v0.x, v0.y, q0, false); q0 = __builtin_amdgcn_cvt_pk_fp8_f32(v0.z, v0.w, q0, true);
                    q1 = __builtin_amdgcn_cvt_pk_fp8_f32(v1.x, v1.y, q1, false); q1 = __builtin_amdgcn_cvt_pk_fp8_f32(v1.z, v1.w, q1, true);
                    *(u32x2*)(oq + off + bj * 128) = (u32x2){(unsigned)q0, (unsigned)q1}; } }
            ss = sum_g4(ss);
            if (fq == 0) atomicAdd(sumsq + row, ss);
        }
    }
};
struct EpiNull {
    static constexpr bool PERM = true;
    float* sink;
    __device__ __forceinline__ void operator()(const f32x4 (&acc)[2][2][4][2], const pg8::Unit& u, int wr, int wc, int fr, int fq) const {
        f32x4 s = (f32x4){0.f, 0.f, 0.f, 0.f};
#pragma unroll
        for (int a = 0; a < 2; ++a)
#pragma unroll
            for (int b = 0; b < 2; ++b)
#pragma unroll
                for (int m = 0; m < 4; ++m)
#pragma unroll
                    for (int n = 0; n < 2; ++n) s += acc[a][b][m][n];
        sink[(size_t)(u.pm * 4 + u.pn) * 512 + threadIdx.x] = s.x + s.y + s.z + s.w;
    }
};
typedef EpiResidT<0> EpiResid;
#ifndef EPI_VAR
#define EPI_VAR 0
#endif
struct EpiMemQ {
    static constexpr bool PERM = true;
    bf16_t* qm; const float* sumsq1; float* hsq;
    __device__ __forceinline__ void operator()(const f32x4 (&acc)[2][2][4][2], const pg8::Unit& u, int wr, int wc, int fr, int fq) const {
        const int row0 = u.pm * 256 + wr * 64 + fr, col0 = u.pn * 256 + wc * 32 + 8 * fq;
        float sq[8];
#pragma unroll
        for (int i = 0; i < 8; ++i) sq[i] = sumsq1[row0 + (i >> 2) * 128 + (i & 3) * 16];
#pragma unroll
        for (int ai = 0; ai < 2; ++ai)
#pragma unroll
            for (int m = 0; m < 4; ++m) { const int row = row0 + ai * 128 + m * 16; const float rs = 1.0f / sqrtf(sq[ai * 4 + m] * (1.f / 1024.f) + 1e-6f); float ss = 0.f;
                bf16_t* rowp = qm + (size_t)row * DM + col0;
#pragma unroll
                for (int bj = 0; bj < 2; ++bj) { const f32x4 v0 = acc[ai][bj][m][0] * rs, v1 = acc[ai][bj][m][1] * rs;
                    ss += (v0.x * v0.x + v0.y * v0.y) + (v0.z * v0.z + v0.w * v0.w) + (v1.x * v1.x + v1.y * v1.y) + (v1.z * v1.z + v1.w * v1.w);
                    u32x4 w; w.x = cvt_pk_bf16(v0.x, v0.y); w.y = cvt_pk_bf16(v0.z, v0.w); w.z = cvt_pk_bf16(v1.x, v1.y); w.w = cvt_pk_bf16(v1.z, v1.w);
                    *(u32x4*)(rowp + 128 * bj) = w; }
                ss = sum_g4(ss);
                if (fq == 0) atomicAdd(hsq + (size_t)row * 4 + u.pn, ss); }
    }
};

__device__ __forceinline__ void p7_mem_attention(Frame& F) {
    const Params& P = *F.p; const int lane = F.lane, w = F.wave, tid = F.tid, g = lane >> 4, li = lane & 15;
    float mq = 0.f, mk = 0.f;
#pragma unroll
    for (int i = 0; i < 4; ++i) { mq = fmaxf(mq, fabsf(P.in[IN_MQN][lane + 64 * i])); mk = fmaxf(mk, fabsf(P.in[IN_MKN][lane + 64 * i])); }
    mq = wave_max(mq); mk = wave_max(mk);
    const float M2 = 16.0f * mq * mk * 1.44269504089f;
    LAS unsigned char* buf = F.lds;
    int kso[2], klo[2];
#pragma unroll
    for (int j = 0; j < 2; ++j) { const int o = tid * 16 + j * 8192, r = o >> 9, cpos = (o & 511) >> 4; klo[j] = o; kso[j] = r * 256 + ((cpos ^ (r & 15)) << 3); }
    const int vdim = tid >> 2, vseg = (tid & 3) ^ ((0 - (vdim >> 2)) & 3);
    for (int U = F.vcu; U < 512; U += F.G) {
        const int bhd = U >> 6, qb = U & 63, b = bhd >> 2, head = bhd & 3;
        const size_t tok0 = (size_t)b * SEQ + (size_t)qb * 256 + 32 * w;
        const bf16_t* Kp = (const bf16_t*)(F.ws + WS_MK) + (size_t)bhd * 65536;
        const bf16_t* Vt = (const bf16_t*)(F.ws + WS_MVT) + (size_t)bhd * 65536;
        bf16x8 qf[2][8]; float hs[2];
#pragma unroll
        for (int qt = 0; qt < 2; ++qt) { const size_t tok = tok0 + 16 * qt + li; const bf16_t* qp = (const bf16_t*)(F.ws + WS_QM) + tok * DM + head * 256 + 8 * g;
#pragma unroll
            for (int ks = 0; ks < 8; ++ks) qf[qt][ks] = *(const bf16x8*)(qp + 32 * ks);
            hs[qt] = 1.44269504089f / sqrtf(((const float*)(F.ws + WS_HSQ))[tok * 4 + head] * (1.f / 256.f) + 1e-6f); }
        bf16x8 pb[2][8]; float lsum[2] = {0.f, 0.f};
        u32x4 sreg[2][2];
#pragma unroll
        for (int j = 0; j < 2; ++j) { sreg[0][j] = *(const u32x4*)(Kp + kso[j]); sreg[1][j] = *(const u32x4*)(Kp + (size_t)8192 + kso[j]); }
        __syncthreads();
#pragma unroll
        for (int j = 0; j < 2; ++j) *(LAS u32x4*)(buf + klo[j]) = sreg[0][j];
        __syncthreads();
#pragma unroll
        for (int Pp = 0; Pp < 8; ++Pp) {
            LAS unsigned char* cb = buf + (Pp & 1) * 16384;
            if (Pp < 6) {
#pragma unroll
                for (int j = 0; j < 2; ++j) sreg[Pp & 1][j] = *(const u32x4*)(Kp + (size_t)(Pp + 2) * 8192 + kso[j]); }
            f32x4 st[2][2];
#pragma unroll
            for (int t = 0; t < 2; ++t) { const int rho = 16 * t + li;
                st[0][t] = (f32x4){0.f, 0.f, 0.f, 0.f}; st[1][t] = (f32x4){0.f, 0.f, 0.f, 0.f};
#pragma unroll
                for (int ks = 0; ks < 8; ++ks) { const bf16x8 kf = *(const LAS bf16x8*)(cb + rho * 512 + (((4 * ks + g) ^ li) << 4));
                    st[0][t] = __builtin_amdgcn_mfma_f32_16x16x32_bf16(kf, qf[0][ks], st[0][t], 0, 0, 0);
                    st[1][t] = __builtin_amdgcn_mfma_f32_16x16x32_bf16(kf, qf[1][ks], st[1][t], 0, 0, 0); } }
#pragma unroll
            for (int qt = 0; qt < 2; ++qt) { float p[8];
#pragma unroll
                for (int t = 0; t < 2; ++t)
#pragma unroll
                    for (int e = 0; e < 4; ++e) { p[t * 4 + e] = __builtin_amdgcn_exp2f(__builtin_fmaf(st[qt][t][e], hs[qt], -M2)); lsum[qt] += p[t * 4 + e]; }
                u32x4 pw; pw.x = cvt_pk_bf16(p[0], p[1]); pw.y = cvt_pk_bf16(p[2], p[3]); pw.z = cvt_pk_bf16(p[4], p[5]); pw.w = cvt_pk_bf16(p[6], p[7]);
                pb[qt][Pp] = __builtin_bit_cast(bf16x8, pw); }
            if (Pp < 7) {
#pragma unroll
                for (int j = 0; j < 2; ++j) *(LAS u32x4*)(buf + ((Pp + 1) & 1) * 16384 + klo[j]) = sreg[(Pp + 1) & 1][j]; }
            __syncthreads();
        }
        float inv[2];
#pragma unroll
        for (int qt = 0; qt < 2; ++qt) inv[qt] = 1.0f / sum_g4(lsum[qt]);
        u32x4 vreg[2];
        vreg[0] = *(const u32x4*)(Vt + (size_t)vdim * 256 + vseg * 8); vreg[1] = *(const u32x4*)(Vt + (size_t)vdim * 256 + 32 + vseg * 8);
        *(LAS u32x4*)(buf + tid * 16) = vreg[0];
        __syncthreads();
#pragma unroll 1
        for (int dh = 0; dh < 2; ++dh) {
            f32x4 o[2][8];
#pragma unroll
            for (int dt = 0; dt < 8; ++dt) { o[0][dt] = (f32x4){0.f, 0.f, 0.f, 0.f}; o[1][dt] = (f32x4){0.f, 0.f, 0.f, 0.f}; }
#pragma unroll
            for (int Pp = 0; Pp < 8; ++Pp) {
                const int c = dh * 8 + Pp; LAS unsigned char* cb = buf + (c & 1) * 8192;
                if (c < 14) { const int c2 = c + 2; vreg[Pp & 1] = *(const u32x4*)(Vt + (size_t)(128 * (c2 >> 3) + vdim) * 256 + 32 * (c2 & 7) + vseg * 8); }
#pragma unroll
                for (int dt = 0; dt < 8; ++dt) { const int dl = 16 * dt + li; const bf16x8 vf = *(const LAS bf16x8*)(cb + dl * 64 + ((g ^ ((0 - (dl >> 2)) & 3)) << 4));
                    o[0][dt] = __builtin_amdgcn_mfma_f32_16x16x32_bf16(vf, pb[0][Pp], o[0][dt], 0, 0, 0);
                    o[1][dt] = __builtin_amdgcn_mfma_f32_16x16x32_bf16(vf, pb[1][Pp], o[1][dt], 0, 0, 0); }
                if (c < 15) *(LAS u32x4*)(buf + ((c + 1) & 1) * 8192 + tid * 16) = vreg[(Pp + 1) & 1];
                __syncthreads();
            }
#pragma unroll
            for (int qt = 0; qt < 2; ++qt) { unsigned char* op = (unsigned char*)(F.ws + WS_OM) + (tok0 + 16 * qt + li) * DM + head * 256 + 128 * dh + 4 * g;
#pragma unroll
                for (int dt = 0; dt < 8; ++dt) { const f32x4 v = o[qt][dt] * (inv[qt] * 16.f); int q0 = 0; q0 = __builtin_amdgcn_cvt_pk_fp8_f32(v.x, v.y, q0, false); q0 = __builtin_amdgcn_cvt_pk_fp8_f32(v.z, v.w, q0, true);
                    *(unsigned*)(op + 16 * dt) = (unsigned)q0; } }
        }
    }
}

constexpr size_t WS_TOKSLOT = 117 * MiB + 512 * 1024;

struct RouteRec { int e0, e1; float g0, g1; };
constexpr int P9_W_BYTES = 48 * 2048, P9_XROW = 288, P9_XT_OFF = P9_W_BYTES + 256;
__device__ __forceinline__ void p9_route(Frame& F, unsigned* gcnt) {
    const int lane = F.lane, w = F.wave, tid = F.tid, g = lane >> 4, li = lane & 15;
    LAS unsigned char* Wl = F.lds;
    LAS unsigned* lcnt = (LAS unsigned*)(F.lds + P9_W_BYTES);
    LAS unsigned char* xt = F.lds + P9_XT_OFF + w * (16 * P9_XROW);
    {
        const bf16_t* wg = (const bf16_t*)(F.ws + WS_WRT);
        u32x4 t[12];
#pragma unroll
        for (int i = 0; i < 12; ++i) { const int p = tid + 512 * i; t[i] = *(const u32x4*)(wg + (size_t)(p >> 7) * 1024 + (p & 127) * 8); }
#pragma unroll
        for (int i = 0; i < 12; ++i) { const int p = tid + 512 * i, row = p >> 7, ch = p & 127; *(LAS u32x4*)(Wl + row * 2048 + ((ch ^ (row & 15)) << 4)) = t[i]; }
    }
    if (tid < 32) lcnt[tid] = 0u;
    __syncthreads();
    const int gw = F.vcu * NWAVES + w, NGW = F.G * NWAVES;
    for (int tt = gw; tt < NT / 16; tt += NGW) {
        const int tok0 = tt * 16;
        const bf16_t* xg = (const bf16_t*)(F.ws + WS_X2B) + (size_t)(tok0 + g) * DM + 8 * li;
        f32x4 acc[3];
#pragma unroll
        for (int ct = 0; ct < 3; ++ct) acc[ct] = (f32x4){0.f, 0.f, 0.f, 0.f};
        u32x4 xr[4];
#pragma unroll
        for (int i = 0; i < 4; ++i) xr[i] = *(const u32x4*)(xg + (size_t)(4 * i) * DM);
#pragma unroll 1
        for (int c = 0; c < 8; ++c) {
#pragma unroll
            for (int i = 0; i < 4; ++i) *(LAS u32x4*)(xt + (4 * i + g) * P9_XROW + li * 16) = xr[i];
            if (c < 7) {
#pragma unroll
                for (int i = 0; i < 4; ++i) xr[i] = *(const u32x4*)(xg + (size_t)(4 * i) * DM + 128 * (c + 1)); }
            LDS_WAIT();
#pragma unroll
            for (int ks = 0; ks < 4; ++ks) {
                const bf16x8 ah = *(const LAS bf16x8*)(xt + li * P9_XROW + (32 * ks + 8 * g) * 2);
                const int chi = 16 * c + 4 * ks + g;
#pragma unroll
                for (int ct = 0; ct < 3; ++ct) { const bf16x8 bh = *(const LAS bf16x8*)(Wl + (16 * ct + li) * 2048 + ((chi ^ li) << 4));
                    acc[ct] = __builtin_amdgcn_mfma_f32_16x16x32_bf16(ah, bh, acc[ct], 0, 0, 0); }
            }
            LDS_WAIT();
        }
        LAS float* lg = (LAS float*)xt;
#pragma unroll
        for (int ct = 0; ct < 3; ++ct)
#pragma unroll
            for (int e = 0; e < 4; ++e) lg[(4 * g + e) * 52 + 16 * ct + li] = acc[ct][e];
        LDS_WAIT();
        if (lane < 16) {
            const int tok = tok0 + lane; const LAS float* a = lg + lane * 52;
            const float rstd = 1.0f / sqrtf(((const float*)(F.ws + WS_SUMSQ2))[tok] * (1.f / 1024.f) + 1e-6f);
            int grp = 0; float gm = a[0];
#pragma unroll
            for (int q = 1; q < 4; ++q) { const float v = a[q]; if (v > gm) { gm = v; grp = q; } }
            float gden = 0.f;
#pragma unroll
            for (int q = 0; q < 4; ++q) gden += expf((a[q] - gm) * rstd);
            const float ggate = 1.0f / gden;
            const LAS float* el = a + 4 + grp * 8;
            int i1 = 0; float v1 = el[0];
#pragma unroll
            for (int e = 1; e < 8; ++e) { const float v = el[e]; if (v > v1) { v1 = v; i1 = e; } }
            int i2 = -1; float v2 = -3.0e38f;
#pragma unroll
            for (int e = 0; e < 8; ++e) { const float v = el[e]; if (e != i1 && v > v2) { v2 = v; i2 = e; } }
            const float ex = expf((v2 - v1) * rstd);
            RouteRec r; r.e0 = grp * 8 + i1; r.e1 = grp * 8 + i2; r.g0 = ggate / (1.0f + ex); r.g1 = ggate * ex / (1.0f + ex);
            ((RouteRec*)(F.ws + WS_ROUTE))[tok] = r;
            __hip_atomic_fetch_add(&lcnt[r.e0], 1u, __ATOMIC_RELAXED, __HIP_MEMORY_SCOPE_WORKGROUP); __hip_atomic_fetch_add(&lcnt[r.e1], 1u, __ATOMIC_RELAXED, __HIP_MEMORY_SCOPE_WORKGROUP);
        }
        LDS_WAIT();
    }
    __syncthreads();
    if (tid < 32) atomicAdd(gcnt + tid, lcnt[tid]);
    __syncthreads();
}
__device__ __forceinline__ void p10_slots(Frame& F) {
    LAS unsigned* lcnt = (LAS unsigned*)F.lds; LAS unsigned* lbase = lcnt + 32; LAS unsigned* loff = lcnt + 64; LAS unsigned* lgc = lcnt + 128;
    unsigned* cnt = (unsigned*)(F.ws + WS_CTL) + CW_CNT; unsigned* fill = (unsigned*)(F.ws + WS_CTL) + CW_FILL;
    int* slot_tok = (int*)(F.ws + WS_SLOTTOK); float* slot_gate = (float*)(F.ws + WS_SLOTGATE); int* tile_exp = (int*)(F.ws + WS_TILEEXP);
    const int tid = F.tid, blk = blockIdx.x;
    if (tid < 32) { lcnt[tid] = 0u; lgc[tid] = __hip_atomic_load(cnt + tid, __ATOMIC_RELAXED, __HIP_MEMORY_SCOPE_AGENT); }
    __syncthreads();
    if (tid == 0) { unsigned o = 0; for (int e = 0; e < 32; ++e) { loff[e] = o; o += (lgc[e] + 255u) & ~255u; } loff[32] = o; }
    __syncthreads();
    int e = 0, tok = 0, rank = 0; float gate = 0.f; unsigned lpos = 0;
    if (tid < 256) { tok = blk * 128 + (tid >> 1); rank = tid & 1; const RouteRec r = ((const RouteRec*)(F.ws + WS_ROUTE))[tok]; e = rank ? r.e1 : r.e0; gate = rank ? r.g1 : r.g0; lpos = __hip_atomic_fetch_add(&lcnt[e], 1u, __ATOMIC_RELAXED, __HIP_MEMORY_SCOPE_WORKGROUP); }
    __syncthreads();
    if (tid < 32) lbase[tid] = lcnt[tid] ? atomicAdd(fill + tid, lcnt[tid]) : 0u;
    __syncthreads();
    if (tid < 256) { const unsigned slot = loff[e] + lbase[e] + lpos; slot_tok[slot] = tok; slot_gate[slot] = gate; ((int*)(F.ws + WS_TOKSLOT))[tok * 2 + rank] = (int)slot; }
    if (blk < 32) { const unsigned c = lgc[blk], cp = (c + 255u) & ~255u, o = loff[blk];
        for (unsigned s = c + tid; s < cp; s += NTHR) { slot_tok[o + s] = 0; slot_gate[o + s] = 0.f; }
        for (unsigned t = tid; t < cp / 256u; t += NTHR) tile_exp[o / 256u + t] = blk; }
    __syncthreads();
}
struct MoeOrder {
    const char* A; const char* W; const int* tile_exp; const int* slot_tok; int ntiles, G, c, kb; size_t wstride, tstepB, tstepA;
    __device__ bool next_(int i, pg8::Unit& u, bool gatherA) const {
        const int L = i * G + c, T = L >> 2; if (T >= ntiles) return false;
        const int e = tile_exp[T]; u.pm = T; u.pn = L & 3; u.aux = e;
        u.A = gatherA ? A : A + (size_t)T * tstepA; u.B = W + (size_t)e * wstride + (size_t)u.pn * tstepB; return true;
    }
};
struct MoeOrder1 : MoeOrder {
    static constexpr bool GATHER = true;
    __device__ bool next(int i, pg8::Unit& u) const { return next_(i, u, true); }
    __device__ __forceinline__ void gather(const pg8::Unit& u, int R0, int R1, int C0, int C1, unsigned (&vA)[2][2]) const {
#pragma unroll
        for (int h = 0; h < 2; ++h) { const int t0 = slot_tok[u.pm * 256 + R0 + 128 * h], t1 = slot_tok[u.pm * 256 + R1 + 128 * h];
            vA[h][0] = (unsigned)(t0 * kb + C0) * 2u; vA[h][1] = (unsigned)(t1 * kb + C1) * 2u; }
    }
};
struct MoeOrder2 : MoeOrder {
    static constexpr bool GATHER = false;
    __device__ bool next(int i, pg8::Unit& u) const { return next_(i, u, false); }
    __device__ __forceinline__ void gather(const pg8::Unit&, int, int, int, int, unsigned (&)[2][2]) const {}
};
struct EpiMoe1 {
    static constexpr bool PERM = true;
    unsigned char* H; const int* slot_tok; const float* slot_gate; const float* sumsq2;
    __device__ __forceinline__ void operator()(const f32x4 (&acc)[2][2][4][2], const pg8::Unit& u, int wr, int wc, int fr, int fq) const {
        const int row0 = u.pm * 256 + wr * 64 + fr;
        int tk[8]; float gts[8], sq[8];
#pragma unroll
        for (int i = 0; i < 8; ++i) { const int slot = row0 + (i >> 2) * 128 + (i & 3) * 16; tk[i] = slot_tok[slot]; gts[i] = slot_gate[slot]; }
#pragma unroll
        for (int i = 0; i < 8; ++i) sq[i] = sumsq2[tk[i]];
#pragma unroll
        for (int ai = 0; ai < 2; ++ai)
#pragma unroll
            for (int m = 0; m < 4; ++m) { const int slot = row0 + ai * 128 + m * 16; const float gt = gts[ai * 4 + m];
                const float rs = 1.0f / sqrtf(sq[ai * 4 + m] * (1.f / 1024.f) + 1e-6f);
                f32x4 h0, h1;
                { const f32x4 a = acc[ai][0][m][0] * rs, b = acc[ai][1][m][0] * (rs * gt * 8.0f); h0.x = silu_f(a.x) * b.x; h0.y = silu_f(a.y) * b.y; h0.z = silu_f(a.z) * b.z; h0.w = silu_f(a.w) * b.w; }
                { const f32x4 a = acc[ai][0][m][1] * rs, b = acc[ai][1][m][1] * (rs * gt * 8.0f); h1.x = silu_f(a.x) * b.x; h1.y = silu_f(a.y) * b.y; h1.z = silu_f(a.z) * b.z; h1.w = silu_f(a.w) * b.w; }
                int q0 = 0, q1 = 0; q0 = __builtin_amdgcn_cvt_pk_fp8_f32(h0.x, h0.y, q0, false); q0 = __builtin_amdgcn_cvt_pk_fp8_f32(h0.z, h0.w, q0, true);
                q1 = __builtin_amdgcn_cvt_pk_fp8_f32(h1.x, h1.y, q1, false); q1 = __builtin_amdgcn_cvt_pk_fp8_f32(h1.z, h1.w, q1, true);
                *(u32x2*)(H + (size_t)slot * FF + u.pn * 128 + wc * 32 + 8 * fq) = (u32x2){(unsigned)q0, (unsigned)q1}; }
    }
};
struct EpiMoe2 {
    static constexpr bool PERM = true;
    unsigned char* Y;
    __device__ __forceinline__ void operator()(const f32x4 (&acc)[2][2][4][2], const pg8::Unit& u, int wr, int wc, int fr, int fq) const {
        const int row0 = u.pm * 256 + wr * 64 + fr, col0 = u.pn * 256 + wc * 32 + 8 * fq;
#pragma unroll
        for (int ai = 0; ai < 2; ++ai)
#pragma unroll
            for (int m = 0; m < 4; ++m) { unsigned char* rowp = Y + (size_t)(row0 + ai * 128 + m * 16) * DM + col0;
#pragma unroll
                for (int bj = 0; bj < 2; ++bj) { const f32x4 v0 = acc[ai][bj][m][0] * 16.0f, v1 = acc[ai][bj][m][1] * 16.0f;
                    int q0 = 0, q1 = 0; q0 = __builtin_amdgcn_cvt_pk_fp8_f32(v0.x, v0.y, q0, false); q0 = __builtin_amdgcn_cvt_pk_fp8_f32(v0.z, v0.w, q0, true);
                    q1 = __builtin_amdgcn_cvt_pk_fp8_f32(v1.x, v1.y, q1, false); q1 = __builtin_amdgcn_cvt_pk_fp8_f32(v1.z, v1.w, q1, true);
                    *(u32x2*)(rowp + 128 * bj) = (u32x2){(unsigned)q0, (unsigned)q1}; } }
    }
};
__device__ __forceinline__ void p13_combine(Frame& F, float* outp) {
    const int lane = F.lane;
    const int gw = F.vcu * NWAVES + F.wave, NGW = F.G * NWAVES;
    const unsigned char* Y = (const unsigned char*)(F.ws + WS_Y); const int* ts = (const int*)(F.ws + WS_TOKSLOT);
    typedef float f32x2v __attribute__((ext_vector_type(2)));
    for (int tok0 = gw; tok0 < NT; tok0 += 4 * NGW) {
        int s0[4], s1[4];
#pragma unroll
        for (int t = 0; t < 4; ++t) { const int tok = tok0 + t * NGW; s0[t] = ts[tok * 2]; s1[t] = ts[tok * 2 + 1]; }
        const int c = lane * 16;
        u32x4 y0[4], y1[4], xa[4], xc[4];
#pragma unroll
        for (int t = 0; t < 4; ++t) { const int tok = tok0 + t * NGW; const bf16_t* xb = (const bf16_t*)(F.ws + WS_X2B) + (size_t)tok * DM;
            y0[t] = *(const u32x4*)(Y + (size_t)s0[t] * DM + c); y1[t] = *(const u32x4*)(Y + (size_t)s1[t] * DM + c); xa[t] = *(const u32x4*)(xb + c); xc[t] = *(const u32x4*)(xb + c + 8); }
#pragma unroll
        for (int t = 0; t < 4; ++t) { const int tok = tok0 + t * NGW; float* od = outp + (size_t)tok * DM;
            const unsigned yw0[4] = {y0[t].x, y0[t].y, y0[t].z, y0[t].w}, yw1[4] = {y1[t].x, y1[t].y, y1[t].z, y1[t].w};
            const unsigned xw[8] = {xa[t].x, xa[t].y, xa[t].z, xa[t].w, xc[t].x, xc[t].y, xc[t].z, xc[t].w};
#pragma unroll
            for (int j = 0; j < 4; ++j) {
                const f32x2v a0 = __builtin_amdgcn_cvt_pk_f32_fp8((int)yw0[j], false), a1 = __builtin_amdgcn_cvt_pk_f32_fp8((int)yw0[j], true);
                const f32x2v b0 = __builtin_amdgcn_cvt_pk_f32_fp8((int)yw1[j], false), b1 = __builtin_amdgcn_cvt_pk_f32_fp8((int)yw1[j], true);
                f32x4 o; o.x = bflo(xw[2 * j]) + (a0.x + b0.x) * 0.0625f; o.y = bfhi(xw[2 * j]) + (a0.y + b0.y) * 0.0625f;
                o.z = bflo(xw[2 * j + 1]) + (a1.x + b1.x) * 0.0625f; o.w = bfhi(xw[2 * j + 1]) + (a1.y + b1.y) * 0.0625f;
                *(f32x4*)(od + c + 4 * j) = o; } }
    }
}

constexpr int CW_DBG = 1024;
__device__ __forceinline__ void dbg_report(Frame& F, float got, float ref, float atol, float rtol) {
    const float err = fabsf(got - ref), tol = atol + rtol * fabsf(ref);
    unsigned code = 0;
    if (!(err <= tol)) { code = 1; if (!(err <= 3.f * tol)) code = 2; if (!(err <= 10.f * tol)) code = 3; if (!(err <= 100.f * tol)) code = 4; if (!(err == err)) code = 5; }
    if (code) atomicMax((unsigned*)(F.ws + WS_CTL) + CW_DBG, code);
}
__device__ __forceinline__ void dbg_finish(Frame& F, const XcdBarrier& xb) {
    xcd_barrier(xb);
    const unsigned code = __hip_atomic_load((unsigned*)(F.ws + WS_CTL) + CW_DBG, __ATOMIC_RELAXED, __HIP_MEMORY_SCOPE_AGENT);
    const float c = 1.0f - 0.2f * (float)code;
    const size_t gt = (size_t)blockIdx.x * NTHR + F.tid, NGT = (size_t)F.G * NTHR;
    for (size_t i = gt; i < (size_t)NT * DM; i += NGT) F.p->out[i] = F.p->in[IN_X][i] * c;
}
__device__ __forceinline__ void dbg_check_inproj(Frame& F, int s) {
    const Params& P = *F.p; const int lane = F.lane;
    const int row = (int)(((long)s * 7919 + 13) % NT), col = (int)(((long)s * 104729 + 7) % 3072);
    const float* x = P.in[IN_X] + (size_t)row * DM; const float* nw = P.in[IN_NORM_MIX]; const float* W = P.in[IN_W_IN];
    float ss = 0.f; for (int k = lane; k < DM; k += 64) ss += x[k] * x[k];
    const float rstd = 1.0f / sqrtf(wave_sum(ss) * (1.f / 1024.f) + 1e-6f);
    if (col < 1024) {
        const int hb = col & ~63; float v[64];
#pragma unroll
        for (int d = 0; d < 64; ++d) v[d] = 0.f;
        for (int k = lane; k < DM; k += 64) { const float h = x[k] * rstd * nw[k];
#pragma unroll
            for (int d = 0; d < 64; ++d) v[d] += h * W[(size_t)k * 3072 + hb + d]; }
        float q = 0.f, mine = 0.f;
#pragma unroll
        for (int d = 0; d < 64; ++d) { v[d] = wave_sum(v[d]); q += v[d] * v[d]; if (d == (col & 63)) mine = v[d]; }
        const float* hn = col < 512 ? P.in[IN_AQN] : P.in[IN_AKN];
        const float ref = mine / sqrtf(q * (1.f / 64.f) + 1e-6f) * hn[col & 63] * (col < 512 ? 0.125f : 1.f);
        const bf16_t* t = (const bf16_t*)(F.ws + (col < 512 ? WS_AQ : WS_AK));
        const float got = bf2f(t[(size_t)row * 512 + (col & 511)]);
        if (lane == 0) dbg_report(F, got, ref, 0.01f, 0.02f);
    } else {
        float d = 0.f; for (int k = lane; k < DM; k += 64) d += x[k] * rstd * nw[k] * W[(size_t)k * 3072 + col];
        d = wave_sum(d); float ref = d; const bf16_t* t; int ld, c;
        if (col < 1536) { t = (const bf16_t*)(F.ws + WS_AV); ld = 512; c = col - 1024; }
        else if (col < 1792) { t = (const bf16_t*)(F.ws + WS_RQ); ld = 256; c = col - 1536; }
        else if (col < 2048) { t = (const bf16_t*)(F.ws + WS_RK); ld = 256; c = col - 1792; ref = d * 0.125f; }
        else if (col < 2560) { t = (const bf16_t*)(F.ws + WS_RV); ld = 512; c = col - 2048; }
        else { t = (const bf16_t*)(F.ws + WS_RG); ld = 512; c = col - 2560; ref = d / (1.f + expf(-d)); }
        const float got = bf2f(t[(size_t)row * ld + c]);
        if (lane == 0) dbg_report(F, got, ref, 0.02f, 0.02f);
    }
}


__device__ __forceinline__ void dbg_check_attn(Frame& F, int s) {
    const int lane = F.lane;
    const int b = s & 1, h = (s >> 1) & 7; int t = (int)(((long)s * 7919 + 5) % SEQ); if ((s & 63) == 0) t = (s >> 6) % 70; if ((s & 63) == 1) t = SEQ - 1 - ((s >> 6) % 70);
    const bf16_t* Q = (const bf16_t*)(F.ws + WS_AQ) + (size_t)b * SEQ * 512 + h * 64;
    const bf16_t* K = (const bf16_t*)(F.ws + WS_AK) + (size_t)b * SEQ * 512 + h * 64;
    const bf16_t* V = (const bf16_t*)(F.ws + WS_AV) + (size_t)b * SEQ * 512 + h * 64;
    const float slope = exp2f(-(float)(h + 1));
    float oacc[3], lse[3];
    const int dils[3] = {1, 4, 16};
    for (int pi = 0; pi < 3; ++pi) {
        const int d = dils[pi], r = t % d, jq = t / d, L = SEQ / d;
        float sc[3]; float mx = -1e30f;
        for (int kk = 0; kk < 3; ++kk) { const int dl = -64 + lane + 64 * kk; const int jk = jq + dl; float v = -1e30f;
            if (dl <= 64 && jk >= 0 && jk < L) { const bf16_t* kr = K + (size_t)(r + d * jk) * 512; float a = 0.f; for (int c = 0; c < 64; ++c) a += bf2f(Q[(size_t)t * 512 + c]) * bf2f(kr[c]);
                v = a - slope * (float)(d * (dl < 0 ? -dl : dl)); }
            sc[kk] = v; mx = fmaxf(mx, v); }
#pragma unroll
        for (int o = 1; o < 64; o <<= 1) mx = fmaxf(mx, __shfl_xor(mx, o));
        float den = 0.f, pk[3];
        for (int kk = 0; kk < 3; ++kk) { pk[kk] = sc[kk] > -1e29f ? expf(sc[kk] - mx) : 0.f; den += pk[kk]; }
        den = wave_sum(den);
        float o = 0.f;
        for (int kk = 0; kk < 3; ++kk) for (int l2 = 0; l2 < 64; ++l2) { const float pp = __shfl(pk[kk], l2); const int dl = -64 + l2 + 64 * kk; const int jk = jq + dl;
            if (pp != 0.f) o += pp * bf2f(V[(size_t)(r + d * jk) * 512 + lane]); }
        oacc[pi] = o / den; lse[pi] = mx + logf(den);
    }
    const float ml = fmaxf(lse[0], fmaxf(lse[1], lse[2]));
    const float w0 = expf(lse[0] - ml), w1 = expf(lse[1] - ml), w2 = expf(lse[2] - ml);
    const float ref = (w0 * oacc[0] + w1 * oacc[1] + w2 * oacc[2]) / (w0 + w1 + w2);
    const float got = bf2f(((const bf16_t*)(F.ws + WS_MIX))[((size_t)b * SEQ + t) * 1024 + h * 64 + lane]);
    dbg_report(F, got, ref, 0.004f, 0.02f);
}
__device__ __forceinline__ void dbg_check_ret(Frame& F, int s) {
    const Params& P = *F.p; const int lane = F.lane;
    const int b = s & 1, h = (s >> 1) & 3; int t = (int)(((long)s * 7919 + 5) % SEQ); if ((s & 31) == 0) t = (s >> 5) % 200; if ((s & 31) == 1) t = SEQ - 1 - ((s >> 5) % 200);
    const bf16_t* Q = (const bf16_t*)(F.ws + WS_RQ) + (size_t)b * SEQ * 256 + h * 64;
    const bf16_t* K = (const bf16_t*)(F.ws + WS_RK) + (size_t)b * SEQ * 256 + h * 64;
    const bf16_t* V = (const bf16_t*)(F.ws + WS_RV) + (size_t)b * SEQ * 512 + h * 128;
    const float lgf = -logf(1.f + expf(-P.in[IN_DECF][h])), lgb = -logf(1.f + expf(-P.in[IN_DECB][h]));
    float y0 = 0.f, y1 = 0.f;
    const float qv = bf2f(Q[(size_t)t * 256 + lane]);
    for (int j = 0; j < SEQ; ++j) {
        const int df = t - j; const float lg = (df >= 0 ? lgf * (float)df : lgb * (float)(-df)); if (lg < -40.f) continue;
        float a = qv * bf2f(K[(size_t)j * 256 + lane]); a = wave_sum(a);
        const float wgt = a * expf(lg);
        y0 += wgt * bf2f(V[(size_t)j * 512 + lane]); y1 += wgt * bf2f(V[(size_t)j * 512 + 64 + lane]);
    }
    const float mu = wave_sum(y0 + y1) * (1.f / 128.f); const float d0 = y0 - mu, d1 = y1 - mu;
    const float var = wave_sum(d0 * d0 + d1 * d1) * (1.f / 128.f); const float rstd = 1.f / sqrtf(var + 1e-5f);
    const bf16_t* G = (const bf16_t*)(F.ws + WS_RG) + ((size_t)b * SEQ + t) * 512 + h * 128;
    const float r0 = d0 * rstd * P.in[IN_GNW][h * 128 + lane] * bf2f(G[lane]), r1 = d1 * rstd * P.in[IN_GNW][h * 128 + 64 + lane] * bf2f(G[64 + lane]);
    const bf16_t* M = (const bf16_t*)(F.ws + WS_MIX) + ((size_t)b * SEQ + t) * 1024 + 512 + h * 128;
    dbg_report(F, bf2f(M[lane]), r0, 0.02f, 0.03f); dbg_report(F, bf2f(M[64 + lane]), r1, 0.02f, 0.03f);
}
__device__ __forceinline__ void dbg_check_outproj(Frame& F, int s) {
    const Params& P = *F.p; const int lane = F.lane;
    const int row = (int)(((long)s * 7919 + 13) % NT), col = (int)(((long)s * 104729 + 7) % 1024);
    const bf16_t* M = (const bf16_t*)(F.ws + WS_MIX) + (size_t)row * 1024;
    float d = 0.f; for (int k = lane; k < 1024; k += 64) d += bf2f(M[k]) * P.in[IN_W_OUT][(size_t)k * 1024 + col];
    d = wave_sum(d) + P.in[IN_X][(size_t)row * 1024 + col];
    if (lane == 0) { dbg_report(F, P.out[(size_t)row * 1024 + col], d, 0.01f, 0.01f);
        dbg_report(F, bf2f(((const bf16_t*)(F.ws + WS_X1B))[(size_t)row * 1024 + col]), d, 0.02f, 0.01f); }
    if (s < 256) { float ss = 0.f; for (int k = lane; k < 1024; k += 64) { const float v = P.out[(size_t)row * 1024 + k]; ss += v * v; } ss = wave_sum(ss);
        if (lane == 0) dbg_report(F, ((const float*)(F.ws + WS_SUMSQ1))[row], ss, 0.5f, 0.01f); }
}


__device__ __forceinline__ void dbg_check_memattn(Frame& F, int s, LAS float* scr  ) {
    const Params& P = *F.p; const int lane = F.lane;
    const int tok = (int)(((long)s * 7919 + 13) % NT), head = s & 3, b = tok / SEQ;
    const float* x1 = P.out + (size_t)tok * DM;
    float ss = 0.f; for (int k = lane; k < DM; k += 64) ss += x1[k] * x1[k];
    const float rstd = 1.0f / sqrtf(wave_sum(ss) * (1.f / 1024.f) + 1e-6f);
    float q[4] = {0.f, 0.f, 0.f, 0.f};
    for (int k = 0; k < DM; ++k) { const float hk = x1[k] * rstd * P.in[IN_NORM_MEM][k];
#pragma unroll
        for (int i = 0; i < 4; ++i) q[i] += hk * P.in[IN_W_MQ][(size_t)k * 1024 + head * 256 + lane + 64 * i]; }
    float qs = 0.f;
#pragma unroll
    for (int i = 0; i < 4; ++i) qs += q[i] * q[i];
    const float qr = 1.0f / sqrtf(wave_sum(qs) * (1.f / 256.f) + 1e-6f);
#pragma unroll
    for (int i = 0; i < 4; ++i) scr[lane + 64 * i] = q[i] * qr * P.in[IN_MQN][lane + 64 * i] * 0.0625f;
    LDS_WAIT();
    float sc[4]; const bf16_t* mh = (const bf16_t*)(F.ws + WS_MEMH);
    float kd[4];
    for (int i = 0; i < 4; ++i) { const int key = lane + 64 * i; const bf16_t* mr = mh + (size_t)(b * 256 + key) * 1024; float dot = 0.f, kss = 0.f;
        for (int d = 0; d < 256; ++d) { float kv = 0.f; for (int k = 0; k < DM; ++k) kv += bf2f(mr[k]) * P.in[IN_W_MKV][(size_t)k * 2048 + head * 256 + d];
            kss += kv * kv; dot += kv * P.in[IN_MKN][d] * scr[d]; }
        sc[i] = dot / sqrtf(kss * (1.f / 256.f) + 1e-6f); kd[i] = 0.f; }
    float mx = fmaxf(fmaxf(sc[0], sc[1]), fmaxf(sc[2], sc[3]));
#pragma unroll
    for (int o = 1; o < 64; o <<= 1) mx = fmaxf(mx, __shfl_xor(mx, o));
    float den = 0.f; for (int i = 0; i < 4; ++i) { sc[i] = expf(sc[i] - mx); den += sc[i]; }
    den = wave_sum(den);
    for (int i = 0; i < 4; ++i) scr[1024 + lane + 64 * i] = sc[i] / den;
    LDS_WAIT();
    float o = 0.f;
    for (int key = 0; key < 256; ++key) { const bf16_t* mr = mh + (size_t)(b * 256 + key) * 1024; float vv = 0.f; for (int k = 0; k < DM; ++k) vv += bf2f(mr[k]) * P.in[IN_W_MKV][(size_t)k * 2048 + 1024 + head * 256 + lane]; o += scr[1024 + key] * vv; }
    const float got = bf2f(((const bf16_t*)(F.ws + WS_OM))[(size_t)tok * DM + head * 256 + lane]);
    dbg_report(F, got, o, 0.004f, 0.03f);
    (void)kd;
}


__device__ __forceinline__ void dbg_check_memkv(Frame& F, int s) {
    const Params& P = *F.p; const int lane = F.lane;
    const int b = s & 1, head = (s >> 1) & 3, key = (s * 37 + 11) & 255;
    const bf16_t* mr = (const bf16_t*)(F.ws + WS_MEMH) + (size_t)(b * 256 + key) * 1024;
    float kv[4], vv[4], kss = 0.f;
    for (int i = 0; i < 4; ++i) { const int d = lane + 64 * i; float a = 0.f, c = 0.f; for (int k = 0; k < DM; ++k) { const float m = bf2f(mr[k]); a += m * P.in[IN_W_MKV][(size_t)k * 2048 + head * 256 + d]; c += m * P.in[IN_W_MKV][(size_t)k * 2048 + 1024 + head * 256 + d]; }
        kv[i] = a; vv[i] = c; kss += a * a; }
    const float kr = 1.0f / sqrtf(wave_sum(kss) * (1.f / 256.f) + 1e-6f);
    for (int i = 0; i < 4; ++i) { const int d = lane + 64 * i;
        const float refk = kv[i] * kr * P.in[IN_MKN][d] * P.in[IN_MQN][d] * 0.0625f;
        dbg_report(F, bf2f(((const bf16_t*)(F.ws + WS_MK))[((size_t)(b * 4 + head) * 256 + key) * 256 + d]), refk, 0.002f, 0.02f);
        dbg_report(F, bf2f(((const bf16_t*)(F.ws + WS_MVT))[((size_t)(b * 4 + head) * 256 + d) * 256 + key]), vv[i], 0.02f, 0.02f); }
}
__device__ __forceinline__ void dbg_check_memq(Frame& F, int s) {
    const Params& P = *F.p; const int lane = F.lane;
    const int tok = (int)(((long)s * 7919 + 13) % NT), head = s & 3;
    const float* x1 = P.out + (size_t)tok * DM;
    float ss = 0.f; for (int k = lane; k < DM; k += 64) ss += x1[k] * x1[k];
    const float rstd = 1.0f / sqrtf(wave_sum(ss) * (1.f / 1024.f) + 1e-6f);
    float q[4] = {0.f, 0.f, 0.f, 0.f};
    for (int k = 0; k < DM; ++k) { const float hk = x1[k] * rstd * P.in[IN_NORM_MEM][k];
#pragma unroll
        for (int i = 0; i < 4; ++i) q[i] += hk * P.in[IN_W_MQ][(size_t)k * 1024 + head * 256 + lane + 64 * i]; }
    float qs = 0.f;
#pragma unroll
    for (int i = 0; i < 4; ++i) { qs += q[i] * q[i]; dbg_report(F, bf2f(((const bf16_t*)(F.ws + WS_QM))[(size_t)tok * DM + head * 256 + lane + 64 * i]), q[i], 0.02f, 0.02f); }
    qs = wave_sum(qs);
    dbg_report(F, ((const float*)(F.ws + WS_HSQ))[(size_t)tok * 4 + head], qs, 1.0f, 0.02f);
}
__device__ __forceinline__ void dbg_check_memo(Frame& F, int s, LAS float* scr) {
    const int lane = F.lane;
    const int tok = (int)(((long)s * 7919 + 13) % NT), head = s & 3, b = tok / SEQ;
    const bf16_t* q = (const bf16_t*)(F.ws + WS_QM) + (size_t)tok * DM + head * 256;
    const float hs = 1.0f / sqrtf(((const float*)(F.ws + WS_HSQ))[(size_t)tok * 4 + head] * (1.f / 256.f) + 1e-6f);
    const bf16_t* K = (const bf16_t*)(F.ws + WS_MK) + (size_t)(b * 4 + head) * 65536;
    const bf16_t* Vt = (const bf16_t*)(F.ws + WS_MVT) + (size_t)(b * 4 + head) * 65536;
    float sc[4], mx = -1e30f;
    for (int i = 0; i < 4; ++i) { const int key = lane + 64 * i; float a = 0.f; for (int d = 0; d < 256; ++d) a += bf2f(q[d]) * bf2f(K[(size_t)key * 256 + d]); sc[i] = a * hs; if (DBG_P7 == 4) sc[i] = logf(fmaxf(1e-30f, 1.0f + sc[i])); if (DBG_P7 == 1) sc[i] = 0.f; if (DBG_P7 == 2) sc[i] = logf(sc[i] * sc[i] + 1e-30f); mx = fmaxf(mx, sc[i]); }
#pragma unroll
    for (int o = 1; o < 64; o <<= 1) mx = fmaxf(mx, __shfl_xor(mx, o));
    float den = 0.f; for (int i = 0; i < 4; ++i) { sc[i] = expf(sc[i] - mx); den += sc[i]; }
    den = wave_sum(den);
    for (int i = 0; i < 4; ++i) scr[lane + 64 * i] = sc[i] / den;
    LDS_WAIT();
    for (int i = 0; i < 4; ++i) { const int d = lane + 64 * i; float o = 0.f; for (int key = 0; key < 256; ++key) o += scr[key] * bf2f(Vt[(size_t)d * 256 + key]);
        dbg_report(F, bf2f(((const bf16_t*)(F.ws + WS_OM))[(size_t)tok * DM + head * 256 + d]), o, 0.003f, 0.02f); }
    LDS_WAIT();
}

#ifndef DBG_STAGE
#define DBG_STAGE 99
#endif
__global__ void __launch_bounds__(NTHR, 2) fwd_megakernel(Params prm) {
    extern __shared__ __attribute__((aligned(16))) unsigned char lds_raw[];
    Frame F;
    F.lds = (LAS unsigned char*)lds_raw; F.tid = threadIdx.x; F.lane = F.tid & 63; F.wave = __builtin_amdgcn_readfirstlane(F.tid >> 6);
    F.G = gridDim.x; { const int bx = blockIdx.x; F.vcu = (F.G % 8 == 0) ? (bx % 8) * (F.G / 8) + bx / 8 : bx; }
    F.p = &prm; F.ws = prm.ws;
    if (F.tid < 16) ((LAS unsigned*)(F.lds + LDS_MISC_OFF))[F.tid] = 0u;
    __syncthreads();
    XcdBarrier xbar = xcd_barrier_post((unsigned*)(F.ws + WS_CTL) + CW_BAR, (volatile LAS unsigned*)(F.lds + LDS_MISC_OFF));
#define REFRESH() do { int t_ = threadIdx.x; asm volatile("" : "+v"(t_)); F.tid = t_; F.lane = t_ & 63; F.wave = __builtin_amdgcn_readfirstlane(t_ >> 6); } while (0)
#define GRID_BAR() do { xcd_barrier(xbar); REFRESH(); } while (0)

    p0_prologue<0>(F);
#if REP & 1
    p0_prologue<0>(F);
#endif
    GRID_BAR();
    {
        pg8::DenseOrder S; S.init(prm.out, F.ws + WS_WIN, NT, 3072, 1024, F.G, (int)blockIdx.x);
        EpiInProj E{F.ws, prm.in[IN_AQN], prm.in[IN_AKN]};
        if (F.vcu & 1) { p0_prologue<1>(F); __syncthreads(); }
        pg8::gemm_phase(F.lds, 1024, S, E);
        if (!(F.vcu & 1)) { __syncthreads(); p0_prologue<1>(F); }
#if REP & 256
        pg8::gemm_phase(F.lds, 1024, S, E);
#endif
    }
    GRID_BAR();
#if DBG_STAGE == 1
    {
        const int gw = blockIdx.x * NWAVES + F.wave, NGW = F.G * NWAVES;
        for (int s = gw; s < 4096; s += NGW) dbg_check_inproj(F, s);
        dbg_finish(F, xbar);
        return;
    }
#endif
    p2_attention<0>(F, (bf16_t*)(F.ws + WS_MIX));
    __syncthreads();
#if REP & 2
    p2_attention<ATT_VAR>(F, (bf16_t*)(F.ws + WS_ST));
    __syncthreads();
#endif
    p2_chunk_kv(F);
#if REP & 4
    p2_chunk_kv(F);
#endif
    GRID_BAR();
    p3_scan(F);
#if REP & 8
    p3_scan(F);
#endif
    GRID_BAR();
    p4_retention_out(F);
#if REP & 16
    p4_retention_out(F);
#endif
    GRID_BAR();
#if DBG_STAGE == 2 || DBG_STAGE == 3
    {
        const int gw = blockIdx.x * NWAVES + F.wave, NGW = F.G * NWAVES;
        if (DBG_STAGE == 2) for (int s = gw; s < 8192; s += NGW) dbg_check_attn(F, s);
        if (DBG_STAGE == 3) for (int s = gw; s < 2048; s += NGW) dbg_check_ret(F, s);
        dbg_finish(F, xbar);
        return;
    }
#endif
    {
        pg8::DenseOrder S; S.init(F.ws + WS_MIX, F.ws + WS_WOUT, NT, 1024, 1024, F.G, (int)blockIdx.x, GEMM_WGM);
        EpiResidHL<true> E{prm.in[IN_NORM_MIX], (const bf16_t*)prm.out, (const float*)(F.ws + WS_RSTD0), (bf16_t*)(F.ws + WS_X1B), (bf16_t*)(F.ws + WS_X1L), (float*)(F.ws + WS_SUMSQ1), nullptr};
        pg8::gemm_phase(F.lds, 1024, S, E);
#if REP & 16384
        { EpiNull E3{(float*)(F.ws + WS_CTL + MiB)}; pg8::gemm_phase(F.lds, 1024, S, E3); }
#endif
#if REP & 512
        { EpiResidHL<true> E2{prm.in[IN_NORM_MIX], (const bf16_t*)prm.out, (const float*)(F.ws + WS_RSTD0), (bf16_t*)(F.ws + WS_X1B), (bf16_t*)(F.ws + WS_X1L), (float*)(F.ws + WS_CTL + MiB), nullptr}; pg8::gemm_phase(F.lds, 1024, S, E2); }
#endif
    }
    GRID_BAR();
#if DBG_STAGE == 4
    {
        const int gw = blockIdx.x * NWAVES + F.wave, NGW = F.G * NWAVES;
        for (int s = gw; s < 8192; s += NGW) dbg_check_outproj(F, s);
        dbg_finish(F, xbar);
        return;
    }
#endif
    memkv_item(F, F.vcu);
#if REP & 1024
    memkv_item(F, F.vcu);
#endif
    {
        pg8::DenseOrder S; S.init(F.ws + WS_X1B, F.ws + WS_WMQ, NT, 1024, 1024, F.G, (int)blockIdx.x, GEMM_WGM);
        EpiMemQ E{(bf16_t*)(F.ws + WS_QM), (const float*)(F.ws + WS_SUMSQ1), (float*)(F.ws + WS_HSQ)};
        pg8::gemm_phase(F.lds, 1024, S, E);
#if REP & 8192
        { EpiMemQ E2{(bf16_t*)(F.ws + WS_QM), (const float*)(F.ws + WS_SUMSQ1), (float*)(F.ws + WS_CTL + MiB + 256 * 1024)}; pg8::gemm_phase(F.lds, 1024, S, E2); }
#endif
    }
    GRID_BAR();
    p7_mem_attention(F);
#if REP & 32
    p7_mem_attention(F);
#endif
    GRID_BAR();
#if DBG_STAGE >= 5 && DBG_STAGE <= 8
    {
        const int gw = blockIdx.x * NWAVES + F.wave, NGW = F.G * NWAVES;
        if (DBG_STAGE == 5) for (int s = gw; s < 2048; s += NGW) dbg_check_memattn(F, s, (LAS float*)(F.lds + F.wave * 8192));
        if (DBG_STAGE == 6) for (int s = gw; s < 2048; s += NGW) dbg_check_memkv(F, s);
        if (DBG_STAGE == 7) for (int s = gw; s < 2048; s += NGW) dbg_check_memq(F, s);
        if (DBG_STAGE == 8) for (int s = gw; s < 4096; s += NGW) dbg_check_memo(F, s, (LAS float*)(F.lds + F.wave * 8192));
        dbg_finish(F, xbar);
        return;
    }
#endif
    {
        pg8::DenseOrder S; S.init(F.ws + WS_OM, F.ws + WS_WMO, NT, 1024, 512, F.G, (int)blockIdx.x, GEMM_WGM);
        EpiResidHL<false> E{nullptr, (const bf16_t*)(F.ws + WS_X1B), nullptr, (bf16_t*)(F.ws + WS_X2B), (bf16_t*)(F.ws + WS_X2L), (float*)(F.ws + WS_SUMSQ2), (unsigned char*)(F.ws + WS_X2Q)};
        pg8::gemm_phase<EpiResidHL<false>, pg8::DenseOrder, true, 123, 122>(F.lds, 512, S, E);
    }
    GRID_BAR();
#if DBG_STAGE == 9
    return;
#endif
    p9_route(F, (unsigned*)(F.ws + WS_CTL) + CW_CNT);
#if REP & 64
    p9_route(F, (unsigned*)(F.ws + WS_CTL) + 3000);
#endif
    GRID_BAR();
    p10_slots(F);
    GRID_BAR();
    {
        const unsigned* cnt = (const unsigned*)(F.ws + WS_CTL) + CW_CNT; int ntiles = 0;
        for (int e = 0; e < 32; ++e) ntiles += (int)((__hip_atomic_load(cnt + e, __ATOMIC_RELAXED, __HIP_MEMORY_SCOPE_AGENT) + 255u) >> 8);
        {
            MoeOrder1 S; S.A = (const char*)(F.ws + WS_X2Q); S.W = (const char*)(F.ws + WS_W13); S.tile_exp = (const int*)(F.ws + WS_TILEEXP); S.slot_tok = (const int*)(F.ws + WS_SLOTTOK);
            S.ntiles = ntiles; S.G = F.G; S.c = F.vcu; S.kb = 512; S.wstride = (size_t)1024 * 1024; S.tstepB = (size_t)256 * 1024; S.tstepA = 0;
            EpiMoe1 E{(unsigned char*)(F.ws + WS_H), (const int*)(F.ws + WS_SLOTTOK), (const float*)(F.ws + WS_SLOTGATE), (const float*)(F.ws + WS_SUMSQ2)};
            pg8::gemm_phase<EpiMoe1, MoeOrder1, true, 127, 122>(F.lds, 512, S, E);
#if REP & 32768
            { EpiNull E3{(float*)prm.out}; pg8::gemm_phase<EpiNull, MoeOrder1, true, 127, 122>(F.lds, 512, S, E3); }
#endif
#if REP & 2048
            pg8::gemm_phase<EpiMoe1, MoeOrder1, true, 127, 122>(F.lds, 512, S, E);
#endif
        }
        GRID_BAR();
        {
            MoeOrder2 S; S.A = (const char*)(F.ws + WS_H); S.W = (const char*)(F.ws + WS_W2); S.tile_exp = (const int*)(F.ws + WS_TILEEXP); S.slot_tok = nullptr;
            S.ntiles = ntiles; S.G = F.G; S.c = F.vcu; S.kb = 256; S.wstride = (size_t)1024 * 512; S.tstepB = (size_t)256 * 512; S.tstepA = (size_t)256 * 512;
            EpiMoe2 E{(unsigned char*)(F.ws + WS_Y)};
            pg8::gemm_phase<EpiMoe2, MoeOrder2, true, 124, 123>(F.lds, 256, S, E);
#if REP & 65536
            { EpiNull E3{(float*)prm.out}; pg8::gemm_phase<EpiNull, MoeOrder2, true, 124, 123>(F.lds, 256, S, E3); }
#endif
#if REP & 4096
            pg8::gemm_phase<EpiMoe2, MoeOrder2, true, 124, 123>(F.lds, 256, S, E);
#endif
        }
        GRID_BAR();
    }
#if REP & 128
    p13_combine(F, (float*)(F.ws + WS_H));
#endif
    p13_combine(F, prm.out);
}

extern "C" void kernel_launch(void* const* d_in, const int* in_sizes, int n_in, void* d_out, int out_size, void* d_ws, size_t ws_size, hipStream_t stream) {
    static int grid = 0;
    if (grid == 0) {
        if (n_in != 23 || out_size != NT * DM || ws_size < WS_END) { fprintf(stderr, "kernel_launch: unexpected shapes (n_in %d out %d ws %zu)\n", n_in, out_size, ws_size); grid = -1; return; }
        int dev = 0, cus = 0, per_cu = 0;
        hipGetDevice(&dev); hipDeviceGetAttribute(&cus, hipDeviceAttributeMultiprocessorCount, dev);
        if (hipFuncSetAttribute((const void*)fwd_megakernel, hipFuncAttributeMaxDynamicSharedMemorySize, LDS_BYTES) != hipSuccess) { fprintf(stderr, "hipFuncSetAttribute failed\n"); grid = -1; return; }
        if (hipOccupancyMaxActiveBlocksPerMultiprocessor(&per_cu, (const void*)fwd_megakernel, NTHR, LDS_BYTES) != hipSuccess || per_cu < 1) { fprintf(stderr, "occupancy query: %d\n", per_cu); grid = -1; return; }
        if (cus < 256) { fprintf(stderr, "kernel_launch: this kernel is laid out for a 256-CU device (got %d)\n", cus); grid = -1; return; }
        grid = 256;
        fprintf(stderr, "kernel_launch: grid %d (cus %d, per_cu %d)\n", grid, cus, per_cu);
    }
    if (grid < 0) return;
    hipMemsetAsync((char*)d_ws + WS_CTL, 0, CTL_ZERO_BYTES, stream);
    Params p{};
    for (int i = 0; i < 23; ++i) p.in[i] = (const float*)d_in[i];
    p.out = (float*)d_out; p.ws = (unsigned char*)d_ws;
    hipLaunchKernelGGL(fwd_megakernel, dim3(grid), dim3(NTHR), LDS_BYTES, stream, p);
    hipError_t e = hipPeekAtLastError();
    if (e != hipSuccess) fprintf(stderr, "launch failed: %s (grid %d)\n", hipGetErrorString(e), grid);
}
```

```cpp
#include <hip/hip_runtime.h>
#include <hip/hip_cooperative_groups.h>
#include <cstdio>
#include <cstdint>
namespace cg = cooperative_groups;
#ifndef ATT_VAR
#define ATT_VAR 0
#endif
#ifndef GEMM_WGM
#define GEMM_WGM 4
#endif
#ifndef REP
#define REP 0
#endif
#ifndef DBG_P7
#define DBG_P7 0
#endif

#define LAS __attribute__((address_space(3)))
#define GAS __attribute__((address_space(1)))
typedef unsigned short bf16_t;
typedef short bf16x8 __attribute__((ext_vector_type(8)));
typedef short bf16x4 __attribute__((ext_vector_type(4)));
typedef float f32x4 __attribute__((ext_vector_type(4)));
typedef float f32x2 __attribute__((ext_vector_type(2)));
typedef unsigned u32x4 __attribute__((ext_vector_type(4)));
typedef unsigned u32x2 __attribute__((ext_vector_type(2)));

constexpr int NB = 2, SEQ = 16384, NT = NB * SEQ, DM = 1024;
constexpr int NMEM = 256;
constexpr int NEXP = 32, FF = 512;
constexpr int NWAVES = 8, NTHR = 512;
constexpr int MAX_TILES = 288, MAX_SLOTS = MAX_TILES * 256;

constexpr size_t MiB = 1u << 20;
constexpr size_t WS_CTL = 0, CTL_ZERO_BYTES = 64 * 1024;
constexpr size_t WS_SUMSQ1 = 64 * 1024, WS_SUMSQ2 = 192 * 1024, WS_HSQ = 320 * 1024;
constexpr int CW_CNT = 2048, CW_FILL = 2048 + 64, CW_NTILES = 2048 + 128;
constexpr size_t WS_WIN = 2 * MiB, WS_WOUT = 8 * MiB, WS_WMQ = 10 * MiB, WS_WMKV = 12 * MiB, WS_WMO = 16 * MiB, WS_W13 = 18 * MiB, WS_W2 = 82 * MiB;
constexpr size_t WS_MEMH = 114 * MiB, WS_MK = 115 * MiB, WS_MVT = 116 * MiB, WS_ROUTE = 117 * MiB, WS_SLOTTOK = 118 * MiB, WS_SLOTGATE = 118 * MiB + 512 * 1024, WS_TILEEXP = 119 * MiB;
constexpr size_t WS_AQ = 128 * MiB, WS_AK = 160 * MiB, WS_AV = 192 * MiB, WS_RQ = 224 * MiB, WS_RK = 240 * MiB, WS_RV = 256 * MiB, WS_RG = 288 * MiB;
constexpr size_t WS_X1B = 128 * MiB, WS_QM = 192 * MiB, WS_OM = 256 * MiB, WS_Y = 128 * MiB;
constexpr size_t WS_XB = 320 * MiB, WS_MIX = 320 * MiB, WS_X2B = 320 * MiB;
constexpr size_t WS_KV = 384 * MiB, WS_ST = 448 * MiB, WS_H = 384 * MiB;
constexpr size_t WS_WRT = 119 * MiB + 64 * 1024;
constexpr size_t WS_X1L = 384 * MiB, WS_X2L = 192 * MiB;
constexpr size_t WS_RSTD0 = 125 * MiB;
constexpr size_t WS_X2Q = 192 * MiB;
constexpr size_t WS_END = 512 * MiB;

constexpr int LDS_BYTES = 147456;

__device__ __forceinline__ unsigned cvt_pk_bf16(float lo, float hi) { unsigned r; asm volatile("s_nop 0\n\tv_cvt_pk_bf16_f32 %0, %1, %2" : "=v"(r) : "v"(lo), "v"(hi)); return r; }
typedef __bf16 bf16v2_t __attribute__((ext_vector_type(2)));
__device__ __forceinline__ unsigned cvt_pk_bf16_c(float lo, float hi) { f32x2 v = {lo, hi}; bf16v2_t r = __builtin_convertvector(v, bf16v2_t); return __builtin_bit_cast(unsigned, r); }
__device__ __forceinline__ float bf2f(unsigned short b) { return __uint_as_float(((unsigned)b) << 16); }
__device__ __forceinline__ float bflo(unsigned w) { return __uint_as_float(w << 16); }
__device__ __forceinline__ float bfhi(unsigned w) { return __uint_as_float(w & 0xffff0000u); }
__device__ __forceinline__ float xl_dpp_quad1(float v) { return __builtin_bit_cast(float, __builtin_amdgcn_update_dpp(0, __builtin_bit_cast(int, v), 0xB1, 0xF, 0xF, true)); }
__device__ __forceinline__ float xl_dpp_quad2(float v) { return __builtin_bit_cast(float, __builtin_amdgcn_update_dpp(0, __builtin_bit_cast(int, v), 0x4E, 0xF, 0xF, true)); }
__device__ __forceinline__ float xl_dpp_ror4(float v)  { return __builtin_bit_cast(float, __builtin_amdgcn_update_dpp(0, __builtin_bit_cast(int, v), 0x124, 0xF, 0xF, true)); }
__device__ __forceinline__ float xl_dpp_ror8(float v)  { return __builtin_bit_cast(float, __builtin_amdgcn_update_dpp(0, __builtin_bit_cast(int, v), 0x128, 0xF, 0xF, true)); }
__device__ __forceinline__ float xl_swz16(float v)     { return __builtin_bit_cast(float, __builtin_amdgcn_ds_swizzle(__builtin_bit_cast(int, v), 0x401F)); }
__device__ __forceinline__ void xl_swap32(float& a, float& b) { asm volatile("s_nop 1\n\tv_permlane32_swap_b32 %0, %1\n\ts_nop 1" : "+v"(a), "+v"(b)); }
__device__ __forceinline__ float sum_g4(float v) { v += xl_swz16(v); float a = v, b = v; xl_swap32(a, b); return a + b; }
__device__ __forceinline__ float max_g4(float v) { v = fmaxf(v, xl_swz16(v)); float a = v, b = v; xl_swap32(a, b); return fmaxf(a, b); }
__device__ __forceinline__ float sum_row16(float v) { v += xl_dpp_quad1(v); v += xl_dpp_quad2(v); v += xl_dpp_ror4(v); v += xl_dpp_ror8(v); return v; }
__device__ __forceinline__ float max_row16(float v) { v = fmaxf(v, xl_dpp_quad1(v)); v = fmaxf(v, xl_dpp_quad2(v)); v = fmaxf(v, xl_dpp_ror4(v)); v = fmaxf(v, xl_dpp_ror8(v)); return v; }
__device__ __forceinline__ float wave_sum(float v) { return sum_g4(sum_row16(v)); }
__device__ __forceinline__ float wave_max(float v) { return max_g4(max_row16(v)); }
__device__ __forceinline__ float fast_exp(float x) { return __builtin_amdgcn_exp2f(x * 1.44269504089f); }
__device__ __forceinline__ float silu_f(float x) { return x * __builtin_amdgcn_rcpf(1.0f + fast_exp(-x)); }
#define LDS_WAIT() asm volatile("s_waitcnt lgkmcnt(0)" ::: "memory")
#define VM_WAIT() asm volatile("s_waitcnt vmcnt(0)" ::: "memory")

namespace pg8 {
constexpr int BM = 256, BK = 64, HALF = 128, HTB = HALF * BK * 2, STAGE_BYTES = 8 * HTB, NXCD = 8, WGM = 8;
__host__ __device__ __forceinline__ int lds_byte(int r, int c) { const int st = (r >> 4) * 2 + (c >> 5), rr = r & 15, cc = c & 31, ob = rr * 64 + cc * 2; return st * 1024 + (ob ^ (((ob >> 9) & 1) << 5)); }
__host__ __device__ __forceinline__ void stage_rc(int b, int& R, int& C) { const int st = b / 1024, sb = b % 1024, swz = sb ^ (((sb >> 9) & 1) << 5); R = (st >> 1) * 16 + swz / 64; C = (st & 1) * 32 + (swz % 64) / 2; }
__host__ __device__ __forceinline__ int perm32(int rho) { const int n = rho >> 4, i = rho & 15; return 8 * (i >> 2) + 4 * n + (i & 3); }

struct Unit { int pm, pn; const char* A; const char* B; int aux; };

struct DenseOrder {
    static constexpr bool GATHER = false;
    const char* A; const char* Bt; int nM, nN, nwg, G, c, wgm; size_t tstep;
    __device__ void init(const void* A_, const void* Bt_, int M, int N, int K, int G_, int c_, int wgm_ = WGM) { A = (const char*)A_; Bt = (const char*)Bt_; nM = M / BM; nN = N / BM; nwg = nM * nN; G = G_; c = c_; wgm = wgm_; tstep = (size_t)BM * K * 2; }
    __device__ bool next(int i, Unit& u) const {
        const long L = (long)i * G + c; if (L >= nwg) return false;
        int wgid = (int)L; { const int q = nwg / NXCD, r = nwg % NXCD, xcd = wgid % NXCD, off = wgid / NXCD; wgid = (xcd < r ? xcd * (q + 1) : r * (q + 1) + (xcd - r) * q) + off; }
        const int nig = wgm * nN, gid = wgid / nig, fm = gid * wgm, gsz = (nM - fm) < wgm ? (nM - fm) : wgm;
        u.pm = fm + ((wgid % nig) % gsz); u.pn = (wgid % nig) / gsz; u.A = A + (size_t)u.pm * tstep; u.B = Bt + (size_t)u.pn * tstep; u.aux = 0; return true;
    }
    __device__ __forceinline__ void gather(const Unit&, int, int, int, int, unsigned (&)[2][2]) const {}
};

template <class Epi, class Sched, bool FP8 = false, int SCA = 127, int SCB = 127>
__device__ __forceinline__ void gemm_phase(LAS unsigned char* lds, const int K, const Sched& S, const Epi& E) {
    constexpr bool GATHER = Sched::GATHER;
    int tid = threadIdx.x; asm volatile("" : "+v"(tid));
    const int wid = __builtin_amdgcn_readfirstlane(tid >> 6), lane = tid & 63, wr = wid >> 2, wc = wid & 3, fr = lane & 15, fq = lane >> 4;
    const int nt = K / BK;
    unsigned voffA[2], voffB[2]; int sR[2], sC[2];
#pragma unroll
    for (int i = 0; i < 2; ++i) { int R, C; stage_rc(tid * 16 + i * 8192, R, C); const int Rb = Epi::PERM ? ((R & ~31) + perm32(R & 31)) : R;
        sR[i] = R; sC[i] = C; voffA[i] = (unsigned)(R * K + C) * 2u; voffB[i] = (unsigned)(Rb * K + C) * 2u; }
    const size_t kstep = (size_t)(BK * 2);
    const size_t hstep = (size_t)HALF * K * 2;
    const unsigned ldsw = (unsigned)wid * 1024u;
    const int aoff = lds_byte(wr * 64 + fr, fq * 8), boff = lds_byte(wc * 32 + fr, fq * 8);
#define PG8_SA(b, h) (((b) * 2 + (h)) * HTB)
#define PG8_SB(b, h) ((4 + (b) * 2 + (h)) * HTB)
#define PG8_STAGE2(bufoff, gbase, o0, o1) do { \
        __builtin_amdgcn_global_load_lds((const unsigned*)((const char*)(gbase) + (o0)), (LAS unsigned*)(lds + (bufoff) + ldsw), 16, 0, 0); \
        __builtin_amdgcn_global_load_lds((const unsigned*)((const char*)(gbase) + (o1)), (LAS unsigned*)(lds + (bufoff) + ldsw + 8192), 16, 0, 0); } while (0)
#define PG8_STAGE_B(bufoff, gbase) PG8_STAGE2(bufoff, gbase, voffB[0], voffB[1])
#define PG8_STAGE_A(bufoff, gbase, h, VA) PG8_STAGE2(bufoff, (gbase) + (GATHER ? (size_t)0 : (size_t)(h) * hstep), VA[GATHER ? (h) : 0][0], VA[GATHER ? (h) : 0][1])
#define PG8_LDA(dst, b, h) do { _Pragma("unroll") for (int m = 0; m < 4; ++m) _Pragma("unroll") for (int k = 0; k < 2; ++k) dst[m][k] = *(const LAS bf16x8*)(lds + PG8_SA(b, h) + aoff + m * 2048 + k * 1024); } while (0)
#define PG8_LDB(dst, b, h) do { _Pragma("unroll") for (int n = 0; n < 2; ++n) _Pragma("unroll") for (int k = 0; k < 2; ++k) dst[n][k] = *(const LAS bf16x8*)(lds + PG8_SB(b, h) + boff + n * 2048 + k * 1024); } while (0)
#define PG8_MMA(ai, bj, At, Bt) do { __builtin_amdgcn_s_setprio(1); _Pragma("unroll") for (int m = 0; m < 4; ++m) _Pragma("unroll") for (int n = 0; n < 2; ++n) { \
        if constexpr (FP8) { typedef int i32x4_ __attribute__((ext_vector_type(4))); typedef int i32x8_ __attribute__((ext_vector_type(8))); \
            const i32x8_ bq = __builtin_shufflevector(__builtin_bit_cast(i32x4_, Bt[n][0]), __builtin_bit_cast(i32x4_, Bt[n][1]), 0, 1, 2, 3, 4, 5, 6, 7); \
            const i32x8_ aq = __builtin_shufflevector(__builtin_bit_cast(i32x4_, At[m][0]), __builtin_bit_cast(i32x4_, At[m][1]), 0, 1, 2, 3, 4, 5, 6, 7); \
            asm volatile("v_mfma_scale_f32_16x16x128_f8f6f4 %0, %1, %2, %0, %3, %4 op_sel_hi:[0,0,0]" : "+v"(acc[ai][bj][m][n]) : "v"(bq), "v"(aq), "v"(scb_), "v"(sca_)); } \
        else { _Pragma("unroll") for (int k = 0; k < 2; ++k) acc[ai][bj][m][n] = __builtin_amdgcn_mfma_f32_16x16x32_bf16(Bt[n][k], At[m][k], acc[ai][bj][m][n], 0, 0, 0); } } \
        __builtin_amdgcn_s_setprio(0); } while (0)
#define PG8_WAIT_V(n) asm volatile("s_waitcnt vmcnt(" #n ")" ::: "memory")
#define PG8_WAIT_L(n) asm volatile("s_waitcnt lgkmcnt(" #n ")" ::: "memory")
#define PG8_BAR __builtin_amdgcn_s_barrier()
#define PG8_SCHED __builtin_amdgcn_sched_barrier(0)
    Unit cur, nxt; int ui = 0;
    if (!S.next(0, cur)) return;
    f32x4 acc[2][2][4][2];
#pragma unroll
    for (int a = 0; a < 2; ++a)
#pragma unroll
        for (int b = 0; b < 2; ++b)
#pragma unroll
            for (int m = 0; m < 4; ++m)
#pragma unroll
                for (int n = 0; n < 2; ++n) acc[a][b][m][n] = (f32x4){0.f, 0.f, 0.f, 0.f};
    bf16x8 At[4][2], B0[2][2], B1[2][2];
    int sca_ = SCA * 0x01010101, scb_ = SCB * 0x01010101;
    unsigned vAc[2][2], vAn[2][2];
    if constexpr (GATHER) { S.gather(cur, sR[0], sR[1], sC[0], sC[1], vAc); }
    else { vAc[0][0] = voffA[0]; vAc[0][1] = voffA[1]; vAc[1][0] = voffA[0]; vAc[1][1] = voffA[1]; }
#pragma unroll
    for (int h = 0; h < 2; ++h) { vAn[h][0] = vAc[h][0]; vAn[h][1] = vAc[h][1]; }
    const char* cA = cur.A; const char* cB = cur.B;
    PG8_STAGE_B(PG8_SB(0, 0), cB); PG8_STAGE_A(PG8_SA(0, 0), cA, 0, vAc); PG8_STAGE_B(PG8_SB(0, 1), cB + hstep); PG8_STAGE_A(PG8_SA(0, 1), cA, 1, vAc);
    if (wr == 1) PG8_BAR;
    PG8_WAIT_V(4); PG8_BAR;
    PG8_STAGE_B(PG8_SB(1, 0), cB + kstep); PG8_STAGE_A(PG8_SA(1, 0), cA + kstep, 0, vAc); PG8_STAGE_B(PG8_SB(1, 1), cB + hstep + kstep);
    PG8_WAIT_V(6); PG8_BAR;
    for (;;) {
        const bool has_next = S.next(ui + 1, nxt);
        const char* nA = has_next ? nxt.A : cA; const char* nB = has_next ? nxt.B : cB;
        if constexpr (GATHER) { if (has_next) S.gather(nxt, sR[0], sR[1], sC[0], sC[1], vAn); }
        for (int t = 0; t < nt; t += 2) {
            const bool last = (t == nt - 2);
            const char* a1 = cA + (size_t)(t + 1) * kstep;
            const char* a2 = last ? nA : cA + (size_t)(t + 2) * kstep; const char* b2 = last ? nB : cB + (size_t)(t + 2) * kstep;
            const char* a3 = a2 + kstep; const char* b3 = b2 + kstep;
            unsigned vA2[2][2];
#pragma unroll
            for (int h = 0; h < 2; ++h) { vA2[h][0] = (GATHER && last) ? vAn[h][0] : vAc[h][0]; vA2[h][1] = (GATHER && last) ? vAn[h][1] : vAc[h][1]; }
            PG8_LDB(B0, 0, 0); PG8_SCHED; PG8_LDA(At, 0, 0); PG8_STAGE_A(PG8_SA(1, 1), a1, 1, vAc);
            PG8_WAIT_L(8); PG8_BAR; PG8_WAIT_L(0); PG8_MMA(0, 0, At, B0); PG8_BAR; PG8_SCHED;
            PG8_LDB(B1, 0, 1); PG8_STAGE_B(PG8_SB(0, 0), b2);
            PG8_BAR; PG8_WAIT_L(0); PG8_MMA(0, 1, At, B1); PG8_BAR;
            PG8_LDA(At, 0, 1); PG8_STAGE_A(PG8_SA(0, 0), a2, 0, vA2);
            PG8_BAR; PG8_WAIT_L(0); PG8_MMA(1, 0, At, B0); PG8_BAR; PG8_SCHED;
            PG8_STAGE_B(PG8_SB(0, 1), b2 + hstep);
            PG8_WAIT_V(6); PG8_BAR; PG8_MMA(1, 1, At, B1); PG8_BAR;
            PG8_LDB(B0, 1, 0); PG8_SCHED; PG8_LDA(At, 1, 0); PG8_STAGE_A(PG8_SA(0, 1), a2, 1, vA2);
            PG8_WAIT_L(8); PG8_BAR; PG8_WAIT_L(0); PG8_MMA(0, 0, At, B0); PG8_BAR; PG8_SCHED;
            PG8_LDB(B1, 1, 1); PG8_STAGE_B(PG8_SB(1, 0), b3);
            PG8_BAR; PG8_WAIT_L(0); PG8_MMA(0, 1, At, B1); PG8_BAR;
            PG8_LDA(At, 1, 1); PG8_STAGE_A(PG8_SA(1, 0), a3, 0, vA2);
            PG8_BAR; PG8_WAIT_L(0); PG8_MMA(1, 0, At, B0); PG8_BAR; PG8_SCHED;
            PG8_STAGE_B(PG8_SB(1, 1), b3 + hstep);
            PG8_WAIT_V(6); PG8_BAR; PG8_MMA(1, 1, At, B1); PG8_BAR;
        }
        if constexpr (FP8) asm volatile("s_nop 15\n\ts_nop 15" ::: "memory");
        E(acc, cur, wr, wc, fr, fq);
        if (!has_next) break;
#pragma unroll
        for (int a = 0; a < 2; ++a)
#pragma unroll
            for (int b = 0; b < 2; ++b)
#pragma unroll
                for (int m = 0; m < 4; ++m)
#pragma unroll
                    for (int n = 0; n < 2; ++n) acc[a][b][m][n] = (f32x4){0.f, 0.f, 0.f, 0.f};
        cur = nxt; cA = nA; cB = nB; ++ui;
        if constexpr (GATHER) {
#pragma unroll
            for (int h = 0; h < 2; ++h) { vAc[h][0] = vAn[h][0]; vAc[h][1] = vAn[h][1]; }
        }
    }
    PG8_WAIT_V(0);
    if (wr == 0) PG8_BAR;
    PG8_BAR;
#undef PG8_SA
#undef PG8_SB
#undef PG8_STAGE2
#undef PG8_STAGE_A
#undef PG8_STAGE_B
#undef PG8_LDA
#undef PG8_LDB
#undef PG8_MMA
#undef PG8_WAIT_V
#undef PG8_WAIT_L
#undef PG8_BAR
#undef PG8_SCHED
}
}


#define XB_TMO      128
#define XB_XCNT(j)  (256  + 64 * (j))
#define XB_XSUB(j)  (1280 + 64 * (j))
#define XB_XGEN(j)  (2304 + 64 * (j))
#define XB_TOP      3328
#define XB_TOPGEN   3392
#define XCD_BAR_WORDS 3456
#define XB_SPIN_CAP (1u << 20)
constexpr int CW_BAR = 4096;
constexpr int LDS_MISC_OFF = 147456 - 64;
__device__ __forceinline__ unsigned xb_ld(unsigned* p)              { return __hip_atomic_load(p, __ATOMIC_RELAXED, __HIP_MEMORY_SCOPE_AGENT); }
__device__ __forceinline__ unsigned xb_add(unsigned* p, unsigned v) { return __hip_atomic_fetch_add(p, v, __ATOMIC_RELAXED, __HIP_MEMORY_SCOPE_AGENT); }
__device__ __forceinline__ unsigned xb_xcc_id() { return (unsigned)__builtin_amdgcn_s_getreg((3 << 11) | 20) & 0xFu; }
#define XB_SPIN(cond, bar) do { unsigned _sp = 0; while (cond) { __builtin_amdgcn_s_sleep(1); \
    if ((++_sp & 255u) == 0u) { if (xb_ld(&(bar)[XB_TMO])) break; if (_sp > XB_SPIN_CAP) { atomicAdd(&(bar)[XB_TMO], 1u); break; } } } } while (0)
struct XcdBarrier { unsigned* bar; unsigned x; volatile LAS unsigned* st; };
__device__ __forceinline__ XcdBarrier xcd_barrier_post(unsigned* bar, volatile LAS unsigned* st) {
    XcdBarrier b; b.bar = bar; b.x = xb_xcc_id(); b.st = st;
    if (threadIdx.x == 0) (void)xb_add(&bar[XB_XCNT(b.x)], 1u);
    return b;
}
__device__ __forceinline__ void xcd_barrier_complete(unsigned* bar, unsigned x, unsigned& nloc, unsigned& nx) {
    const unsigned G = gridDim.x * gridDim.y * gridDim.z;
    unsigned sum, cnt, mine, sp = 0u;
    for (;;) {
        sum = 0u; cnt = 0u; mine = 0u;
#pragma unroll
        for (unsigned j = 0; j < 16; ++j) { const unsigned c = xb_ld(&bar[XB_XCNT(j)]); sum += c; cnt += (c > 0u) ? 1u : 0u; mine = (j == x) ? c : mine; }
        if (sum == G) break;
        __builtin_amdgcn_s_sleep(1);
        if ((++sp & 255u) == 0u) { if (xb_ld(&bar[XB_TMO])) break; if (sp > XB_SPIN_CAP) { atomicAdd(&bar[XB_TMO], 1u); break; } }
    }
    nloc = mine > 0u ? mine : 1u; nx = cnt > 0u ? cnt : 1u;
}
__device__ __forceinline__ void xcd_barrier(const XcdBarrier& b) {
    asm volatile("s_waitcnt vmcnt(0)" ::: "memory");
    __syncthreads();
    if (threadIdx.x == 0) {
        unsigned* bar = b.bar;
        __builtin_amdgcn_s_waitcnt(0);
        unsigned nloc = b.st[0], nx = b.st[1];
        if (nloc == 0u) { xcd_barrier_complete(bar, b.x, nloc, nx); b.st[0] = nloc; b.st[1] = nx; }
        const unsigned old = xb_add(&bar[XB_XSUB(b.x)], 1u);
        const unsigned gen = old / nloc;
        if (old + 1u == (gen + 1u) * nloc) {
            __builtin_amdgcn_fence(__ATOMIC_RELEASE, "agent");
            asm volatile("s_waitcnt vmcnt(0)" ::: "memory");
            const unsigned og = xb_add(&bar[XB_TOP], 1u);
            const unsigned tg = og / nx;
            if (og + 1u == (tg + 1u) * nx) xb_add(&bar[XB_TOPGEN], 1u);
            else XB_SPIN(xb_ld(&bar[XB_TOPGEN]) == tg, bar);
            __builtin_amdgcn_fence(__ATOMIC_ACQUIRE, "agent");
            xb_add(&bar[XB_XGEN(b.x)], 1u);
            asm volatile("s_waitcnt vmcnt(0)" ::: "memory");
        } else {
            XB_SPIN(xb_ld(&bar[XB_XGEN(b.x)]) == gen, bar);
            __builtin_amdgcn_fence(__ATOMIC_ACQUIRE, "agent");
            asm volatile("s_waitcnt vmcnt(0)" ::: "memory");
        }
    }
    __syncthreads();
}

struct Params {
    const float* in[23];
    float* out; unsigned char* ws;
};
struct Frame {
    LAS unsigned char* lds; int tid, lane, wave, vcu, G;
    const Params* p; unsigned char* ws;
};
#define IN_X 0
#define IN_MEM 1
#define IN_NORM_MIX 2
#define IN_W_IN 3
#define IN_AQN 4
#define IN_AKN 5
#define IN_DECF 6
#define IN_DECB 7
#define IN_GNW 8
#define IN_W_OUT 9
#define IN_NORM_MEM 10
#define IN_NORM_MEMKV 11
#define IN_W_MQ 12
#define IN_W_MKV 13
#define IN_MQN 14
#define IN_MKN 15
#define IN_W_MO 16
#define IN_NORM_MOE 17
#define IN_W_GROUP 18
#define IN_W_ROUTER 19
#define IN_W1 20
#define IN_W3 21
#define IN_W2 22

template <class RowMap>
__device__ __forceinline__ void p0_transpose_item(const float* W, int K, int N, bf16_t* WT, const RowMap& rm, const float* kscale, LAS float* scr, int item, int lane) {
    const int nblk = N / 64, kb = item / nblk, nb = item % nblk, k0 = 64 * kb, n0 = 64 * nb;
    const int lr = lane >> 4, lc = (lane & 15) * 4;
    f32x4 v[16];
#pragma unroll
    for (int i = 0; i < 16; ++i) v[i] = *(const f32x4*)(W + (size_t)(k0 + 4 * i + lr) * N + n0 + lc);
#pragma unroll
    for (int i = 0; i < 16; ++i) { const int kk = 4 * i + lr; f32x4 t = v[i]; if (kscale) t = t * kscale[k0 + kk];
        LAS float* d = scr + kk * 65 + lc; d[0] = t.x; d[1] = t.y; d[2] = t.z; d[3] = t.w; }
    LDS_WAIT(); asm volatile("" ::: "memory");
    const int c = lane & 7;
#pragma unroll
    for (int j = 0; j < 8; ++j) { const int n = (lane >> 3) + 8 * j; const LAS float* s = scr + (8 * c) * 65 + n;
        u32x4 o; o.x = cvt_pk_bf16(s[0 * 65], s[1 * 65]); o.y = cvt_pk_bf16(s[2 * 65], s[3 * 65]); o.z = cvt_pk_bf16(s[4 * 65], s[5 * 65]); o.w = cvt_pk_bf16(s[6 * 65], s[7 * 65]);
        *(u32x4*)(WT + (size_t)rm(n0 + n) * K + k0 + 8 * c) = o; }
    LDS_WAIT(); asm volatile("" ::: "memory");
}
template <class RowMap>
__device__ __forceinline__ void p0_transpose_item_fp8(const float* W, int K, int N, unsigned char* WT, const RowMap& rm, const float* kscale, float mul, LAS float* scr, int item, int lane) {
    const int nblk = N / 64, kb = item / nblk, nb = item % nblk, k0 = 64 * kb, n0 = 64 * nb;
    const int lr = lane >> 4, lc = (lane & 15) * 4;
    f32x4 v[16];
#pragma unroll
    for (int i = 0; i < 16; ++i) v[i] = *(const f32x4*)(W + (size_t)(k0 + 4 * i + lr) * N + n0 + lc);
#pragma unroll
    for (int i = 0; i < 16; ++i) { const int kk = 4 * i + lr; const f32x4 t = v[i] * (kscale ? kscale[k0 + kk] * mul : mul);
        LAS float* d = scr + kk * 65 + lc; d[0] = t.x; d[1] = t.y; d[2] = t.z; d[3] = t.w; }
    LDS_WAIT(); asm volatile("" ::: "memory");
    const int c = lane & 7;
#pragma unroll
    for (int j = 0; j < 8; ++j) { const int n = (lane >> 3) + 8 * j; const LAS float* s = scr + (8 * c) * 65 + n;
        int w0 = 0, w1 = 0;
        w0 = __builtin_amdgcn_cvt_pk_fp8_f32(s[0 * 65], s[1 * 65], w0, false); w0 = __builtin_amdgcn_cvt_pk_fp8_f32(s[2 * 65], s[3 * 65], w0, true);
        w1 = __builtin_amdgcn_cvt_pk_fp8_f32(s[4 * 65], s[5 * 65], w1, false); w1 = __builtin_amdgcn_cvt_pk_fp8_f32(s[6 * 65], s[7 * 65], w1, true);
        *(u32x2*)(WT + (size_t)rm(n0 + n) * K + k0 + 8 * c) = (u32x2){(unsigned)w0, (unsigned)w1}; }
    LDS_WAIT(); asm volatile("" ::: "memory");
}
struct RmId { __device__ __forceinline__ int operator()(int n) const { return n; } };
struct RmOff { int off; __device__ __forceinline__ int operator()(int n) const { return n + off; } };
struct RmIn { __device__ __forceinline__ int operator()(int n) const {
        if (n >= 1024) return n;
        const int seg = n >> 9, head = (n & 511) >> 6, dim = n & 63;
        return 256 * (seg * 2 + (head >> 2)) + 128 * (dim >> 5) + 32 * (head & 3) + (dim & 31); } };
struct RmGU { int up; __device__ __forceinline__ int operator()(int f) const { return 256 * (f >> 7) + 128 * up + (f & 127); } };

__device__ __forceinline__ void rms_row_to_bf16(const float* xrow, const float* w, bf16_t* orow, int lane, float* rstd_out = nullptr) {
    const f32x4* xr = (const f32x4*)xrow + lane; const f32x4* wr = (const f32x4*)w + lane;
    f32x4 v[4]; float s = 0.f;
#pragma unroll
    for (int j = 0; j < 4; ++j) { v[j] = xr[64 * j]; s += (v[j].x * v[j].x + v[j].y * v[j].y) + (v[j].z * v[j].z + v[j].w * v[j].w); }
    const float rstd = 1.0f / sqrtf(wave_sum(s) * (1.f / 1024.f) + 1e-6f);
    if (rstd_out && lane == 0) *rstd_out = rstd;
    u32x2* o8 = (u32x2*)orow + lane;
#pragma unroll
    for (int j = 0; j < 4; ++j) { const f32x4 ww = wr[64 * j]; u32x2 o; o.x = cvt_pk_bf16(v[j].x * rstd * ww.x, v[j].y * rstd * ww.y); o.y = cvt_pk_bf16(v[j].z * rstd * ww.z, v[j].w * rstd * ww.w); o8[64 * j] = o; }
}

template <int PART>
__device__ __forceinline__ void p0_prologue(Frame& F) {
    const Params& P = *F.p;
    LAS float* scr = (LAS float*)(F.lds + F.wave * 16640);
    const int gw = F.vcu * NWAVES + F.wave, NGW = F.G * NWAVES;
    constexpr int I_IN = 16 * 48, I_SQ = 16 * 16, I_MKV = 16 * 32, I_E1 = 16 * 8, I_E2 = 8 * 16;
    constexpr int NDENSE = I_IN, NITEMS = I_IN + 3 * I_SQ + I_MKV + NEXP * (2 * I_E1 + I_E2);
    unsigned char* ws = F.ws;
    for (int it = (PART ? NDENSE : 0) + gw; it < (PART ? NITEMS : NDENSE); it += NGW) {
        int r = it;
        if (r < I_IN) { p0_transpose_item(P.in[IN_W_IN], 1024, 3072, (bf16_t*)(ws + WS_WIN), RmIn{}, nullptr, scr, r, F.lane); continue; } r -= I_IN;
        if (r < I_SQ) { p0_transpose_item(P.in[IN_W_OUT], 1024, 1024, (bf16_t*)(ws + WS_WOUT), RmId{}, nullptr, scr, r, F.lane); continue; } r -= I_SQ;
        if (r < I_SQ) { p0_transpose_item(P.in[IN_W_MQ], 1024, 1024, (bf16_t*)(ws + WS_WMQ), RmId{}, P.in[IN_NORM_MEM], scr, r, F.lane); continue; } r -= I_SQ;
        if (r < I_SQ) { p0_transpose_item_fp8(P.in[IN_W_MO], 1024, 1024, (unsigned char*)(ws + WS_WMO), RmId{}, nullptr, 32.f, scr, r, F.lane); continue; } r -= I_SQ;
        if (r < I_MKV) { p0_transpose_item(P.in[IN_W_MKV], 1024, 2048, (bf16_t*)(ws + WS_WMKV), RmId{}, nullptr, scr, r, F.lane); continue; } r -= I_MKV;
        const int e = r / (2 * I_E1 + I_E2); r -= e * (2 * I_E1 + I_E2);
        if (r < I_E1) { p0_transpose_item_fp8(P.in[IN_W1] + (size_t)e * 1024 * 512, 1024, 512, (unsigned char*)(ws + WS_W13) + (size_t)e * 1024 * 1024, RmGU{0}, P.in[IN_NORM_MOE], 32.f, scr, r, F.lane); continue; } r -= I_E1;
        if (r < I_E1) { p0_transpose_item_fp8(P.in[IN_W3] + (size_t)e * 1024 * 512, 1024, 512, (unsigned char*)(ws + WS_W13) + (size_t)e * 1024 * 1024, RmGU{1}, P.in[IN_NORM_MOE], 32.f, scr, r, F.lane); continue; } r -= I_E1;
        p0_transpose_item_fp8(P.in[IN_W2] + (size_t)e * 512 * 1024, 512, 1024, (unsigned char*)(ws + WS_W2) + (size_t)e * 1024 * 512, RmId{}, nullptr, 16.f, scr, r, F.lane);
    }
    if (PART) return;
    for (int i = blockIdx.x * NTHR + F.tid; i < (int)((WS_HSQ + (size_t)NT * 16 - WS_SUMSQ1) / 16); i += F.G * NTHR) ((u32x4*)(ws + WS_SUMSQ1))[i] = (u32x4){0u, 0u, 0u, 0u};
    for (int i = blockIdx.x * NTHR + F.tid; i < 48 * 1024; i += F.G * NTHR) { const int c = i >> 10, k = i & 1023; float v = 0.f;
        if (c < 4) v = P.in[IN_W_GROUP][(size_t)k * 4 + c]; else if (c < 36) v = P.in[IN_W_ROUTER][((size_t)((c - 4) >> 3) * 1024 + k) * 8 + ((c - 4) & 7)];
        v *= P.in[IN_NORM_MOE][k];
        const unsigned hi = cvt_pk_bf16(v, 0.f) & 0xffffu; const float rem = v - __uint_as_float(hi << 16);
        ((bf16_t*)(ws + WS_WRT))[i] = (bf16_t)hi; ((bf16_t*)(ws + WS_WRT))[48 * 1024 + i] = (bf16_t)(cvt_pk_bf16(rem, 0.f) & 0xffffu); }
    for (int m = gw; m < NT; m += NGW) rms_row_to_bf16(P.in[IN_X] + (size_t)m * DM, P.in[IN_NORM_MIX], (bf16_t*)P.out + (size_t)m * DM, F.lane, (float*)(ws + WS_RSTD0) + m);
    for (int m = gw; m < NB * NMEM; m += NGW) rms_row_to_bf16(P.in[IN_MEM] + (size_t)m * DM, P.in[IN_NORM_MEMKV], (bf16_t*)(ws + WS_MEMH) + (size_t)m * DM, F.lane);
}

struct EpiInProj {
    static constexpr bool PERM = true;
    unsigned char* ws; const float* qnw; const float* knw;
    __device__ __forceinline__ void operator()(const f32x4 (&acc)[2][2][4][2], const pg8::Unit& u, int wr, int wc, int fr, int fq) const {
        const int pn = u.pn; const int row0 = u.pm * 256 + wr * 64 + fr;
        if (pn < 4) {
            const float* nw = pn < 2 ? qnw : knw; const float sc = pn < 2 ? 0.125f * 1.44269504089f : 1.0f;
            bf16_t* dst = (bf16_t*)(ws + (pn < 2 ? WS_AQ : WS_AK)); const int head = 4 * (pn & 1) + wc;
            f32x4 w4[2][2];
#pragma unroll
            for (int bj = 0; bj < 2; ++bj)
#pragma unroll
                for (int n = 0; n < 2; ++n) w4[bj][n] = *(const f32x4*)(nw + 32 * bj + 8 * fq + 4 * n);
#pragma unroll
            for (int ai = 0; ai < 2; ++ai)
#pragma unroll
                for (int m = 0; m < 4; ++m) {
                    float ss = 0.f;
#pragma unroll
                    for (int bj = 0; bj < 2; ++bj)
#pragma unroll
                        for (int n = 0; n < 2; ++n) { const f32x4 v = acc[ai][bj][m][n]; ss += (v.x * v.x + v.y * v.y) + (v.z * v.z + v.w * v.w); }
                    ss = sum_g4(ss);
                    const float rs = sc / sqrtf(ss * (1.f / 64.f) + 1e-6f);
                    bf16_t* rowp = dst + (size_t)(row0 + ai * 128 + m * 16) * 512 + head * 64 + 8 * fq;
#pragma unroll
                    for (int bj = 0; bj < 2; ++bj) { const f32x4 v0 = acc[ai][bj][m][0] * rs * w4[bj][0], v1 = acc[ai][bj][m][1] * rs * w4[bj][1];
                        u32x4 w; w.x = cvt_pk_bf16(v0.x, v0.y); w.y = cvt_pk_bf16(v0.z, v0.w); w.z = cvt_pk_bf16(v1.x, v1.y); w.w = cvt_pk_bf16(v1.z, v1.w);
                        *(u32x4*)(rowp + 32 * bj) = w; }
                }
        } else {
            bf16_t* dst; int ld, c0; float sc = 1.f; bool act = false;
            if (pn < 6) { dst = (bf16_t*)(ws + WS_AV); ld = 512; c0 = (pn - 4) * 256; }
            else if (pn == 6) { dst = (bf16_t*)(ws + WS_RQ); ld = 256; c0 = 0; }
            else if (pn == 7) { dst = (bf16_t*)(ws + WS_RK); ld = 256; c0 = 0; sc = 0.125f; }
            else if (pn < 10) { dst = (bf16_t*)(ws + WS_RV); ld = 512; c0 = (pn - 8) * 256; }
            else { dst = (bf16_t*)(ws + WS_RG); ld = 512; c0 = (pn - 10) * 256; act = true; }
#pragma unroll
            for (int ai = 0; ai < 2; ++ai)
#pragma unroll
                for (int m = 0; m < 4; ++m) {
                    bf16_t* rowp = dst + (size_t)(row0 + ai * 128 + m * 16) * ld + c0 + wc * 32 + 8 * fq;
#pragma unroll
                    for (int bj = 0; bj < 2; ++bj) { f32x4 v0 = acc[ai][bj][m][0] * sc, v1 = acc[ai][bj][m][1] * sc;
                        if (act) { v0.x = silu_f(v0.x); v0.y = silu_f(v0.y); v0.z = silu_f(v0.z); v0.w = silu_f(v0.w); v1.x = silu_f(v1.x); v1.y = silu_f(v1.y); v1.z = silu_f(v1.z); v1.w = silu_f(v1.w); }
                        u32x4 w; w.x = cvt_pk_bf16(v0.x, v0.y); w.y = cvt_pk_bf16(v0.z, v0.w); w.z = cvt_pk_bf16(v1.x, v1.y); w.w = cvt_pk_bf16(v1.z, v1.w);
                        *(u32x4*)(rowp + 128 * bj) = w; }
                }
        }
    }
};


__device__ __forceinline__ void tr_read8(unsigned addr, bf16x4 (&r)[8]) {
    asm volatile("ds_read_b64_tr_b16 %0, %8\n\tds_read_b64_tr_b16 %1, %8 offset:32\n\tds_read_b64_tr_b16 %2, %8 offset:64\n\tds_read_b64_tr_b16 %3, %8 offset:96\n\t"
                 "ds_read_b64_tr_b16 %4, %8 offset:2048\n\tds_read_b64_tr_b16 %5, %8 offset:2080\n\tds_read_b64_tr_b16 %6, %8 offset:2112\n\tds_read_b64_tr_b16 %7, %8 offset:2144\n\t"
                 "s_waitcnt lgkmcnt(0)"
                 : "=&v"(r[0]), "=&v"(r[1]), "=&v"(r[2]), "=&v"(r[3]), "=&v"(r[4]), "=&v"(r[5]), "=&v"(r[6]), "=&v"(r[7]) : "v"(addr) : "memory");
}
__device__ __forceinline__ void tr_read8_issue(unsigned addr, bf16x4 (&r)[8]) {
    asm volatile("ds_read_b64_tr_b16 %0, %8\n\tds_read_b64_tr_b16 %1, %8 offset:32\n\tds_read_b64_tr_b16 %2, %8 offset:64\n\tds_read_b64_tr_b16 %3, %8 offset:96\n\t"
                 "ds_read_b64_tr_b16 %4, %8 offset:2048\n\tds_read_b64_tr_b16 %5, %8 offset:2080\n\tds_read_b64_tr_b16 %6, %8 offset:2112\n\tds_read_b64_tr_b16 %7, %8 offset:2144"
                 : "=&v"(r[0]), "=&v"(r[1]), "=&v"(r[2]), "=&v"(r[3]), "=&v"(r[4]), "=&v"(r[5]), "=&v"(r[6]), "=&v"(r[7]) : "v"(addr) : "memory");
}
__device__ __forceinline__ void tr_read8_wait(bf16x4 (&r)[8]) {
    asm volatile("s_waitcnt lgkmcnt(0)" : "+v"(r[0]), "+v"(r[1]), "+v"(r[2]), "+v"(r[3]), "+v"(r[4]), "+v"(r[5]), "+v"(r[6]), "+v"(r[7]) :: "memory");
}
__device__ __forceinline__ bf16x8 cat4(bf16x4 a, bf16x4 b) { return __builtin_shufflevector(a, b, 0, 1, 2, 3, 4, 5, 6, 7); }
constexpr int ACC_LD = 136;
constexpr int ATT_TOK = 512;
constexpr int ATT_ACC_BYTES = ATT_TOK * ACC_LD;
constexpr int ATT_VBUF_OFF = ATT_ACC_BYTES;

struct AttRing { bf16x8 kf[2][2][2]; u32x4 vst[2][4]; bf16x8 qn[2][2]; };
struct AttItem { const bf16_t* Qb; int d, r, jq0, L; };
constexpr size_t ATT_K_OFF = (WS_AK - WS_AQ) / 2, ATT_V_OFF = (WS_AV - WS_AQ) / 2;
template <int B>
__device__ __forceinline__ void att_ring_load(AttRing& R, const AttItem& it, int P, int lane) {
    asm volatile("" : "+v"(lane));
    const int g = lane >> 4, li = lane & 15, sc = lane & 7, sr = lane >> 3;
    const bf16_t* Kb = it.Qb + ATT_K_OFF; const bf16_t* Vb = it.Qb + ATT_V_OFF; const int jb = it.jq0 - 64 + 32 * P;
#pragma unroll
    for (int t = 0; t < 2; ++t) { int jk = jb + 16 * t + li; jk = jk < 0 ? 0 : (jk >= it.L ? it.L - 1 : jk); const bf16_t* kp = Kb + (size_t)(it.r + it.d * jk) * 512 + 8 * g;
        R.kf[B][t][0] = *(const bf16x8*)kp; R.kf[B][t][1] = *(const bf16x8*)(kp + 32); }
#pragma unroll
    for (int i = 0; i < 4; ++i) { int jk = jb + sr + 8 * i; jk = jk < 0 ? 0 : (jk >= it.L ? it.L - 1 : jk); R.vst[B][i] = *(const u32x4*)(Vb + (size_t)(it.r + it.d * jk) * 512 + 8 * sc); }
}
template <int NQ>
__device__ __forceinline__ void att_q_load(AttRing& R, const AttItem& it, int lane) {
    asm volatile("" : "+v"(lane));
    const int g = lane >> 4, li = lane & 15;
#pragma unroll
    for (int q = 0; q < NQ; ++q)
#pragma unroll
        for (int ks = 0; ks < 2; ++ks) R.qn[q][ks] = *(const bf16x8*)(it.Qb + (size_t)(it.r + it.d * (it.jq0 + 16 * q + li)) * 512 + 32 * ks + 8 * g);
}
template <int NQ, bool EDGE, int mode, int PAR, int NQN>
__device__ __forceinline__ void attn_item_r(AttRing& R, const AttItem& it, const AttItem& nx, float slope2  , unsigned m2w  ,
                                            LAS float* ACC, int T0, LAS unsigned char* vbuf  , bf16_t* mixrow0  , int lane) {
    asm volatile("" : "+v"(lane));
    const int g = lane >> 4, li = lane & 15;
    const int jq0 = it.jq0, L = it.L;
    const unsigned s2b = cvt_pk_bf16(slope2, 0.f) & 0xffffu;
    const float s2r = __builtin_bit_cast(float, s2b << 16);
    const unsigned gm = g == 0 ? 0xffffffffu : 0u;
    int tq[NQ]; bf16x8 qf[NQ][2], qa[NQ]; f32x4 o[NQ][4], ol[NQ];
#pragma unroll
    for (int q = 0; q < NQ; ++q) { tq[q] = it.r + it.d * (jq0 + 16 * q + li); qf[q][0] = R.qn[q][0]; qf[q][1] = R.qn[q][1];
        u32x4 a; a.x = ((__builtin_bit_cast(unsigned, (float)(16 * q + li)) >> 16) | (s2b << 16)) & gm; a.y = 0x3F80u & gm; a.z = 0u; a.w = 0u; qa[q] = __builtin_bit_cast(bf16x8, a);
#pragma unroll
        for (int dt = 0; dt < 4; ++dt) o[q][dt] = (f32x4){0.f, 0.f, 0.f, 0.f};
        ol[q] = (f32x4){0.f, 0.f, 0.f, 0.f}; }
    float kbase = (float)(li - 64), delta0 = (float)(4 * g - li); asm volatile("" : "+v"(kbase), "+v"(delta0));
    const unsigned kw0 = (s2b | 0x8000u) & gm, kmask = 0xffff0000u & gm, kflip = 0x80008000u & gm, kw1 = m2w & gm;
    u32x4 onesw; onesw.x = 0x3F803F80u; onesw.y = 0x3F803F80u; onesw.z = 0x3F803F80u; onesw.w = 0x3F803F80u; const bf16x8 ones = __builtin_bit_cast(bf16x8, onesw);
    const unsigned vaddr = (unsigned)(size_t)vbuf + (unsigned)((4 * g + (li >> 2)) * 128 + (li & 3) * 8);
    const int sc = lane & 7, sr = lane >> 3;
#pragma unroll
    for (int P = 0; P < 5; ++P) {
        const int B = (P + PAR) & 1; const int jb = jq0 - 64 + 32 * P;
        if (P < 4) { if (B) att_ring_load<0>(R, it, P + 1, lane); else att_ring_load<1>(R, it, P + 1, lane); }
        else if (NQN) { if (B) att_ring_load<0>(R, nx, 0, lane); else att_ring_load<1>(R, nx, 0, lane); att_q_load<NQN ? NQN : 1>(R, nx, lane); }
        bf16x4 vr[8]; tr_read8_issue(vaddr + B * 4096, vr);
        bf16x8 pb[NQ];
#pragma unroll
        for (int q = 0; q < NQ; ++q) {
            float p[8];
#pragma unroll
            for (int t = 0; t < 2; ++t) {
                const int c = 2 * P + t - q;
                if (c < 0 || c > 8) {
#pragma unroll
                    for (int e = 0; e < 4; ++e) p[t * 4 + e] = 0.f;
                } else {
                    u32x4 kw; kw.x = (__builtin_bit_cast(unsigned, kbase + (float)(32 * P + 16 * t)) & kmask) | kw0; if (c >= 5) kw.x ^= kflip;
                    kw.y = kw1; kw.z = 0u; kw.w = 0u;
                    f32x4 st = __builtin_amdgcn_mfma_f32_16x16x32_bf16(R.kf[B][t][0], qf[q][0], (f32x4){0.f, 0.f, 0.f, 0.f}, 0, 0, 0);
                    st = __builtin_amdgcn_mfma_f32_16x16x32_bf16(R.kf[B][t][1], qf[q][1], st, 0, 0, 0);
                    st = __builtin_amdgcn_mfma_f32_16x16x32_bf16(__builtin_bit_cast(bf16x8, kw), qa[q], st, 0, 0, 0);
#pragma unroll
                    for (int e = 0; e < 4; ++e) { float x = st[e];
                        if (c == 4) x = __builtin_fmaf(__builtin_fmaxf(delta0 + (float)e, 0.f), -2.f * s2r, x);
                        float v = __builtin_amdgcn_exp2f(x);
                        if (c == 0) v = (delta0 + (float)e < 0.f) ? 0.f : v;
                        if (c == 8) v = (delta0 + (float)e > 0.f) ? 0.f : v;
                        if (EDGE) { const int jk = jb + 16 * t + 4 * g + e; v = ((unsigned)jk < (unsigned)L) ? v : 0.f; }
                        p[t * 4 + e] = v; }
                }
            }
            u32x4 pw; pw.x = cvt_pk_bf16(p[0], p[1]); pw.y = cvt_pk_bf16(p[2], p[3]); pw.z = cvt_pk_bf16(p[4], p[5]); pw.w = cvt_pk_bf16(p[6], p[7]);
            pb[q] = __builtin_bit_cast(bf16x8, pw);
        }
        tr_read8_wait(vr);
        __builtin_amdgcn_sched_barrier(0);
#pragma unroll
        for (int dt = 0; dt < 4; ++dt) { const bf16x8 vf = cat4(vr[dt], vr[4 + dt]);
#pragma unroll
            for (int q = 0; q < NQ; ++q) o[q][dt] = __builtin_amdgcn_mfma_f32_16x16x32_bf16(vf, pb[q], o[q][dt], 0, 0, 0); }
#pragma unroll
        for (int q = 0; q < NQ; ++q) ol[q] = __builtin_amdgcn_mfma_f32_16x16x32_bf16(ones, pb[q], ol[q], 0, 0, 0);
        if (P < 4 || NQN) {
#pragma unroll
            for (int i = 0; i < 4; ++i) *(LAS u32x4*)(vbuf + (B ^ 1) * 4096 + (sr + 8 * i) * 128 + sc * 16) = R.vst[B ^ 1][i]; }
    }
#pragma unroll
    for (int q = 0; q < NQ; ++q) {
        const float ls = ol[q][0];
        LAS unsigned char* arow = (LAS unsigned char*)ACC + (tq[q] - T0) * ACC_LD;
        if (mode == 0) {
#pragma unroll
            for (int dt = 0; dt < 4; ++dt) { u32x2 w; w.x = cvt_pk_bf16_c(o[q][dt].x, o[q][dt].y); w.y = cvt_pk_bf16_c(o[q][dt].z, o[q][dt].w); *(LAS u32x2*)(arow + 32 * dt + 8 * g) = w; }
            if (g == 0) *(LAS float*)(arow + 128) = ls;
        } else if (mode == 1) {
#pragma unroll
            for (int dt = 0; dt < 4; ++dt) { const u32x2 a = *(LAS u32x2*)(arow + 32 * dt + 8 * g);
                u32x2 w; w.x = cvt_pk_bf16_c(bflo(a.x) + o[q][dt].x, bfhi(a.x) + o[q][dt].y); w.y = cvt_pk_bf16_c(bflo(a.y) + o[q][dt].z, bfhi(a.y) + o[q][dt].w); *(LAS u32x2*)(arow + 32 * dt + 8 * g) = w; }
            if (g == 0) *(LAS float*)(arow + 128) += ls;
        } else {
            const float inv = 1.0f / (*(LAS float*)(arow + 128) + ls);
            bf16_t* orow = mixrow0 + (size_t)tq[q] * 1024;
#pragma unroll
            for (int dt = 0; dt < 4; ++dt) { const u32x2 a = *(LAS u32x2*)(arow + 32 * dt + 8 * g);
                u32x2 w; w.x = cvt_pk_bf16_c((bflo(a.x) + o[q][dt].x) * inv, (bfhi(a.x) + o[q][dt].y) * inv); w.y = cvt_pk_bf16_c((bflo(a.y) + o[q][dt].z) * inv, (bfhi(a.y) + o[q][dt].w) * inv);
                *(u32x2*)(orow + 16 * dt + 4 * g) = w; }
        }
    }
}
template <int NQ, int mode, int PAR, int NQN>
__device__ __forceinline__ void attn_item_d(AttRing& R, const AttItem& it, const AttItem& nx, float slope2, unsigned M2, LAS float* ACC, int T0, LAS unsigned char* vbuf, bf16_t* mixrow0, int lane) {
    if (it.jq0 - 64 < 0 || it.jq0 + 96 > it.L) attn_item_r<NQ, true, mode, PAR, NQN>(R, it, nx, slope2, M2, ACC, T0, vbuf, mixrow0, lane);
    else attn_item_r<NQ, false, mode, PAR, NQN>(R, it, nx, slope2, M2, ACC, T0, vbuf, mixrow0, lane);
}

template <int VAR>
__device__ __forceinline__ void p2_attention(Frame& F, bf16_t* mixbase) {
    const Params& P = *F.p; const int lane = F.lane, w = F.wave;
    LAS float* ACC = (LAS float*)F.lds; LAS unsigned char* vbuf = F.lds + ATT_VBUF_OFF + w * 8192;
    float mq = fabsf(P.in[IN_AQN][lane]), mk = fabsf(P.in[IN_AKN][lane]);
    mq = wave_max(mq); mk = wave_max(mk);
    const unsigned M2 = cvt_pk_bf16(-8.0f * mq * mk * 1.44269504089f, 0.f) & 0xffffu;
    AttRing R;
#define ATT_QB(U_) ((const bf16_t*)(F.ws + WS_AQ) + (size_t)((U_) >> 8) * SEQ * 512 + (((U_) >> 5) & 7) * 64)
#define ATT_L(n_) (VAR == 1 ? 32 : (n_))
    int U = F.vcu;
    if (U < 512) { const AttItem a0{ATT_QB(U), 16, 2 * w, ((U & 31) * ATT_TOK) / 16, ATT_L(SEQ / 16)}; att_ring_load<0>(R, a0, 0, lane); att_q_load<2>(R, a0, lane);
        const int sc = lane & 7, sr = lane >> 3;
#pragma unroll
        for (int i = 0; i < 4; ++i) *(LAS u32x4*)(vbuf + (sr + 8 * i) * 128 + sc * 16) = R.vst[0][i]; }
    for (; U < 512; U += F.G) {
        const int bh = U >> 5, blk = U & 31, b = bh >> 3, h = bh & 7, T0 = blk * ATT_TOK;
        const bf16_t* Qb = ATT_QB(U);
        bf16_t* mix = mixbase + (size_t)b * SEQ * 1024 + h * 64;
        const float slope = __builtin_amdgcn_exp2f(-(float)(h + 1)) * 1.44269504089f;
        const AttItem iA{Qb, 16, 2 * w, T0 / 16, ATT_L(SEQ / 16)}, iB{Qb, 16, 2 * w + 1, T0 / 16, ATT_L(SEQ / 16)};
        const AttItem iC{Qb, 4, w >> 1, T0 / 4 + 64 * (w & 1), ATT_L(SEQ / 4)}, iD{Qb, 4, w >> 1, T0 / 4 + 64 * (w & 1) + 32, ATT_L(SEQ / 4)};
        const AttItem iE{Qb, 1, 0, T0 + 64 * w, ATT_L(SEQ)}, iF{Qb, 1, 0, T0 + 64 * w + 32, ATT_L(SEQ)};
        const int Un = (U + F.G < 512) ? U + F.G : U;
        const AttItem nA{ATT_QB(Un), 16, 2 * w, ((Un & 31) * ATT_TOK) / 16, ATT_L(SEQ / 16)};
        attn_item_d<2, 0, 0, 2>(R, iA, iB, slope * 16.f, M2, ACC, T0, vbuf, mix, lane);
        attn_item_d<2, 0, 1, 2>(R, iB, iC, slope * 16.f, M2, ACC, T0, vbuf, mix, lane);
        __syncthreads();
        attn_item_d<2, 1, 0, 2>(R, iC, iD, slope * 4.f, M2, ACC, T0, vbuf, mix, lane);
        attn_item_d<2, 1, 1, 2>(R, iD, iE, slope * 4.f, M2, ACC, T0, vbuf, mix, lane);
        __syncthreads();
        attn_item_d<2, 2, 0, 2>(R, iE, iF, slope, M2, ACC, T0, vbuf, mix, lane);
        attn_item_d<2, 2, 1, 2>(R, iF, nA, slope, M2, ACC, T0, vbuf, mix, lane);
        __syncthreads();
    }
#undef ATT_QB
#undef ATT_L
}

template <int ROWB>
__device__ __forceinline__ bf16x8 tr_read2(unsigned addr) {
    bf16x4 a, b;
    asm volatile("ds_read_b64_tr_b16 %0, %2\n\tds_read_b64_tr_b16 %1, %2 offset:%3\n\ts_waitcnt lgkmcnt(0)" : "=&v"(a), "=&v"(b) : "v"(addr), "i"(16 * ROWB) : "memory");
    return cat4(a, b);
}
template <int ROWB, int STEP>
__device__ __forceinline__ void tr_read2x8(unsigned addr, bf16x8 (&f)[8]) {
    bf16x4 a[8], b[8];
    asm volatile("ds_read_b64_tr_b16 %0, %16\n\tds_read_b64_tr_b16 %8, %16 offset:%17\n\t"
                 "ds_read_b64_tr_b16 %1, %16 offset:%18\n\tds_read_b64_tr_b16 %9, %16 offset:%19\n\t"
                 "ds_read_b64_tr_b16 %2, %16 offset:%20\n\tds_read_b64_tr_b16 %10, %16 offset:%21\n\t"
                 "ds_read_b64_tr_b16 %3, %16 offset:%22\n\tds_read_b64_tr_b16 %11, %16 offset:%23\n\t"
                 "ds_read_b64_tr_b16 %4, %16 offset:%24\n\tds_read_b64_tr_b16 %12, %16 offset:%25\n\t"
                 "ds_read_b64_tr_b16 %5, %16 offset:%26\n\tds_read_b64_tr_b16 %13, %16 offset:%27\n\t"
                 "ds_read_b64_tr_b16 %6, %16 offset:%28\n\tds_read_b64_tr_b16 %14, %16 offset:%29\n\t"
                 "ds_read_b64_tr_b16 %7, %16 offset:%30\n\tds_read_b64_tr_b16 %15, %16 offset:%31\n\t"
                 "s_waitcnt lgkmcnt(0)"
                 : "=&v"(a[0]), "=&v"(a[1]), "=&v"(a[2]), "=&v"(a[3]), "=&v"(a[4]), "=&v"(a[5]), "=&v"(a[6]), "=&v"(a[7]),
                   "=&v"(b[0]), "=&v"(b[1]), "=&v"(b[2]), "=&v"(b[3]), "=&v"(b[4]), "=&v"(b[5]), "=&v"(b[6]), "=&v"(b[7])
                 : "v"(addr), "i"(16 * ROWB), "i"(1 * STEP), "i"(1 * STEP + 16 * ROWB), "i"(2 * STEP), "i"(2 * STEP + 16 * ROWB), "i"(3 * STEP), "i"(3 * STEP + 16 * ROWB),
                   "i"(4 * STEP), "i"(4 * STEP + 16 * ROWB), "i"(5 * STEP), "i"(5 * STEP + 16 * ROWB), "i"(6 * STEP), "i"(6 * STEP + 16 * ROWB), "i"(7 * STEP), "i"(7 * STEP + 16 * ROWB)
                 : "memory");
#pragma unroll
    for (int i = 0; i < 8; ++i) f[i] = cat4(a[i], b[i]);
}
template <int ROWB, int STEP>
__device__ __forceinline__ void tr_read2x4(unsigned addr, bf16x8 (&f)[4]) {
    bf16x4 a[4], b[4];
    asm volatile("ds_read_b64_tr_b16 %0, %8\n\tds_read_b64_tr_b16 %4, %8 offset:%9\n\t"
                 "ds_read_b64_tr_b16 %1, %8 offset:%10\n\tds_read_b64_tr_b16 %5, %8 offset:%11\n\t"
                 "ds_read_b64_tr_b16 %2, %8 offset:%12\n\tds_read_b64_tr_b16 %6, %8 offset:%13\n\t"
                 "ds_read_b64_tr_b16 %3, %8 offset:%14\n\tds_read_b64_tr_b16 %7, %8 offset:%15\n\t"
                 "s_waitcnt lgkmcnt(0)"
                 : "=&v"(a[0]), "=&v"(a[1]), "=&v"(a[2]), "=&v"(a[3]), "=&v"(b[0]), "=&v"(b[1]), "=&v"(b[2]), "=&v"(b[3])
                 : "v"(addr), "i"(16 * ROWB), "i"(1 * STEP), "i"(1 * STEP + 16 * ROWB), "i"(2 * STEP), "i"(2 * STEP + 16 * ROWB), "i"(3 * STEP), "i"(3 * STEP + 16 * ROWB)
                 : "memory");
#pragma unroll
    for (int i = 0; i < 4; ++i) f[i] = cat4(a[i], b[i]);
}
__device__ __forceinline__ float log2_sigmoid(float x) { return -log2f(1.0f + expf(-x)); }

__device__ __forceinline__ void p2_chunk_kv(Frame& F) {
    const Params& P = *F.p; const int lane = F.lane, w = F.wave, tid = F.tid, g = lane >> 4, li = lane & 15;
    LAS unsigned char* Vl = F.lds;
    LAS unsigned char* Kf = F.lds + 32768;
    LAS unsigned char* Kbk = F.lds + 32768 + 16384;
    u32x4 rv[4], rk[2];
#define P2B_LOAD(U) do { const int bh_ = (U) >> 7, n_ = (U) & 127, b_ = bh_ >> 2, h_ = bh_ & 3; const size_t row0_ = (size_t)b_ * SEQ + (size_t)n_ * 128; \
        const bf16_t* Vg_ = (const bf16_t*)(F.ws + WS_RV) + row0_ * 512 + h_ * 128; const bf16_t* Kg_ = (const bf16_t*)(F.ws + WS_RK) + row0_ * 256 + h_ * 64; \
        _Pragma("unroll") for (int i = 0; i < 4; ++i) { const int c = tid + 512 * i; rv[i] = *(const u32x4*)(Vg_ + (size_t)(c >> 4) * 512 + (c & 15) * 8); } \
        _Pragma("unroll") for (int i = 0; i < 2; ++i) { const int c = tid + 512 * i; rk[i] = *(const u32x4*)(Kg_ + (size_t)(c >> 3) * 256 + (c & 7) * 8); } } while (0)
    int U = F.vcu;
    if (U < 1024) P2B_LOAD(U);
    for (; U < 1024; U += F.G) {
        const int bh = U >> 7, h = bh & 3;
        const float l2f = log2_sigmoid(P.in[IN_DECF][h]), l2b = log2_sigmoid(P.in[IN_DECB][h]);
#pragma unroll
        for (int i = 0; i < 4; ++i) { const int c = tid + 512 * i, j = c >> 4, cc = c & 15; *(LAS u32x4*)(Vl + j * 256 + cc * 16) = rv[i]; }
#pragma unroll
        for (int i = 0; i < 2; ++i) { const int c = tid + 512 * i, j = c >> 3, cc = c & 7; const u32x4 kv = rk[i];
            const float wf = __builtin_amdgcn_exp2f(l2f * (float)(127 - j)), wb = __builtin_amdgcn_exp2f(l2b * (float)j);
            u32x4 a, bq;
            a.x = cvt_pk_bf16(bflo(kv.x) * wf, bfhi(kv.x) * wf); a.y = cvt_pk_bf16(bflo(kv.y) * wf, bfhi(kv.y) * wf); a.z = cvt_pk_bf16(bflo(kv.z) * wf, bfhi(kv.z) * wf); a.w = cvt_pk_bf16(bflo(kv.w) * wf, bfhi(kv.w) * wf);
            bq.x = cvt_pk_bf16(bflo(kv.x) * wb, bfhi(kv.x) * wb); bq.y = cvt_pk_bf16(bflo(kv.y) * wb, bfhi(kv.y) * wb); bq.z = cvt_pk_bf16(bflo(kv.z) * wb, bfhi(kv.z) * wb); bq.w = cvt_pk_bf16(bflo(kv.w) * wb, bfhi(kv.w) * wb);
            *(LAS u32x4*)(Kf + j * 128 + cc * 16) = a; *(LAS u32x4*)(Kbk + j * 128 + cc * 16) = bq; }
        __syncthreads();
        const int Un = U + F.G;
        if (Un < 1024) P2B_LOAD(Un);
        f32x4 acc[2][4];
#pragma unroll
        for (int dir = 0; dir < 2; ++dir)
#pragma unroll
            for (int dt = 0; dt < 4; ++dt) acc[dir][dt] = (f32x4){0.f, 0.f, 0.f, 0.f};
        const unsigned va = (unsigned)(size_t)Vl + (unsigned)((4 * g + (li >> 2)) * 256 + (16 * w + 4 * (li & 3)) * 2);
        const unsigned kaf = (unsigned)(size_t)Kf + (unsigned)((4 * g + (li >> 2)) * 128 + (4 * (li & 3)) * 2);
        const unsigned kab = (unsigned)(size_t)Kbk + (unsigned)((4 * g + (li >> 2)) * 128 + (4 * (li & 3)) * 2);
#pragma unroll
        for (int ks = 0; ks < 4; ++ks) {
            const bf16x8 af = tr_read2<256>(va + ks * 32 * 256);
            bf16x8 b0[4], b1[4]; tr_read2x4<128, 32>(kaf + ks * 32 * 128, b0); tr_read2x4<128, 32>(kab + ks * 32 * 128, b1);
#pragma unroll
            for (int dt = 0; dt < 4; ++dt) {
                acc[0][dt] = __builtin_amdgcn_mfma_f32_16x16x32_bf16(af, b0[dt], acc[0][dt], 0, 0, 0);
                acc[1][dt] = __builtin_amdgcn_mfma_f32_16x16x32_bf16(af, b1[dt], acc[1][dt], 0, 0, 0);
            }
        }
#pragma unroll
        for (int dir = 0; dir < 2; ++dir) { float* dst = (float*)(F.ws + WS_KV) + ((size_t)dir * 1024 + U) * 8192;
#pragma unroll
            for (int dt = 0; dt < 4; ++dt)
#pragma unroll
                for (int e = 0; e < 4; ++e) dst[(16 * w + 4 * g + e) * 64 + 16 * dt + li] = acc[dir][dt][e]; }
        __syncthreads();
    }
#undef P2B_LOAD
}

__device__ __forceinline__ void p3_scan(Frame& F) {
    const Params& P = *F.p;
    for (int gt = blockIdx.x * NTHR + F.tid; gt < 2 * 8 * 8192; gt += F.G * NTHR) {
        const int dir = gt >> 16, bh = (gt >> 13) & 7, el = gt & 8191, h = bh & 3;
        const float dec = __builtin_amdgcn_exp2f(128.f * log2_sigmoid(P.in[dir ? IN_DECB : IN_DECF][h]));
        const float* kv = (const float*)(F.ws + WS_KV) + ((size_t)dir * 1024 + bh * 128) * 8192 + el;
        bf16_t* st = (bf16_t*)(F.ws + WS_ST) + ((size_t)dir * 1024 + bh * 128) * 8192 + el;
        float s = 0.f;
        for (int c0 = 0; c0 < 128; c0 += 64) {
            float v[64];
#pragma unroll
            for (int i = 0; i < 64; ++i) { const int n = dir ? 127 - (c0 + i) : c0 + i; v[i] = kv[(size_t)n * 8192]; }
#pragma unroll
            for (int i = 0; i < 64; ++i) { const int n = dir ? 127 - (c0 + i) : c0 + i; st[(size_t)n * 8192] = (bf16_t)(cvt_pk_bf16(s, 0.f) & 0xffffu); s = s * dec + v[i]; }
        }
    }
}

constexpr int P4_V = 0, P4_K = 32768, P4_SF = 49152, P4_SB = 65536;
__device__ __forceinline__ void p4_retention_out(Frame& F) {
    const Params& P = *F.p; const int lane = F.lane, w = F.wave, tid = F.tid, g = lane >> 4, li = lane & 15;
    LAS unsigned char* L = F.lds;
    u32x4 rv[4], rk[2], rf[2], rb[2]; bf16x8 qn[2];
    const int iq = 16 * w + li;
#define P4_LOAD(U) do { const int bh_ = (U) >> 7, n_ = (U) & 127, b_ = bh_ >> 2, h_ = bh_ & 3; const size_t row0_ = (size_t)b_ * SEQ + (size_t)n_ * 128; \
        const bf16_t* Vg_ = (const bf16_t*)(F.ws + WS_RV) + row0_ * 512 + h_ * 128; const bf16_t* Kg_ = (const bf16_t*)(F.ws + WS_RK) + row0_ * 256 + h_ * 64; \
        const bf16_t* Qg_ = (const bf16_t*)(F.ws + WS_RQ) + row0_ * 256 + h_ * 64; \
        const bf16_t* Sf_ = (const bf16_t*)(F.ws + WS_ST) + (size_t)(U) * 8192; const bf16_t* Sb_ = Sf_ + (size_t)1024 * 8192; \
        _Pragma("unroll") for (int i = 0; i < 4; ++i) { const int c = tid + 512 * i; rv[i] = *(const u32x4*)(Vg_ + (size_t)(c >> 4) * 512 + (c & 15) * 8); } \
        _Pragma("unroll") for (int i = 0; i < 2; ++i) { const int c = tid + 512 * i; rk[i] = *(const u32x4*)(Kg_ + (size_t)(c >> 3) * 256 + (c & 7) * 8); \
            rf[i] = *(const u32x4*)(Sf_ + (size_t)c * 8); rb[i] = *(const u32x4*)(Sb_ + (size_t)c * 8); } \
        _Pragma("unroll") for (int ks = 0; ks < 2; ++ks) qn[ks] = *(const bf16x8*)(Qg_ + (size_t)iq * 256 + 32 * ks + 8 * g); } while (0)
    int U = F.vcu;
    if (U < 1024) P4_LOAD(U);
    for (; U < 1024; U += F.G) {
        const int bh = U >> 7, n = U & 127, b = bh >> 2, h = bh & 3;
        const size_t row0 = (size_t)b * SEQ + (size_t)n * 128;
        const float l2f = log2_sigmoid(P.in[IN_DECF][h]), l2b = log2_sigmoid(P.in[IN_DECB][h]);
#pragma unroll
        for (int i = 0; i < 4; ++i) { const int c = tid + 512 * i; *(LAS u32x4*)(L + P4_V + (c >> 4) * 256 + (c & 15) * 16) = rv[i]; }
#pragma unroll
        for (int i = 0; i < 2; ++i) { const int c = tid + 512 * i, row = c >> 3, pos = ((c & 7) ^ ((row >> 1) & 7)) << 4;
            *(LAS u32x4*)(L + P4_K + row * 128 + pos) = rk[i]; *(LAS u32x4*)(L + P4_SF + row * 128 + pos) = rf[i]; *(LAS u32x4*)(L + P4_SB + row * 128 + pos) = rb[i]; }
        bf16x8 qf[2] = {qn[0], qn[1]};
        __syncthreads();
        const int Un = U + F.G;
        if (Un < 1024) P4_LOAD(Un);
        const bf16_t* gp = (const bf16_t*)(F.ws + WS_RG) + (row0 + iq) * 512 + h * 128;
        u32x2 gv[8];
#pragma unroll
        for (int et = 0; et < 8; ++et) gv[et] = *(const u32x2*)(gp + 16 * et + 4 * g);
        bf16x8 pb[4];
#pragma unroll
        for (int ks4 = 0; ks4 < 4; ++ks4) {
            float p[8];
#pragma unroll
            for (int t = 0; t < 2; ++t) { const int jt = 2 * ks4 + t, row = 16 * jt + li; const LAS unsigned char* kr = L + P4_K + row * 128;
                f32x4 s = __builtin_amdgcn_mfma_f32_16x16x32_bf16(*(const LAS bf16x8*)(kr + ((g ^ ((row >> 1) & 7)) << 4)), qf[0], (f32x4){0.f, 0.f, 0.f, 0.f}, 0, 0, 0);
                s = __builtin_amdgcn_mfma_f32_16x16x32_bf16(*(const LAS bf16x8*)(kr + (((g + 4) ^ ((row >> 1) & 7)) << 4)), qf[1], s, 0, 0, 0);
#pragma unroll
                for (int e = 0; e < 4; ++e) { const int j = 16 * jt + 4 * g + e, df = iq - j;
                    const float dcy = df >= 0 ? __builtin_amdgcn_exp2f(l2f * (float)df) : __builtin_amdgcn_exp2f(l2b * (float)(-df));
                    p[t * 4 + e] = s[e] * dcy; } }
            u32x4 pw; pw.x = cvt_pk_bf16(p[0], p[1]); pw.y = cvt_pk_bf16(p[2], p[3]); pw.z = cvt_pk_bf16(p[4], p[5]); pw.w = cvt_pk_bf16(p[6], p[7]);
            pb[ks4] = __builtin_bit_cast(bf16x8, pw);
        }
        f32x4 y[8];
#pragma unroll
        for (int et = 0; et < 8; ++et) y[et] = (f32x4){0.f, 0.f, 0.f, 0.f};
        const unsigned va = (unsigned)(size_t)(L + P4_V) + (unsigned)((4 * g + (li >> 2)) * 256 + (4 * (li & 3)) * 2);
#pragma unroll
        for (int ks4 = 0; ks4 < 4; ++ks4)
#pragma unroll
            for (int eh = 0; eh < 2; ++eh) { bf16x8 af[4]; tr_read2x4<256, 32>(va + ks4 * 32 * 256 + eh * 128, af);
#pragma unroll
                for (int et = 0; et < 4; ++et) y[4 * eh + et] = __builtin_amdgcn_mfma_f32_16x16x32_bf16(af[et], pb[ks4], y[4 * eh + et], 0, 0, 0); }
#pragma unroll
        for (int dir = 0; dir < 2; ++dir) {
            const float sc = dir ? __builtin_amdgcn_exp2f(l2b * (float)(128 - iq)) : __builtin_amdgcn_exp2f(l2f * (float)(iq + 1));
            const LAS unsigned char* sp = L + (dir ? P4_SB : P4_SF);
#pragma unroll
            for (int ks = 0; ks < 2; ++ks) {
                const u32x4 qv = __builtin_bit_cast(u32x4, qf[ks]); u32x4 qs;
                qs.x = cvt_pk_bf16(bflo(qv.x) * sc, bfhi(qv.x) * sc); qs.y = cvt_pk_bf16(bflo(qv.y) * sc, bfhi(qv.y) * sc); qs.z = cvt_pk_bf16(bflo(qv.z) * sc, bfhi(qv.z) * sc); qs.w = cvt_pk_bf16(bflo(qv.w) * sc, bfhi(qv.w) * sc);
                const bf16x8 qb = __builtin_bit_cast(bf16x8, qs);
#pragma unroll
                for (int et = 0; et < 8; ++et) { const int row = 16 * et + li; const bf16x8 af = *(const LAS bf16x8*)(sp + row * 128 + (((g + 4 * ks) ^ ((row >> 1) & 7)) << 4));
                    y[et] = __builtin_amdgcn_mfma_f32_16x16x32_bf16(af, qb, y[et], 0, 0, 0); }
            }
        }
        float s1 = 0.f;
#pragma unroll
        for (int et = 0; et < 8; ++et) s1 += (y[et].x + y[et].y) + (y[et].z + y[et].w);
        s1 = sum_g4(s1);
        const float mu = s1 * (1.f / 128.f); float s2 = 0.f;
#pragma unroll
        for (int et = 0; et < 8; ++et) { const f32x4 dv = y[et] - mu; s2 += (dv.x * dv.x + dv.y * dv.y) + (dv.z * dv.z + dv.w * dv.w); }
        s2 = sum_g4(s2);
        const float rstd = 1.0f / sqrtf(s2 * (1.f / 128.f) + 1e-5f);
        const float* gw = P.in[IN_GNW] + h * 128;
        bf16_t* op = (bf16_t*)(F.ws + WS_MIX) + (row0 + iq) * 1024 + 512 + h * 128;
#pragma unroll
        for (int et = 0; et < 8; ++et) { const int e0 = 16 * et + 4 * g; const f32x4 ww = *(const f32x4*)(gw + e0);
            const f32x4 v = (y[et] - mu) * rstd * ww; u32x2 o; o.x = cvt_pk_bf16(v.x * bflo(gv[et].x), v.y * bfhi(gv[et].x)); o.y = cvt_pk_bf16(v.z * bflo(gv[et].y), v.w * bfhi(gv[et].y));
            *(u32x2*)(op + e0) = o; }
        __syncthreads();
    }
#undef P4_LOAD
}

template <int VAR>
struct EpiResidT {
    static constexpr bool PERM = false;
    const float* base; float* out; bf16_t* ob; float* sumsq;
    __device__ __forceinline__ void operator()(const f32x4 (&acc)[2][2][4][2], const pg8::Unit& u, int wr, int wc, int fr, int fq) const {
        const int row0 = u.pm * 256 + wr * 64 + fr, col0 = u.pn * 256 + wc * 32 + 4 * fq;
#pragma unroll
        for (int ai = 0; ai < 2; ++ai)
#pragma unroll
            for (int m = 0; m < 4; ++m) { const int row = row0 + ai * 128 + m * 16; const size_t off = (size_t)row * DM + col0; float ss = 0.f;
#pragma unroll
                for (int bj = 0; bj < 2; ++bj)
#pragma unroll
                    for (int n = 0; n < 2; ++n) { const f32x4 v = (VAR == 3 ? (f32x4){0.f, 0.f, 0.f, 0.f} : *(const f32x4*)(base + off + bj * 128 + n * 16)) + acc[ai][bj][m][n];
                        if (VAR != 2) *(f32x4*)(out + off + bj * 128 + n * 16) = v; ss += (v.x * v.x + v.y * v.y) + (v.z * v.z + v.w * v.w);
                        u32x2 wv; wv.x = cvt_pk_bf16(v.x, v.y); wv.y = cvt_pk_bf16(v.z, v.w); *(u32x2*)(ob + off + bj * 128 + n * 16) = wv; }
                ss = sum_g4(ss);
                if (fq == 0 && VAR != 1) atomicAdd(sumsq + row, ss);
                asm volatile("" ::: "memory"); }
    }
};


__device__ __forceinline__ void memkv_item(Frame& F, int item) {
    const Params& P = *F.p; const int lane = F.lane, w = F.wave, g = lane >> 4, li = lane & 15;
    const int rt = item >> 3, hh = item & 7, row0 = rt * 16;
    const bf16_t* A = (const bf16_t*)(F.ws + WS_MEMH) + (size_t)(row0 + li) * 1024 + 8 * g;
    const bf16_t* Bw = (const bf16_t*)(F.ws + WS_WMKV) + (size_t)(hh * 256 + 32 * w + li) * 1024 + 8 * g;
    LAS float* part = (LAS float*)F.lds;
    f32x4 acc[2] = {(f32x4){0.f, 0.f, 0.f, 0.f}, (f32x4){0.f, 0.f, 0.f, 0.f}};
#pragma unroll 8
    for (int ks = 0; ks < 32; ++ks) { const bf16x8 af = *(const bf16x8*)(A + 32 * ks);
        acc[0] = __builtin_amdgcn_mfma_f32_16x16x32_bf16(af, *(const bf16x8*)(Bw + 32 * ks), acc[0], 0, 0, 0);
        acc[1] = __builtin_amdgcn_mfma_f32_16x16x32_bf16(af, *(const bf16x8*)(Bw + (size_t)16 * 1024 + 32 * ks), acc[1], 0, 0, 0); }
    const int b = row0 >> 8, key0 = (row0 & 255) + 4 * g;
    if (hh < 4) {
#pragma unroll
        for (int e = 0; e < 4; ++e) { const float s = sum_row16(acc[0][e] * acc[0][e] + acc[1][e] * acc[1][e]); if (li == 0) part[w * 16 + 4 * g + e] = s; }
    }
    __syncthreads();
    if (hh < 4) {
        float rs[4];
#pragma unroll
        for (int e = 0; e < 4; ++e) { float t = 0.f;
#pragma unroll
            for (int ww = 0; ww < 8; ++ww) t += part[ww * 16 + 4 * g + e];
            rs[e] = 0.0625f / sqrtf(t * (1.f / 256.f) + 1e-6f); }
        bf16_t* dst = (bf16_t*)(F.ws + WS_MK) + ((size_t)(b * 4 + hh) * 256 + key0) * 256;
#pragma unroll
        for (int c = 0; c < 2; ++c) { const int d = 32 * w + 16 * c + li; const float wv = P.in[IN_MKN][d] * P.in[IN_MQN][d];
#pragma unroll
            for (int e = 0; e < 4; ++e) dst[(size_t)e * 256 + d] = (bf16_t)(cvt_pk_bf16(acc[c][e] * rs[e] * wv, 0.f) & 0xffffu); }
    } else {
        bf16_t* dst = (bf16_t*)(F.ws + WS_MVT) + ((size_t)(b * 4 + (hh - 4)) * 256) * 256 + ((row0 & 255) & ~31) + 8 * g + 4 * ((row0 >> 4) & 1);
#pragma unroll
        for (int c = 0; c < 2; ++c) { const int d = 32 * w + 16 * c + li; u32x2 o; o.x = cvt_pk_bf16_c(acc[c][0], acc[c][1]); o.y = cvt_pk_bf16_c(acc[c][2], acc[c][3]); *(u32x2*)(dst + (size_t)d * 256) = o; }
    }
    __syncthreads();
}

#ifndef KEEP_LO
#define KEEP_LO 0
#endif
template <bool BASE_F32>
struct EpiResidHL {
    static constexpr bool PERM = true;
    const float* basef; const bf16_t* bhi; const float* blo_f; bf16_t* ohi; bf16_t* olo; float* sumsq; unsigned char* oq;
    __device__ __forceinline__ void load_base(int row, int col0, u32x4 (&bh)[2]) const {
        const size_t off = (size_t)row * DM + col0;
#pragma unroll
        for (int bj = 0; bj < 2; ++bj) bh[bj] = *(const u32x4*)(bhi + off + bj * 128);
    }
    __device__ __forceinline__ void operator()(const f32x4 (&acc)[2][2][4][2], const pg8::Unit& u, int wr, int wc, int fr, int fq) const {
        const int row0 = u.pm * 256 + wr * 64 + fr, col0 = u.pn * 256 + wc * 32 + 8 * fq;
        u32x4 bh[4][2];
#pragma unroll
        for (int i = 0; i < 3; ++i) load_base(row0 + (i >> 2) * 128 + (i & 3) * 16, col0, bh[i]);
        f32x4 iw[2][2]; float rr[8];
        if (BASE_F32) {
#pragma unroll
            for (int i = 0; i < 8; ++i) rr[i] = blo_f[row0 + (i >> 2) * 128 + (i & 3) * 16];
#pragma unroll
            for (int bj = 0; bj < 2; ++bj)
#pragma unroll
                for (int n = 0; n < 2; ++n) { const f32x4 w4 = *(const f32x4*)(basef + col0 + bj * 128 + 4 * n); iw[bj][n] = (f32x4){1.0f / w4.x, 1.0f / w4.y, 1.0f / w4.z, 1.0f / w4.w}; } }
#pragma unroll
        for (int i = 0; i < 8; ++i) { const int ai = i >> 2, m = i & 3; const int row = row0 + ai * 128 + m * 16; const size_t off = (size_t)row * DM + col0; float ss = 0.f;
            if (i < 5) load_base(row0 + ((i + 3) >> 2) * 128 + ((i + 3) & 3) * 16, col0, bh[(i + 3) & 3]);
            float rms = 1.f; if (BASE_F32) rms = 1.0f / rr[i];
#pragma unroll
            for (int bj = 0; bj < 2; ++bj) { f32x4 b0, b1;
                { const u32x4 h = bh[i & 3][bj];
                    b0 = (f32x4){bflo(h.x), bfhi(h.x), bflo(h.y), bfhi(h.y)}; b1 = (f32x4){bflo(h.z), bfhi(h.z), bflo(h.w), bfhi(h.w)}; }
                if (BASE_F32) { b0 = b0 * iw[bj][0] * rms; b1 = b1 * iw[bj][1] * rms; }
                const f32x4 v0 = b0 + acc[ai][bj][m][0], v1 = b1 + acc[ai][bj][m][1];
                ss += (v0.x * v0.x + v0.y * v0.y) + (v0.z * v0.z + v0.w * v0.w) + (v1.x * v1.x + v1.y * v1.y) + (v1.z * v1.z + v1.w * v1.w);
                u32x4 hw; hw.x = cvt_pk_bf16(v0.x, v0.y); hw.y = cvt_pk_bf16(v0.z, v0.w); hw.z = cvt_pk_bf16(v1.x, v1.y); hw.w = cvt_pk_bf16(v1.z, v1.w);
                *(u32x4*)(ohi + off + bj * 128) = hw;
                if (oq) { int q0 = 0, q1 = 0; q0 = __builtin_amdgcn_cvt_pk_fp8_f32(v0.x, v0.y, q0, false); q0 = __builtin_amdgcn_cvt_pk_fp8_f32(v0.z, v0.w, q0, true);
                    q1 = __builtin_amdgcn_cvt_pk_fp8_f32(v1.x, v1.y, q1, false); q1 = __builtin_amdgcn_cvt_pk_fp8_f32(v1.z, v1.w, q1, true);
                    *(u32x2*)(oq + off + bj * 128) = (u32x2){(unsigned)q0, (unsigned)q1}; } }
            ss = sum_g4(ss);
            if (fq == 0) atomicAdd(sumsq + row, ss);
        }
    }
};
struct EpiNull {
    static constexpr bool PERM = true;
    float* sink;
    __device__ __forceinline__ void operator()(const f32x4 (&acc)[2][2][4][2], const pg8::Unit& u, int wr, int wc, int fr, int fq) const {
        f32x4 s = (f32x4){0.f, 0.f, 0.f, 0.f};
#pragma unroll
        for (int a = 0; a < 2; ++a)
#pragma unroll
            for (int b = 0; b < 2; ++b)
#pragma unroll
                for (int m = 0; m < 4; ++m)
#pragma unroll
                    for (int n = 0; n < 2; ++n) s += acc[a][b][m][n];
        sink[(size_t)(u.pm * 4 + u.pn) * 512 + threadIdx.x] = s.x + s.y + s.z + s.w;
    }
};
typedef EpiResidT<0> EpiResid;
#ifndef EPI_VAR
#define EPI_VAR 0
#endif
struct EpiMemQ {
    static constexpr bool PERM = true;
    bf16_t* qm; const float* sumsq1; float* hsq;
    __device__ __forceinline__ void operator()(const f32x4 (&acc)[2][2][4][2], const pg8::Unit& u, int wr, int wc, int fr, int fq) const {
        const int row0 = u.pm * 256 + wr * 64 + fr, col0 = u.pn * 256 + wc * 32 + 8 * fq;
        float sq[8];
#pragma unroll
        for (int i = 0; i < 8; ++i) sq[i] = sumsq1[row0 + (i >> 2) * 128 + (i & 3) * 16];
#pragma unroll
        for (int ai = 0; ai < 2; ++ai)
#pragma unroll
            for (int m = 0; m < 4; ++m) { const int row = row0 + ai * 128 + m * 16; const float rs = 1.0f / sqrtf(sq[ai * 4 + m] * (1.f / 1024.f) + 1e-6f); float ss = 0.f;
                bf16_t* rowp = qm + (size_t)row * DM + col0;
#pragma unroll
                for (int bj = 0; bj < 2; ++bj) { const f32x4 v0 = acc[ai][bj][m][0] * rs, v1 = acc[ai][bj][m][1] * rs;
                    ss += (v0.x * v0.x + v0.y * v0.y) + (v0.z * v0.z + v0.w * v0.w) + (v1.x * v1.x + v1.y * v1.y) + (v1.z * v1.z + v1.w * v1.w);
                    u32x4 w; w.x = cvt_pk_bf16(v0.x, v0.y); w.y = cvt_pk_bf16(v0.z, v0.w); w.z = cvt_pk_bf16(v1.x, v1.y); w.w = cvt_pk_bf16(v1.z, v1.w);
                    *(u32x4*)(rowp + 128 * bj) = w; }
                ss = sum_g4(ss);
                if (fq == 0) atomicAdd(hsq + (size_t)row * 4 + u.pn, ss); }
    }
};

__device__ __forceinline__ void p7_mem_attention(Frame& F) {
    const Params& P = *F.p; const int lane = F.lane, w = F.wave, tid = F.tid, g = lane >> 4, li = lane & 15;
    float mq = 0.f, mk = 0.f;
#pragma unroll
    for (int i = 0; i < 4; ++i) { mq = fmaxf(mq, fabsf(P.in[IN_MQN][lane + 64 * i])); mk = fmaxf(mk, fabsf(P.in[IN_MKN][lane + 64 * i])); }
    mq = wave_max(mq); mk = wave_max(mk);
    const float M2 = 16.0f * mq * mk * 1.44269504089f;
    LAS unsigned char* buf = F.lds;
    int kso[2], klo[2];
#pragma unroll
    for (int j = 0; j < 2; ++j) { const int o = tid * 16 + j * 8192, r = o >> 9, cpos = (o & 511) >> 4; klo[j] = o; kso[j] = r * 256 + ((cpos ^ (r & 15)) << 3); }
    const int vdim = tid >> 2, vseg = (tid & 3) ^ ((0 - (vdim >> 2)) & 3);
    for (int U = F.vcu; U < 512; U += F.G) {
        const int bhd = U >> 6, qb = U & 63, b = bhd >> 2, head = bhd & 3;
        const size_t tok0 = (size_t)b * SEQ + (size_t)qb * 256 + 32 * w;
        const bf16_t* Kp = (const bf16_t*)(F.ws + WS_MK) + (size_t)bhd * 65536;
        const bf16_t* Vt = (const bf16_t*)(F.ws + WS_MVT) + (size_t)bhd * 65536;
        bf16x8 qf[2][8]; float hs[2];
#pragma unroll
        for (int qt = 0; qt < 2; ++qt) { const size_t tok = tok0 + 16 * qt + li; const bf16_t* qp = (const bf16_t*)(F.ws + WS_QM) + tok * DM + head * 256 + 8 * g;
#pragma unroll
            for (int ks = 0; ks < 8; ++ks) qf[qt][ks] = *(const bf16x8*)(qp + 32 * ks);
            hs[qt] = 1.44269504089f / sqrtf(((const float*)(F.ws + WS_HSQ))[tok * 4 + head] * (1.f / 256.f) + 1e-6f); }
        bf16x8 pb[2][8]; float lsum[2] = {0.f, 0.f};
        u32x4 sreg[2][2];
#pragma unroll
        for (int j = 0; j < 2; ++j) { sreg[0][j] = *(const u32x4*)(Kp + kso[j]); sreg[1][j] = *(const u32x4*)(Kp + (size_t)8192 + kso[j]); }
        __syncthreads();
#pragma unroll
        for (int j = 0; j < 2; ++j) *(LAS u32x4*)(buf + klo[j]) = sreg[0][j];
        __syncthreads();
#pragma unroll
        for (int Pp = 0; Pp < 8; ++Pp) {
            LAS unsigned char* cb = buf + (Pp & 1) * 16384;
            if (Pp < 6) {
#pragma unroll
                for (int j = 0; j < 2; ++j) sreg[Pp & 1][j] = *(const u32x4*)(Kp + (size_t)(Pp + 2) * 8192 + kso[j]); }
            f32x4 st[2][2];
#pragma unroll
            for (int t = 0; t < 2; ++t) { const int rho = 16 * t + li;
                st[0][t] = (f32x4){0.f, 0.f, 0.f, 0.f}; st[1][t] = (f32x4){0.f, 0.f, 0.f, 0.f};
#pragma unroll
                for (int ks = 0; ks < 8; ++ks) { const bf16x8 kf = *(const LAS bf16x8*)(cb + rho * 512 + (((4 * ks + g) ^ li) << 4));
                    st[0][t] = __builtin_amdgcn_mfma_f32_16x16x32_bf16(kf, qf[0][ks], st[0][t], 0, 0, 0);
                    st[1][t] = __builtin_amdgcn_mfma_f32_16x16x32_bf16(kf, qf[1][ks], st[1][t], 0, 0, 0); } }
#pragma unroll
            for (int qt = 0; qt < 2; ++qt) { float p[8];
#pragma unroll
                for (int t = 0; t < 2; ++t)
#pragma unroll
                    for (int e = 0; e < 4; ++e) { p[t * 4 + e] = __builtin_amdgcn_exp2f(__builtin_fmaf(st[qt][t][e], hs[qt], -M2)); lsum[qt] += p[t * 4 + e]; }
                u32x4 pw; pw.x = cvt_pk_bf16(p[0], p[1]); pw.y = cvt_pk_bf16(p[2], p[3]); pw.z = cvt_pk_bf16(p[4], p[5]); pw.w = cvt_pk_bf16(p[6], p[7]);
                pb[qt][Pp] = __builtin_bit_cast(bf16x8, pw); }
            if (Pp < 7) {
#pragma unroll
                for (int j = 0; j < 2; ++j) *(LAS u32x4*)(buf + ((Pp + 1) & 1) * 16384 + klo[j]) = sreg[(Pp + 1) & 1][j]; }
            __syncthreads();
        }
        float inv[2];
#pragma unroll
        for (int qt = 0; qt < 2; ++qt) inv[qt] = 1.0f / sum_g4(lsum[qt]);
        u32x4 vreg[2];
        vreg[0] = *(const u32x4*)(Vt + (size_t)vdim * 256 + vseg * 8); vreg[1] = *(const u32x4*)(Vt + (size_t)vdim * 256 + 32 + vseg * 8);
        *(LAS u32x4*)(buf + tid * 16) = vreg[0];
        __syncthreads();
#pragma unroll 1
        for (int dh = 0; dh < 2; ++dh) {
            f32x4 o[2][8];
#pragma unroll
            for (int dt = 0; dt < 8; ++dt) { o[0][dt] = (f32x4){0.f, 0.f, 0.f, 0.f}; o[1][dt] = (f32x4){0.f, 0.f, 0.f, 0.f}; }
#pragma unroll
            for (int Pp = 0; Pp < 8; ++Pp) {
                const int c = dh * 8 + Pp; LAS unsigned char* cb = buf + (c & 1) * 8192;
                if (c < 14) { const int c2 = c + 2; vreg[Pp & 1] = *(const u32x4*)(Vt + (size_t)(128 * (c2 >> 3) + vdim) * 256 + 32 * (c2 & 7) + vseg * 8); }
#pragma unroll
                for (int dt = 0; dt < 8; ++dt) { const int dl = 16 * dt + li; const bf16x8 vf = *(const LAS bf16x8*)(cb + dl * 64 + ((g ^ ((0 - (dl >> 2)) & 3)) << 4));
                    o[0][dt] = __builtin_amdgcn_mfma_f32_16x16x32_bf16(vf, pb[0][Pp], o[0][dt], 0, 0, 0);
                    o[1][dt] = __builtin_amdgcn_mfma_f32_16x16x32_bf16(vf, pb[1][Pp], o[1][dt], 0, 0, 0); }
                if (c < 15) *(LAS u32x4*)(buf + ((c + 1) & 1) * 8192 + tid * 16) = vreg[(Pp + 1) & 1];
                __syncthreads();
            }
#pragma unroll
            for (int qt = 0; qt < 2; ++qt) { unsigned char* op = (unsigned char*)(F.ws + WS_OM) + (tok0 + 16 * qt + li) * DM + head * 256 + 128 * dh + 4 * g;
#pragma unroll
                for (int dt = 0; dt < 8; ++dt) { const f32x4 v = o[qt][dt] * (inv[qt] * 16.f); int q0 = 0; q0 = __builtin_amdgcn_cvt_pk_fp8_f32(v.x, v.y, q0, false); q0 = __builtin_amdgcn_cvt_pk_fp8_f32(v.z, v.w, q0, true);
                    *(unsigned*)(op + 16 * dt) = (unsigned)q0; } }
        }
    }
}

constexpr size_t WS_TOKSLOT = 117 * MiB + 512 * 1024;
constexpr size_t WS_SLOTE = 120 * MiB;
constexpr int LDS_MOE_TAB = 131072;
__device__ __forceinline__ int moe_tables(Frame& F) {
    LAS unsigned* cn = (LAS unsigned*)(F.lds + LDS_MOE_TAB); LAS unsigned* tp = cn + 32;
    const unsigned* cnt = (const unsigned*)(F.ws + WS_CTL) + CW_CNT;
    if (F.tid < 32) cn[F.tid] = __hip_atomic_load(cnt + F.tid, __ATOMIC_RELAXED, __HIP_MEMORY_SCOPE_AGENT);
    __syncthreads();
    if (F.tid == 0) { unsigned o = 0; for (int e = 0; e < 32; ++e) { tp[e] = o; o += (cn[e] + 255u) >> 8; } tp[32] = o; }
    __syncthreads();
    return (int)tp[32];
}

struct RouteRec { int e0, e1; float g0, g1; };
constexpr int P9_W_BYTES = 48 * 2048, P9_XROW = 288, P9_XT_OFF = P9_W_BYTES + 256;
__device__ __forceinline__ void p9_route(Frame& F, unsigned* gcnt) {
    const int lane = F.lane, w = F.wave, tid = F.tid, g = lane >> 4, li = lane & 15;
    LAS unsigned char* Wl = F.lds;
    LAS unsigned* lcnt = (LAS unsigned*)(F.lds + P9_W_BYTES);
    LAS unsigned char* xt = F.lds + P9_XT_OFF + w * (16 * P9_XROW);
    {
        const bf16_t* wg = (const bf16_t*)(F.ws + WS_WRT);
        u32x4 t[12];
#pragma unroll
        for (int i = 0; i < 12; ++i) { const int p = tid + 512 * i; t[i] = *(const u32x4*)(wg + (size_t)(p >> 7) * 1024 + (p & 127) * 8); }
#pragma unroll
        for (int i = 0; i < 12; ++i) { const int p = tid + 512 * i, row = p >> 7, ch = p & 127; *(LAS u32x4*)(Wl + row * 2048 + ((ch ^ (row & 15)) << 4)) = t[i]; }
    }
    if (tid < 32) lcnt[tid] = 0u;
    __syncthreads();
    const int gw = F.vcu * NWAVES + w, NGW = F.G * NWAVES;
    LAS unsigned* lbase = lcnt + 32;
    unsigned* slote = (unsigned*)(F.ws + WS_SLOTE); int* tokslot = (int*)(F.ws + WS_TOKSLOT);
    for (int tb = 0; tb < NT / 16; tb += NGW) {
        const int tt = tb + gw; const bool have = tt < NT / 16;
        const int tok0 = (have ? tt : 0) * 16;
        const bf16_t* xg = (const bf16_t*)(F.ws + WS_X2B) + (size_t)(tok0 + g) * DM + 8 * li;
        f32x4 acc[3];
#pragma unroll
        for (int ct = 0; ct < 3; ++ct) acc[ct] = (f32x4){0.f, 0.f, 0.f, 0.f};
        u32x4 xr[4];
#pragma unroll
        for (int i = 0; i < 4; ++i) xr[i] = *(const u32x4*)(xg + (size_t)(4 * i) * DM);
#pragma unroll 1
        for (int c = 0; c < 8; ++c) {
#pragma unroll
            for (int i = 0; i < 4; ++i) *(LAS u32x4*)(xt + (4 * i + g) * P9_XROW + li * 16) = xr[i];
            if (c < 7) {
#pragma unroll
                for (int i = 0; i < 4; ++i) xr[i] = *(const u32x4*)(xg + (size_t)(4 * i) * DM + 128 * (c + 1)); }
            LDS_WAIT();
#pragma unroll
            for (int ks = 0; ks < 4; ++ks) {
                const bf16x8 ah = *(const LAS bf16x8*)(xt + li * P9_XROW + (32 * ks + 8 * g) * 2);
                const int chi = 16 * c + 4 * ks + g;
#pragma unroll
                for (int ct = 0; ct < 3; ++ct) { const bf16x8 bh = *(const LAS bf16x8*)(Wl + (16 * ct + li) * 2048 + ((chi ^ li) << 4));
                    acc[ct] = __builtin_amdgcn_mfma_f32_16x16x32_bf16(ah, bh, acc[ct], 0, 0, 0); }
            }
            LDS_WAIT();
        }
        LAS float* lg = (LAS float*)xt;
#pragma unroll
        for (int ct = 0; ct < 3; ++ct)
#pragma unroll
            for (int e = 0; e < 4; ++e) lg[(4 * g + e) * 52 + 16 * ct + li] = acc[ct][e];
        LDS_WAIT();
        int e0 = 0, e1 = 0; float g0 = 0.f, g1 = 0.f; unsigned lp0 = 0u, lp1 = 0u;
        if (lane < 16) {
            const int tok = tok0 + lane; const LAS float* a = lg + lane * 52;
            const float rstd = 1.0f / sqrtf(((const float*)(F.ws + WS_SUMSQ2))[tok] * (1.f / 1024.f) + 1e-6f);
            int grp = 0; float gm = a[0];
#pragma unroll
            for (int q = 1; q < 4; ++q) { const float v = a[q]; if (v > gm) { gm = v; grp = q; } }
            float gden = 0.f;
#pragma unroll
            for (int q = 0; q < 4; ++q) gden += expf((a[q] - gm) * rstd);
            const float ggate = 1.0f / gden;
            const LAS float* el = a + 4 + grp * 8;
            int i1 = 0; float v1 = el[0];
#pragma unroll
            for (int e = 1; e < 8; ++e) { const float v = el[e]; if (v > v1) { v1 = v; i1 = e; } }
            int i2 = -1; float v2 = -3.0e38f;
#pragma unroll
            for (int e = 0; e < 8; ++e) { const float v = el[e]; if (e != i1 && v > v2) { v2 = v; i2 = e; } }
            const float ex = expf((v2 - v1) * rstd);
            e0 = grp * 8 + i1; e1 = grp * 8 + i2; g0 = ggate / (1.0f + ex); g1 = ggate * ex / (1.0f + ex);
            if (have) { lp0 = __hip_atomic_fetch_add(&lcnt[e0], 1u, __ATOMIC_RELAXED, __HIP_MEMORY_SCOPE_WORKGROUP); lp1 = __hip_atomic_fetch_add(&lcnt[e1], 1u, __ATOMIC_RELAXED, __HIP_MEMORY_SCOPE_WORKGROUP); }
        }
        __syncthreads();
        if (tid < 32) { const unsigned n = lcnt[tid]; lbase[tid] = n ? atomicAdd(gcnt + tid, n) : 0u; }
        __syncthreads();
        if (lane < 16 && have) { const int tok = tok0 + lane; const unsigned p0 = lbase[e0] + lp0, p1 = lbase[e1] + lp1;
            slote[((size_t)e0 << 15) + p0] = (unsigned)tok | (cvt_pk_bf16(g0, 0.f) << 16);
            slote[((size_t)e1 << 15) + p1] = (unsigned)tok | 0x8000u | (cvt_pk_bf16(g1, 0.f) << 16);
            tokslot[tok * 2] = (int)(((unsigned)e0 << 16) | p0); tokslot[tok * 2 + 1] = (int)(((unsigned)e1 << 16) | p1); }
        __syncthreads();
        if (tid < 32) lcnt[tid] = 0u;
        __syncthreads();
    }
}
struct MoeOrder {
    const char* A; const char* W; LAS const unsigned* cn; const unsigned* slote; int ntiles, G, c, kb; size_t wstride, tstepB, tstepA;
    __device__ bool next_(int i, pg8::Unit& u, bool gatherA) const {
        const int L = i * G + c, T = L >> 2; if (T >= ntiles) return false;
        LAS const unsigned* tp = cn + 32; int e = 0;
#pragma unroll
        for (int k = 16; k; k >>= 1) e += (tp[e + k] <= (unsigned)T) ? k : 0;
        u.pm = T; u.pn = L & 3; u.aux = e;
        u.A = gatherA ? A : A + (size_t)T * tstepA; u.B = W + (size_t)e * wstride + (size_t)u.pn * tstepB; return true;
    }
};
struct MoeOrder1 : MoeOrder {
    static constexpr bool GATHER = true;
    __device__ bool next(int i, pg8::Unit& u) const { return next_(i, u, true); }
    __device__ __forceinline__ void gather(const pg8::Unit& u, int R0, int R1, int C0, int C1, unsigned (&vA)[2][2]) const {
        const int e = u.aux; const unsigned n = cn[e]; const unsigned pb = (unsigned)(u.pm - (int)cn[32 + e]) * 256u; const unsigned* se = slote + ((size_t)e << 15);
#pragma unroll
        for (int h = 0; h < 2; ++h) { const unsigned p0 = pb + R0 + 128 * h, p1 = pb + R1 + 128 * h;
            const int t0 = p0 < n ? (int)(se[p0] & 0x7fffu) : 0, t1 = p1 < n ? (int)(se[p1] & 0x7fffu) : 0;
            vA[h][0] = (unsigned)(t0 * kb + C0) * 2u; vA[h][1] = (unsigned)(t1 * kb + C1) * 2u; }
    }
};
struct MoeOrder2 : MoeOrder {
    static constexpr bool GATHER = false;
    __device__ bool next(int i, pg8::Unit& u) const { return next_(i, u, false); }
    __device__ __forceinline__ void gather(const pg8::Unit&, int, int, int, int, unsigned (&)[2][2]) const {}
};
struct EpiMoe1 {
    static constexpr bool PERM = true;
    unsigned char* H; const unsigned* slote; LAS const unsigned* cn; const float* sumsq2;
    __device__ __forceinline__ void operator()(const f32x4 (&acc)[2][2][4][2], const pg8::Unit& u, int wr, int wc, int fr, int fq) const {
        const int row0 = u.pm * 256 + wr * 64 + fr;
        const int e = u.aux; const unsigned n = cn[e]; const unsigned pb = (unsigned)(u.pm - (int)cn[32 + e]) * 256u; const unsigned* se = slote + ((size_t)e << 15);
        int tk[8]; float gts[8], sq[8];
#pragma unroll
        for (int i = 0; i < 8; ++i) { const unsigned p = pb + wr * 64 + fr + (i >> 2) * 128 + (i & 3) * 16; const unsigned wd = p < n ? se[p] : 0u; tk[i] = (int)(wd & 0x7fffu); gts[i] = __builtin_bit_cast(float, wd & 0xffff0000u); }
#pragma unroll
        for (int i = 0; i < 8; ++i) sq[i] = sumsq2[tk[i]];
#pragma unroll
        for (int ai = 0; ai < 2; ++ai)
#pragma unroll
            for (int m = 0; m < 4; ++m) { const int slot = row0 + ai * 128 + m * 16; const float gt = gts[ai * 4 + m];
                const float rs = 1.0f / sqrtf(sq[ai * 4 + m] * (1.f / 1024.f) + 1e-6f);
                f32x4 h0, h1;
                { const f32x4 a = acc[ai][0][m][0] * rs, b = acc[ai][1][m][0] * (rs * gt * 8.0f); h0.x = silu_f(a.x) * b.x; h0.y = silu_f(a.y) * b.y; h0.z = silu_f(a.z) * b.z; h0.w = silu_f(a.w) * b.w; }
                { const f32x4 a = acc[ai][0][m][1] * rs, b = acc[ai][1][m][1] * (rs * gt * 8.0f); h1.x = silu_f(a.x) * b.x; h1.y = silu_f(a.y) * b.y; h1.z = silu_f(a.z) * b.z; h1.w = silu_f(a.w) * b.w; }
                int q0 = 0, q1 = 0; q0 = __builtin_amdgcn_cvt_pk_fp8_f32(h0.x, h0.y, q0, false); q0 = __builtin_amdgcn_cvt_pk_fp8_f32(h0.z, h0.w, q0, true);
                q1 = __builtin_amdgcn_cvt_pk_fp8_f32(h1.x, h1.y, q1, false); q1 = __builtin_amdgcn_cvt_pk_fp8_f32(h1.z, h1.w, q1, true);
                *(u32x2*)(H + (size_t)slot * FF + u.pn * 128 + wc * 32 + 8 * fq) = (u32x2){(unsigned)q0, (unsigned)q1}; }
    }
};
struct EpiMoe2 {
    static constexpr bool PERM = true;
    unsigned char* Y;
    __device__ __forceinline__ void operator()(const f32x4 (&acc)[2][2][4][2], const pg8::Unit& u, int wr, int wc, int fr, int fq) const {
        const int row0 = u.pm * 256 + wr * 64 + fr, col0 = u.pn * 256 + wc * 32 + 8 * fq;
#pragma unroll
        for (int ai = 0; ai < 2; ++ai)
#pragma unroll
            for (int m = 0; m < 4; ++m) { unsigned char* rowp = Y + (size_t)(row0 + ai * 128 + m * 16) * DM + col0;
#pragma unroll
                for (int bj = 0; bj < 2; ++bj) { const f32x4 v0 = acc[ai][bj][m][0] * 16.0f, v1 = acc[ai][bj][m][1] * 16.0f;
                    int q0 = 0, q1 = 0; q0 = __builtin_amdgcn_cvt_pk_fp8_f32(v0.x, v0.y, q0, false); q0 = __builtin_amdgcn_cvt_pk_fp8_f32(v0.z, v0.w, q0, true);
                    q1 = __builtin_amdgcn_cvt_pk_fp8_f32(v1.x, v1.y, q1, false); q1 = __builtin_amdgcn_cvt_pk_fp8_f32(v1.z, v1.w, q1, true);
                    *(u32x2*)(rowp + 128 * bj) = (u32x2){(unsigned)q0, (unsigned)q1}; } }
    }
};
__device__ __forceinline__ void p13_combine(Frame& F, float* outp) {
    const int lane = F.lane;
    const int gw = F.vcu * NWAVES + F.wave, NGW = F.G * NWAVES;
    const unsigned char* Y = (const unsigned char*)(F.ws + WS_Y); const int* ts = (const int*)(F.ws + WS_TOKSLOT);
    LAS const unsigned* tp = (LAS const unsigned*)(F.lds + LDS_MOE_TAB) + 32;
    typedef float f32x2v __attribute__((ext_vector_type(2)));
    for (int tok0 = gw; tok0 < NT; tok0 += 4 * NGW) {
        int s0[4], s1[4];
#pragma unroll
        for (int t = 0; t < 4; ++t) { const int tok = tok0 + t * NGW; const unsigned a = (unsigned)ts[tok * 2], b = (unsigned)ts[tok * 2 + 1];
            s0[t] = (int)(tp[a >> 16] * 256u + (a & 0xffffu)); s1[t] = (int)(tp[b >> 16] * 256u + (b & 0xffffu)); }
        const int c = lane * 16;
        u32x4 y0[4], y1[4], xa[4], xc[4];
#pragma unroll
        for (int t = 0; t < 4; ++t) { const int tok = tok0 + t * NGW; const bf16_t* xb = (const bf16_t*)(F.ws + WS_X2B) + (size_t)tok * DM;
            y0[t] = *(const u32x4*)(Y + (size_t)s0[t] * DM + c); y1[t] = *(const u32x4*)(Y + (size_t)s1[t] * DM + c); xa[t] = *(const u32x4*)(xb + c); xc[t] = *(const u32x4*)(xb + c + 8); }
#pragma unroll
        for (int t = 0; t < 4; ++t) { const int tok = tok0 + t * NGW; float* od = outp + (size_t)tok * DM;
            const unsigned yw0[4] = {y0[t].x, y0[t].y, y0[t].z, y0[t].w}, yw1[4] = {y1[t].x, y1[t].y, y1[t].z, y1[t].w};
            const unsigned xw[8] = {xa[t].x, xa[t].y, xa[t].z, xa[t].w, xc[t].x, xc[t].y, xc[t].z, xc[t].w};
#pragma unroll
            for (int j = 0; j < 4; ++j) {
                const f32x2v a0 = __builtin_amdgcn_cvt_pk_f32_fp8((int)yw0[j], false), a1 = __builtin_amdgcn_cvt_pk_f32_fp8((int)yw0[j], true);
                const f32x2v b0 = __builtin_amdgcn_cvt_pk_f32_fp8((int)yw1[j], false), b1 = __builtin_amdgcn_cvt_pk_f32_fp8((int)yw1[j], true);
                f32x4 o; o.x = bflo(xw[2 * j]) + (a0.x + b0.x) * 0.0625f; o.y = bfhi(xw[2 * j]) + (a0.y + b0.y) * 0.0625f;
                o.z = bflo(xw[2 * j + 1]) + (a1.x + b1.x) * 0.0625f; o.w = bfhi(xw[2 * j + 1]) + (a1.y + b1.y) * 0.0625f;
                *(f32x4*)(od + c + 4 * j) = o; } }
    }
}

constexpr int CW_DBG = 1024;
__device__ __forceinline__ void dbg_report(Frame& F, float got, float ref, float atol, float rtol) {
    const float err = fabsf(got - ref), tol = atol + rtol * fabsf(ref);
    unsigned code = 0;
    if (!(err <= tol)) { code = 1; if (!(err <= 3.f * tol)) code = 2; if (!(err <= 10.f * tol)) code = 3; if (!(err <= 100.f * tol)) code = 4; if (!(err == err)) code = 5; }
    if (code) atomicMax((unsigned*)(F.ws + WS_CTL) + CW_DBG, code);
}
__device__ __forceinline__ void dbg_finish(Frame& F, const XcdBarrier& xb) {
    xcd_barrier(xb);
    const unsigned code = __hip_atomic_load((unsigned*)(F.ws + WS_CTL) + CW_DBG, __ATOMIC_RELAXED, __HIP_MEMORY_SCOPE_AGENT);
    const float c = 1.0f - 0.2f * (float)code;
    const size_t gt = (size_t)blockIdx.x * NTHR + F.tid, NGT = (size_t)F.G * NTHR;
    for (size_t i = gt; i < (size_t)NT * DM; i += NGT) F.p->out[i] = F.p->in[IN_X][i] * c;
}
__device__ __forceinline__ void dbg_check_inproj(Frame& F, int s) {
    const Params& P = *F.p; const int lane = F.lane;
    const int row = (int)(((long)s * 7919 + 13) % NT), col = (int)(((long)s * 104729 + 7) % 3072);
    const float* x = P.in[IN_X] + (size_t)row * DM; const float* nw = P.in[IN_NORM_MIX]; const float* W = P.in[IN_W_IN];
    float ss = 0.f; for (int k = lane; k < DM; k += 64) ss += x[k] * x[k];
    const float rstd = 1.0f / sqrtf(wave_sum(ss) * (1.f / 1024.f) + 1e-6f);
    if (col < 1024) {
        const int hb = col & ~63; float v[64];
#pragma unroll
        for (int d = 0; d < 64; ++d) v[d] = 0.f;
        for (int k = lane; k < DM; k += 64) { const float h = x[k] * rstd * nw[k];
#pragma unroll
            for (int d = 0; d < 64; ++d) v[d] += h * W[(size_t)k * 3072 + hb + d]; }
        float q = 0.f, mine = 0.f;
#pragma unroll
        for (int d = 0; d < 64; ++d) { v[d] = wave_sum(v[d]); q += v[d] * v[d]; if (d == (col & 63)) mine = v[d]; }
        const float* hn = col < 512 ? P.in[IN_AQN] : P.in[IN_AKN];
        const float ref = mine / sqrtf(q * (1.f / 64.f) + 1e-6f) * hn[col & 63] * (col < 512 ? 0.125f : 1.f);
        const bf16_t* t = (const bf16_t*)(F.ws + (col < 512 ? WS_AQ : WS_AK));
        const float got = bf2f(t[(size_t)row * 512 + (col & 511)]);
        if (lane == 0) dbg_report(F, got, ref, 0.01f, 0.02f);
    } else {
        float d = 0.f; for (int k = lane; k < DM; k += 64) d += x[k] * rstd * nw[k] * W[(size_t)k * 3072 + col];
        d = wave_sum(d); float ref = d; const bf16_t* t; int ld, c;
        if (col < 1536) { t = (const bf16_t*)(F.ws + WS_AV); ld = 512; c = col - 1024; }
        else if (col < 1792) { t = (const bf16_t*)(F.ws + WS_RQ); ld = 256; c = col - 1536; }
        else if (col < 2048) { t = (const bf16_t*)(F.ws + WS_RK); ld = 256; c = col - 1792; ref = d * 0.125f; }
        else if (col < 2560) { t = (const bf16_t*)(F.ws + WS_RV); ld = 512; c = col - 2048; }
        else { t = (const bf16_t*)(F.ws + WS_RG); ld = 512; c = col - 2560; ref = d / (1.f + expf(-d)); }
        const float got = bf2f(t[(size_t)row * ld + c]);
        if (lane == 0) dbg_report(F, got, ref, 0.02f, 0.02f);
    }
}


__device__ __forceinline__ void dbg_check_attn(Frame& F, int s) {
    const int lane = F.lane;
    const int b = s & 1, h = (s >> 1) & 7; int t = (int)(((long)s * 7919 + 5) % SEQ); if ((s & 63) == 0) t = (s >> 6) % 70; if ((s & 63) == 1) t = SEQ - 1 - ((s >> 6) % 70);
    const bf16_t* Q = (const bf16_t*)(F.ws + WS_AQ) + (size_t)b * SEQ * 512 + h * 64;
    const bf16_t* K = (const bf16_t*)(F.ws + WS_AK) + (size_t)b * SEQ * 512 + h * 64;
    const bf16_t* V = (const bf16_t*)(F.ws + WS_AV) + (size_t)b * SEQ * 512 + h * 64;
    const float slope = exp2f(-(float)(h + 1));
    float oacc[3], lse[3];
    const int dils[3] = {1, 4, 16};
    for (int pi = 0; pi < 3; ++pi) {
        const int d = dils[pi], r = t % d, jq = t / d, L = SEQ / d;
        float sc[3]; float mx = -1e30f;
        for (int kk = 0; kk < 3; ++kk) { const int dl = -64 + lane + 64 * kk; const int jk = jq + dl; float v = -1e30f;
            if (dl <= 64 && jk >= 0 && jk < L) { const bf16_t* kr = K + (size_t)(r + d * jk) * 512; float a = 0.f; for (int c = 0; c < 64; ++c) a += bf2f(Q[(size_t)t * 512 + c]) * bf2f(kr[c]);
                v = a - slope * (float)(d * (dl < 0 ? -dl : dl)); }
            sc[kk] = v; mx = fmaxf(mx, v); }
#pragma unroll
        for (int o = 1; o < 64; o <<= 1) mx = fmaxf(mx, __shfl_xor(mx, o));
        float den = 0.f, pk[3];
        for (int kk = 0; kk < 3; ++kk) { pk[kk] = sc[kk] > -1e29f ? expf(sc[kk] - mx) : 0.f; den += pk[kk]; }
        den = wave_sum(den);
        float o = 0.f;
        for (int kk = 0; kk < 3; ++kk) for (int l2 = 0; l2 < 64; ++l2) { const float pp = __shfl(pk[kk], l2); const int dl = -64 + l2 + 64 * kk; const int jk = jq + dl;
            if (pp != 0.f) o += pp * bf2f(V[(size_t)(r + d * jk) * 512 + lane]); }
        oacc[pi] = o / den; lse[pi] = mx + logf(den);
    }
    const float ml = fmaxf(lse[0], fmaxf(lse[1], lse[2]));
    const float w0 = expf(lse[0] - ml), w1 = expf(lse[1] - ml), w2 = expf(lse[2] - ml);
    const float ref = (w0 * oacc[0] + w1 * oacc[1] + w2 * oacc[2]) / (w0 + w1 + w2);
    const float got = bf2f(((const bf16_t*)(F.ws + WS_MIX))[((size_t)b * SEQ + t) * 1024 + h * 64 + lane]);
    dbg_report(F, got, ref, 0.004f, 0.02f);
}
__device__ __forceinline__ void dbg_check_ret(Frame& F, int s) {
    const Params& P = *F.p; const int lane = F.lane;
    const int b = s & 1, h = (s >> 1) & 3; int t = (int)(((long)s * 7919 + 5) % SEQ); if ((s & 31) == 0) t = (s >> 5) % 200; if ((s & 31) == 1) t = SEQ - 1 - ((s >> 5) % 200);
    const bf16_t* Q = (const bf16_t*)(F.ws + WS_RQ) + (size_t)b * SEQ * 256 + h * 64;
    const bf16_t* K = (const bf16_t*)(F.ws + WS_RK) + (size_t)b * SEQ * 256 + h * 64;
    const bf16_t* V = (const bf16_t*)(F.ws + WS_RV) + (size_t)b * SEQ * 512 + h * 128;
    const float lgf = -logf(1.f + expf(-P.in[IN_DECF][h])), lgb = -logf(1.f + expf(-P.in[IN_DECB][h]));
    float y0 = 0.f, y1 = 0.f;
    const float qv = bf2f(Q[(size_t)t * 256 + lane]);
    for (int j = 0; j < SEQ; ++j) {
        const int df = t - j; const float lg = (df >= 0 ? lgf * (float)df : lgb * (float)(-df)); if (lg < -40.f) continue;
        float a = qv * bf2f(K[(size_t)j * 256 + lane]); a = wave_sum(a);
        const float wgt = a * expf(lg);
        y0 += wgt * bf2f(V[(size_t)j * 512 + lane]); y1 += wgt * bf2f(V[(size_t)j * 512 + 64 + lane]);
    }
    const float mu = wave_sum(y0 + y1) * (1.f / 128.f); const float d0 = y0 - mu, d1 = y1 - mu;
    const float var = wave_sum(d0 * d0 + d1 * d1) * (1.f / 128.f); const float rstd = 1.f / sqrtf(var + 1e-5f);
    const bf16_t* G = (const bf16_t*)(F.ws + WS_RG) + ((size_t)b * SEQ + t) * 512 + h * 128;
    const float r0 = d0 * rstd * P.in[IN_GNW][h * 128 + lane] * bf2f(G[lane]), r1 = d1 * rstd * P.in[IN_GNW][h * 128 + 64 + lane] * bf2f(G[64 + lane]);
    const bf16_t* M = (const bf16_t*)(F.ws + WS_MIX) + ((size_t)b * SEQ + t) * 1024 + 512 + h * 128;
    dbg_report(F, bf2f(M[lane]), r0, 0.02f, 0.03f); dbg_report(F, bf2f(M[64 + lane]), r1, 0.02f, 0.03f);
}
__device__ __forceinline__ void dbg_check_outproj(Frame& F, int s) {
    const Params& P = *F.p; const int lane = F.lane;
    const int row = (int)(((long)s * 7919 + 13) % NT), col = (int)(((long)s * 104729 + 7) % 1024);
    const bf16_t* M = (const bf16_t*)(F.ws + WS_MIX) + (size_t)row * 1024;
    float d = 0.f; for (int k = lane; k < 1024; k += 64) d += bf2f(M[k]) * P.in[IN_W_OUT][(size_t)k * 1024 + col];
    d = wave_sum(d) + P.in[IN_X][(size_t)row * 1024 + col];
    if (lane == 0) { dbg_report(F, P.out[(size_t)row * 1024 + col], d, 0.01f, 0.01f);
        dbg_report(F, bf2f(((const bf16_t*)(F.ws + WS_X1B))[(size_t)row * 1024 + col]), d, 0.02f, 0.01f); }
    if (s < 256) { float ss = 0.f; for (int k = lane; k < 1024; k += 64) { const float v = P.out[(size_t)row * 1024 + k]; ss += v * v; } ss = wave_sum(ss);
        if (lane == 0) dbg_report(F, ((const float*)(F.ws + WS_SUMSQ1))[row], ss, 0.5f, 0.01f); }
}


__device__ __forceinline__ void dbg_check_memattn(Frame& F, int s, LAS float* scr  ) {
    const Params& P = *F.p; const int lane = F.lane;
    const int tok = (int)(((long)s * 7919 + 13) % NT), head = s & 3, b = tok / SEQ;
    const float* x1 = P.out + (size_t)tok * DM;
    float ss = 0.f; for (int k = lane; k < DM; k += 64) ss += x1[k] * x1[k];
    const float rstd = 1.0f / sqrtf(wave_sum(ss) * (1.f / 1024.f) + 1e-6f);
    float q[4] = {0.f, 0.f, 0.f, 0.f};
    for (int k = 0; k < DM; ++k) { const float hk = x1[k] * rstd * P.in[IN_NORM_MEM][k];
#pragma unroll
        for (int i = 0; i < 4; ++i) q[i] += hk * P.in[IN_W_MQ][(size_t)k * 1024 + head * 256 + lane + 64 * i]; }
    float qs = 0.f;
#pragma unroll
    for (int i = 0; i < 4; ++i) qs += q[i] * q[i];
    const float qr = 1.0f / sqrtf(wave_sum(qs) * (1.f / 256.f) + 1e-6f);
#pragma unroll
    for (int i = 0; i < 4; ++i) scr[lane + 64 * i] = q[i] * qr * P.in[IN_MQN][lane + 64 * i] * 0.0625f;
    LDS_WAIT();
    float sc[4]; const bf16_t* mh = (const bf16_t*)(F.ws + WS_MEMH);
    float kd[4];
    for (int i = 0; i < 4; ++i) { const int key = lane + 64 * i; const bf16_t* mr = mh + (size_t)(b * 256 + key) * 1024; float dot = 0.f, kss = 0.f;
        for (int d = 0; d < 256; ++d) { float kv = 0.f; for (int k = 0; k < DM; ++k) kv += bf2f(mr[k]) * P.in[IN_W_MKV][(size_t)k * 2048 + head * 256 + d];
            kss += kv * kv; dot += kv * P.in[IN_MKN][d] * scr[d]; }
        sc[i] = dot / sqrtf(kss * (1.f / 256.f) + 1e-6f); kd[i] = 0.f; }
    float mx = fmaxf(fmaxf(sc[0], sc[1]), fmaxf(sc[2], sc[3]));
#pragma unroll
    for (int o = 1; o < 64; o <<= 1) mx = fmaxf(mx, __shfl_xor(mx, o));
    float den = 0.f; for (int i = 0; i < 4; ++i) { sc[i] = expf(sc[i] - mx); den += sc[i]; }
    den = wave_sum(den);
    for (int i = 0; i < 4; ++i) scr[1024 + lane + 64 * i] = sc[i] / den;
    LDS_WAIT();
    float o = 0.f;
    for (int key = 0; key < 256; ++key) { const bf16_t* mr = mh + (size_t)(b * 256 + key) * 1024; float vv = 0.f; for (int k = 0; k < DM; ++k) vv += bf2f(mr[k]) * P.in[IN_W_MKV][(size_t)k * 2048 + 1024 + head * 256 + lane]; o += scr[1024 + key] * vv; }
    const float got = bf2f(((const bf16_t*)(F.ws + WS_OM))[(size_t)tok * DM + head * 256 + lane]);
    dbg_report(F, got, o, 0.004f, 0.03f);
    (void)kd;
}


__device__ __forceinline__ void dbg_check_memkv(Frame& F, int s) {
    const Params& P = *F.p; const int lane = F.lane;
    const int b = s & 1, head = (s >> 1) & 3, key = (s * 37 + 11) & 255;
    const bf16_t* mr = (const bf16_t*)(F.ws + WS_MEMH) + (size_t)(b * 256 + key) * 1024;
    float kv[4], vv[4], kss = 0.f;
    for (int i = 0; i < 4; ++i) { const int d = lane + 64 * i; float a = 0.f, c = 0.f; for (int k = 0; k < DM; ++k) { const float m = bf2f(mr[k]); a += m * P.in[IN_W_MKV][(size_t)k * 2048 + head * 256 + d]; c += m * P.in[IN_W_MKV][(size_t)k * 2048 + 1024 + head * 256 + d]; }
        kv[i] = a; vv[i] = c; kss += a * a; }
    const float kr = 1.0f / sqrtf(wave_sum(kss) * (1.f / 256.f) + 1e-6f);
    for (int i = 0; i < 4; ++i) { const int d = lane + 64 * i;
        const float refk = kv[i] * kr * P.in[IN_MKN][d] * P.in[IN_MQN][d] * 0.0625f;
        dbg_report(F, bf2f(((const bf16_t*)(F.ws + WS_MK))[((size_t)(b * 4 + head) * 256 + key) * 256 + d]), refk, 0.002f, 0.02f);
        dbg_report(F, bf2f(((const bf16_t*)(F.ws + WS_MVT))[((size_t)(b * 4 + head) * 256 + d) * 256 + key]), vv[i], 0.02f, 0.02f); }
}
__device__ __forceinline__ void dbg_check_memq(Frame& F, int s) {
    const Params& P = *F.p; const int lane = F.lane;
    const int tok = (int)(((long)s * 7919 + 13) % NT), head = s & 3;
    const float* x1 = P.out + (size_t)tok * DM;
    float ss = 0.f; for (int k = lane; k < DM; k += 64) ss += x1[k] * x1[k];
    const float rstd = 1.0f / sqrtf(wave_sum(ss) * (1.f / 1024.f) + 1e-6f);
    float q[4] = {0.f, 0.f, 0.f, 0.f};
    for (int k = 0; k < DM; ++k) { const float hk = x1[k] * rstd * P.in[IN_NORM_MEM][k];
#pragma unroll
        for (int i = 0; i < 4; ++i) q[i] += hk * P.in[IN_W_MQ][(size_t)k * 1024 + head * 256 + lane + 64 * i]; }
    float qs = 0.f;
#pragma unroll
    for (int i = 0; i < 4; ++i) { qs += q[i] * q[i]; dbg_report(F, bf2f(((const bf16_t*)(F.ws + WS_QM))[(size_t)tok * DM + head * 256 + lane + 64 * i]), q[i], 0.02f, 0.02f); }
    qs = wave_sum(qs);
    dbg_report(F, ((const float*)(F.ws + WS_HSQ))[(size_t)tok * 4 + head], qs, 1.0f, 0.02f);
}
__device__ __forceinline__ void dbg_check_memo(Frame& F, int s, LAS float* scr) {
    const int lane = F.lane;
    const int tok = (int)(((long)s * 7919 + 13) % NT), head = s & 3, b = tok / SEQ;
    const bf16_t* q = (const bf16_t*)(F.ws + WS_QM) + (size_t)tok * DM + head * 256;
    const float hs = 1.0f / sqrtf(((const float*)(F.ws + WS_HSQ))[(size_t)tok * 4 + head] * (1.f / 256.f) + 1e-6f);
    const bf16_t* K = (const bf16_t*)(F.ws + WS_MK) + (size_t)(b * 4 + head) * 65536;
    const bf16_t* Vt = (const bf16_t*)(F.ws + WS_MVT) + (size_t)(b * 4 + head) * 65536;
    float sc[4], mx = -1e30f;
    for (int i = 0; i < 4; ++i) { const int key = lane + 64 * i; float a = 0.f; for (int d = 0; d < 256; ++d) a += bf2f(q[d]) * bf2f(K[(size_t)key * 256 + d]); sc[i] = a * hs; if (DBG_P7 == 4) sc[i] = logf(fmaxf(1e-30f, 1.0f + sc[i])); if (DBG_P7 == 1) sc[i] = 0.f; if (DBG_P7 == 2) sc[i] = logf(sc[i] * sc[i] + 1e-30f); mx = fmaxf(mx, sc[i]); }
#pragma unroll
    for (int o = 1; o < 64; o <<= 1) mx = fmaxf(mx, __shfl_xor(mx, o));
    float den = 0.f; for (int i = 0; i < 4; ++i) { sc[i] = expf(sc[i] - mx); den += sc[i]; }
    den = wave_sum(den);
    for (int i = 0; i < 4; ++i) scr[lane + 64 * i] = sc[i] / den;
    LDS_WAIT();
    for (int i = 0; i < 4; ++i) { const int d = lane + 64 * i; float o = 0.f; for (int key = 0; key < 256; ++key) o += scr[key] * bf2f(Vt[(size_t)d * 256 + key]);
        dbg_report(F, bf2f(((const bf16_t*)(F.ws + WS_OM))[(size_t)tok * DM + head * 256 + d]), o, 0.003f, 0.02f); }
    LDS_WAIT();
}

#ifndef DBG_STAGE
#define DBG_STAGE 99
#endif
__global__ void __launch_bounds__(NTHR, 2) fwd_megakernel(Params prm) {
    extern __shared__ __attribute__((aligned(16))) unsigned char lds_raw[];
    Frame F;
    F.lds = (LAS unsigned char*)lds_raw; F.tid = threadIdx.x; F.lane = F.tid & 63; F.wave = __builtin_amdgcn_readfirstlane(F.tid >> 6);
    F.G = gridDim.x; { const int bx = blockIdx.x; F.vcu = (F.G % 8 == 0) ? (bx % 8) * (F.G / 8) + bx / 8 : bx; }
    F.p = &prm; F.ws = prm.ws;
    if (F.tid < 16) ((LAS unsigned*)(F.lds + LDS_MISC_OFF))[F.tid] = 0u;
    __syncthreads();
    XcdBarrier xbar = xcd_barrier_post((unsigned*)(F.ws + WS_CTL) + CW_BAR, (volatile LAS unsigned*)(F.lds + LDS_MISC_OFF));
#define REFRESH() do { int t_ = threadIdx.x; asm volatile("" : "+v"(t_)); F.tid = t_; F.lane = t_ & 63; F.wave = __builtin_amdgcn_readfirstlane(t_ >> 6); } while (0)
#define GRID_BAR() do { xcd_barrier(xbar); REFRESH(); } while (0)

    p0_prologue<0>(F);
#if REP & 1
    p0_prologue<0>(F);
#endif
    GRID_BAR();
    {
        pg8::DenseOrder S; S.init(prm.out, F.ws + WS_WIN, NT, 3072, 1024, F.G, (int)blockIdx.x);
        EpiInProj E{F.ws, prm.in[IN_AQN], prm.in[IN_AKN]};
        if (F.vcu & 1) { p0_prologue<1>(F); __syncthreads(); }
        pg8::gemm_phase(F.lds, 1024, S, E);
        if (!(F.vcu & 1)) { __syncthreads(); p0_prologue<1>(F); }
#if REP & 256
        pg8::gemm_phase(F.lds, 1024, S, E);
#endif
    }
    GRID_BAR();
#if DBG_STAGE == 1
    {
        const int gw = blockIdx.x * NWAVES + F.wave, NGW = F.G * NWAVES;
        for (int s = gw; s < 4096; s += NGW) dbg_check_inproj(F, s);
        dbg_finish(F, xbar);
        return;
    }
#endif
    p2_attention<0>(F, (bf16_t*)(F.ws + WS_MIX));
    __syncthreads();
#if REP & 2
    p2_attention<ATT_VAR>(F, (bf16_t*)(F.ws + WS_ST));
    __syncthreads();
#endif
    p2_chunk_kv(F);
#if REP & 4
    p2_chunk_kv(F);
#endif
    GRID_BAR();
    p3_scan(F);
#if REP & 8
    p3_scan(F);
#endif
    GRID_BAR();
    p4_retention_out(F);
#if REP & 16
    p4_retention_out(F);
#endif
    GRID_BAR();
#if DBG_STAGE == 2 || DBG_STAGE == 3
    {
        const int gw = blockIdx.x * NWAVES + F.wave, NGW = F.G * NWAVES;
        if (DBG_STAGE == 2) for (int s = gw; s < 8192; s += NGW) dbg_check_attn(F, s);
        if (DBG_STAGE == 3) for (int s = gw; s < 2048; s += NGW) dbg_check_ret(F, s);
        dbg_finish(F, xbar);
        return;
    }
#endif
    {
        pg8::DenseOrder S; S.init(F.ws + WS_MIX, F.ws + WS_WOUT, NT, 1024, 1024, F.G, (int)blockIdx.x, GEMM_WGM);
        EpiResidHL<true> E{prm.in[IN_NORM_MIX], (const bf16_t*)prm.out, (const float*)(F.ws + WS_RSTD0), (bf16_t*)(F.ws + WS_X1B), (bf16_t*)(F.ws + WS_X1L), (float*)(F.ws + WS_SUMSQ1), nullptr};
        pg8::gemm_phase(F.lds, 1024, S, E);
#if REP & 16384
        { EpiNull E3{(float*)(F.ws + WS_CTL + MiB)}; pg8::gemm_phase(F.lds, 1024, S, E3); }
#endif
#if REP & 512
        { EpiResidHL<true> E2{prm.in[IN_NORM_MIX], (const bf16_t*)prm.out, (const float*)(F.ws + WS_RSTD0), (bf16_t*)(F.ws + WS_X1B), (bf16_t*)(F.ws + WS_X1L), (float*)(F.ws + WS_CTL + MiB), nullptr}; pg8::gemm_phase(F.lds, 1024, S, E2); }
#endif
    }
    GRID_BAR();
#if DBG_STAGE == 4
    {
        const int gw = blockIdx.x * NWAVES + F.wave, NGW = F.G * NWAVES;
        for (int s = gw; s < 8192; s += NGW) dbg_check_outproj(F, s);
        dbg_finish(F, xbar);
        return;
    }
#endif
    memkv_item(F, F.vcu);
#if REP & 1024
    memkv_item(F, F.vcu);
#endif
    {
        pg8::DenseOrder S; S.init(F.ws + WS_X1B, F.ws + WS_WMQ, NT, 1024, 1024, F.G, (int)blockIdx.x, GEMM_WGM);
        EpiMemQ E{(bf16_t*)(F.ws + WS_QM), (const float*)(F.ws + WS_SUMSQ1), (float*)(F.ws + WS_HSQ)};
        pg8::gemm_phase(F.lds, 1024, S, E);
#if REP & 8192
        { EpiMemQ E2{(bf16_t*)(F.ws + WS_QM), (const float*)(F.ws + WS_SUMSQ1), (float*)(F.ws + WS_CTL + MiB + 256 * 1024)}; pg8::gemm_phase(F.lds, 1024, S, E2); }
#endif
    }
    GRID_BAR();
    p7_mem_attention(F);
#if REP & 32
    p7_mem_attention(F);
#endif
    GRID_BAR();
#if DBG_STAGE >= 5 && DBG_STAGE <= 8
    {
        const int gw = blockIdx.x * NWAVES + F.wave, NGW = F.G * NWAVES;
        if (DBG_STAGE == 5) for (int s = gw; s < 2048; s += NGW) dbg_check_memattn(F, s, (LAS float*)(F.lds + F.wave * 8192));
        if (DBG_STAGE == 6) for (int s = gw; s < 2048; s += NGW) dbg_check_memkv(F, s);
        if (DBG_STAGE == 7) for (int s = gw; s < 2048; s += NGW) dbg_check_memq(F, s);
        if (DBG_STAGE == 8) for (int s = gw; s < 4096; s += NGW) dbg_check_memo(F, s, (LAS float*)(F.lds + F.wave * 8192));
        dbg_finish(F, xbar);
        return;
    }
#endif
    {
        pg8::DenseOrder S; S.init(F.ws + WS_OM, F.ws + WS_WMO, NT, 1024, 512, F.G, (int)blockIdx.x, GEMM_WGM);
        EpiResidHL<false> E{nullptr, (const bf16_t*)(F.ws + WS_X1B), nullptr, (bf16_t*)(F.ws + WS_X2B), (bf16_t*)(F.ws + WS_X2L), (float*)(F.ws + WS_SUMSQ2), (unsigned char*)(F.ws + WS_X2Q)};
        pg8::gemm_phase<EpiResidHL<false>, pg8::DenseOrder, true, 123, 122>(F.lds, 512, S, E);
    }
    GRID_BAR();
#if DBG_STAGE == 9
    return;
#endif
    p9_route(F, (unsigned*)(F.ws + WS_CTL) + CW_CNT);
#if REP & 64
    p9_route(F, (unsigned*)(F.ws + WS_CTL) + 3000);
#endif
    GRID_BAR();
    {
        const int ntiles = moe_tables(F);
        {
            MoeOrder1 S; S.A = (const char*)(F.ws + WS_X2Q); S.W = (const char*)(F.ws + WS_W13); S.cn = (LAS const unsigned*)(F.lds + LDS_MOE_TAB); S.slote = (const unsigned*)(F.ws + WS_SLOTE);
            S.ntiles = ntiles; S.G = F.G; S.c = F.vcu; S.kb = 512; S.wstride = (size_t)1024 * 1024; S.tstepB = (size_t)256 * 1024; S.tstepA = 0;
            EpiMoe1 E{(unsigned char*)(F.ws + WS_H), (const unsigned*)(F.ws + WS_SLOTE), (LAS const unsigned*)(F.lds + LDS_MOE_TAB), (const float*)(F.ws + WS_SUMSQ2)};
            pg8::gemm_phase<EpiMoe1, MoeOrder1, true, 127, 122>(F.lds, 512, S, E);
#if REP & 32768
            { EpiNull E3{(float*)prm.out}; pg8::gemm_phase<EpiNull, MoeOrder1, true, 127, 122>(F.lds, 512, S, E3); }
#endif
#if REP & 2048
            pg8::gemm_phase<EpiMoe1, MoeOrder1, true, 127, 122>(F.lds, 512, S, E);
#endif
        }
        GRID_BAR();
        {
            MoeOrder2 S; S.A = (const char*)(F.ws + WS_H); S.W = (const char*)(F.ws + WS_W2); S.cn = (LAS const unsigned*)(F.lds + LDS_MOE_TAB); S.slote = nullptr;
            S.ntiles = ntiles; S.G = F.G; S.c = F.vcu; S.kb = 256; S.wstride = (size_t)1024 * 512; S.tstepB = (size_t)256 * 512; S.tstepA = (size_t)256 * 512;
            EpiMoe2 E{(unsigned char*)(F.ws + WS_Y)};
            pg8::gemm_phase<EpiMoe2, MoeOrder2, true, 124, 123>(F.lds, 256, S, E);
#if REP & 65536
            { EpiNull E3{(float*)prm.out}; pg8::gemm_phase<EpiNull, MoeOrder2, true, 124, 123>(F.lds, 256, S, E3); }
#endif
#if REP & 4096
            pg8::gemm_phase<EpiMoe2, MoeOrder2, true, 124, 123>(F.lds, 256, S, E);
#endif
        }
        GRID_BAR();
    }
#if REP & 128
    p13_combine(F, (float*)(F.ws + WS_H));
#endif
    p13_combine(F, prm.out);
}

extern "C" void kernel_launch(void* const* d_in, const int* in_sizes, int n_in, void* d_out, int out_size, void* d_ws, size_t ws_size, hipStream_t stream) {
    static int grid = 0;
    if (grid == 0) {
        if (n_in != 23 || out_size != NT * DM || ws_size < WS_END) { fprintf(stderr, "kernel_launch: unexpected shapes (n_in %d out %d ws %zu)\n", n_in, out_size, ws_size); grid = -1; return; }
        int dev = 0, cus = 0, per_cu = 0;
        hipGetDevice(&dev); hipDeviceGetAttribute(&cus, hipDeviceAttributeMultiprocessorCount, dev);
        if (hipFuncSetAttribute((const void*)fwd_megakernel, hipFuncAttributeMaxDynamicSharedMemorySize, LDS_BYTES) != hipSuccess) { fprintf(stderr, "hipFuncSetAttribute failed\n"); grid = -1; return; }
        if (hipOccupancyMaxActiveBlocksPerMultiprocessor(&per_cu, (const void*)fwd_megakernel, NTHR, LDS_BYTES) != hipSuccess || per_cu < 1) { fprintf(stderr, "occupancy query: %d\n", per_cu); grid = -1; return; }
        if (cus < 256) { fprintf(stderr, "kernel_launch: this kernel is laid out for a 256-CU device (got %d)\n", cus); grid = -1; return; }
        grid = 256;
        fprintf(stderr, "kernel_launch: grid %d (cus %d, per_cu %d)\n", grid, cus, per_cu);
    }
    if (grid < 0) return;
    hipMemsetAsync((char*)d_ws + WS_CTL, 0, CTL_ZERO_BYTES, stream);
    Params p{};
    for (int i = 0; i < 23; ++i) p.in[i] = (const float*)d_in[i];
    p.out = (float*)d_out; p.ws = (unsigned char*)d_ws;
    hipLaunchKernelGGL(fwd_megakernel, dim3(grid), dim3(NTHR), LDS_BYTES, stream, p);
    hipError_t e = hipPeekAtLastError();
    if (e != hipSuccess) fprintf(stderr, "launch failed: %s (grid %d)\n", hipGetErrorString(e), grid);
}
```

```cpp
#include <hip/hip_runtime.h>
#include <hip/hip_cooperative_groups.h>
#include <cstdio>
#include <cstdint>
namespace cg = cooperative_groups;
#ifndef ATT_VAR
#define ATT_VAR 0
#endif
#ifndef GEMM_WGM
#define GEMM_WGM 4
#endif
#ifndef REP
#define REP 0
#endif
#ifndef DBG_P7
#define DBG_P7 0
#endif

#define LAS __attribute__((address_space(3)))
#define GAS __attribute__((address_space(1)))
typedef unsigned short bf16_t;
typedef short bf16x8 __attribute__((ext_vector_type(8)));
typedef short bf16x4 __attribute__((ext_vector_type(4)));
typedef float f32x4 __attribute__((ext_vector_type(4)));
typedef float f32x2 __attribute__((ext_vector_type(2)));
typedef unsigned u32x4 __attribute__((ext_vector_type(4)));
typedef unsigned u32x2 __attribute__((ext_vector_type(2)));

constexpr int NB = 2, SEQ = 16384, NT = NB * SEQ, DM = 1024;
constexpr int NMEM = 256;
constexpr int NEXP = 32, FF = 512;
constexpr int NWAVES = 8, NTHR = 512;
constexpr int MAX_TILES = 288, MAX_SLOTS = MAX_TILES * 256;

constexpr size_t MiB = 1u << 20;
constexpr size_t WS_CTL = 0, CTL_ZERO_BYTES = 64 * 1024;
constexpr size_t WS_SUMSQ1 = 64 * 1024, WS_SUMSQ2 = 320 * 1024, WS_HSQ = 576 * 1024;
typedef unsigned long long u64_t;
__device__ __forceinline__ void stat_add(u64_t* p, float v) { const float fl = __builtin_floorf(v); const unsigned hi = (unsigned)fl, lo = (unsigned)((v - fl) * 4294967296.0f); atomicAdd(p, ((u64_t)hi << 32) | (u64_t)lo); }
__device__ __forceinline__ float stat_get(const u64_t* p) { const u64_t v = *p; return (float)(unsigned)(v >> 32) + (float)(unsigned)v * 2.3283064365386963e-10f; }
constexpr int CW_CNT = 2048, CW_FILL = 2048 + 64, CW_NTILES = 2048 + 128;
constexpr size_t WS_WIN = 2 * MiB, WS_WOUT = 8 * MiB, WS_WMQ = 10 * MiB, WS_WMKV = 12 * MiB, WS_WMO = 16 * MiB, WS_W13 = 18 * MiB, WS_W2 = 82 * MiB;
constexpr size_t WS_MEMH = 114 * MiB, WS_MK = 115 * MiB, WS_MVT = 116 * MiB, WS_ROUTE = 117 * MiB, WS_SLOTTOK = 118 * MiB, WS_SLOTGATE = 118 * MiB + 512 * 1024, WS_TILEEXP = 119 * MiB;
constexpr size_t WS_AQ = 128 * MiB, WS_AK = 160 * MiB, WS_AV = 192 * MiB, WS_RQ = 224 * MiB, WS_RK = 240 * MiB, WS_RV = 256 * MiB, WS_RG = 288 * MiB;
constexpr size_t WS_X1B = 128 * MiB, WS_QM = 192 * MiB, WS_OM = 256 * MiB, WS_Y = 128 * MiB;
constexpr size_t WS_XB = 320 * MiB, WS_MIX = 320 * MiB, WS_X2B = 320 * MiB;
constexpr size_t WS_KV = 384 * MiB, WS_ST = 448 * MiB, WS_H = 384 * MiB;
constexpr size_t WS_WRT = 119 * MiB + 64 * 1024;
constexpr size_t WS_X1L = 384 * MiB, WS_X2L = 192 * MiB;
constexpr size_t WS_RSTD0 = 125 * MiB;
constexpr size_t WS_X1Q = 448 * MiB;
constexpr size_t WS_X2Q = 192 * MiB;
constexpr size_t WS_END = 512 * MiB;

constexpr int LDS_BYTES = 147456;

__device__ __forceinline__ unsigned cvt_pk_bf16(float lo, float hi) { unsigned r; asm volatile("s_nop 0\n\tv_cvt_pk_bf16_f32 %0, %1, %2" : "=v"(r) : "v"(lo), "v"(hi)); return r; }
typedef __bf16 bf16v2_t __attribute__((ext_vector_type(2)));
__device__ __forceinline__ unsigned cvt_pk_bf16_c(float lo, float hi) { f32x2 v = {lo, hi}; bf16v2_t r = __builtin_convertvector(v, bf16v2_t); return __builtin_bit_cast(unsigned, r); }
__device__ __forceinline__ float bf2f(unsigned short b) { return __uint_as_float(((unsigned)b) << 16); }
__device__ __forceinline__ float bflo(unsigned w) { return __uint_as_float(w << 16); }
__device__ __forceinline__ float bfhi(unsigned w) { return __uint_as_float(w & 0xffff0000u); }
__device__ __forceinline__ float xl_dpp_quad1(float v) { return __builtin_bit_cast(float, __builtin_amdgcn_update_dpp(0, __builtin_bit_cast(int, v), 0xB1, 0xF, 0xF, true)); }
__device__ __forceinline__ float xl_dpp_quad2(float v) { return __builtin_bit_cast(float, __builtin_amdgcn_update_dpp(0, __builtin_bit_cast(int, v), 0x4E, 0xF, 0xF, true)); }
__device__ __forceinline__ float xl_dpp_ror4(float v)  { return __builtin_bit_cast(float, __builtin_amdgcn_update_dpp(0, __builtin_bit_cast(int, v), 0x124, 0xF, 0xF, true)); }
__device__ __forceinline__ float xl_dpp_ror8(float v)  { return __builtin_bit_cast(float, __builtin_amdgcn_update_dpp(0, __builtin_bit_cast(int, v), 0x128, 0xF, 0xF, true)); }
__device__ __forceinline__ float xl_swz16(float v)     { return __builtin_bit_cast(float, __builtin_amdgcn_ds_swizzle(__builtin_bit_cast(int, v), 0x401F)); }
__device__ __forceinline__ void xl_swap32(float& a, float& b) { asm volatile("s_nop 1\n\tv_permlane32_swap_b32 %0, %1\n\ts_nop 1" : "+v"(a), "+v"(b)); }
__device__ __forceinline__ float sum_g4(float v) { v += xl_swz16(v); float a = v, b = v; xl_swap32(a, b); return a + b; }
__device__ __forceinline__ float max_g4(float v) { v = fmaxf(v, xl_swz16(v)); float a = v, b = v; xl_swap32(a, b); return fmaxf(a, b); }
__device__ __forceinline__ float sum_row16(float v) { v += xl_dpp_quad1(v); v += xl_dpp_quad2(v); v += xl_dpp_ror4(v); v += xl_dpp_ror8(v); return v; }
__device__ __forceinline__ float max_row16(float v) { v = fmaxf(v, xl_dpp_quad1(v)); v = fmaxf(v, xl_dpp_quad2(v)); v = fmaxf(v, xl_dpp_ror4(v)); v = fmaxf(v, xl_dpp_ror8(v)); return v; }
__device__ __forceinline__ float wave_sum(float v) { return sum_g4(sum_row16(v)); }
__device__ __forceinline__ float wave_max(float v) { return max_g4(max_row16(v)); }
__device__ __forceinline__ float fast_exp(float x) { return __builtin_amdgcn_exp2f(x * 1.44269504089f); }
__device__ __forceinline__ float silu_f(float x) { return x * __builtin_amdgcn_rcpf(1.0f + fast_exp(-x)); }
#define LDS_WAIT() asm volatile("s_waitcnt lgkmcnt(0)" ::: "memory")
#define VM_WAIT() asm volatile("s_waitcnt vmcnt(0)" ::: "memory")

namespace pg8 {
constexpr int BM = 256, BK = 64, HALF = 128, HTB = HALF * BK * 2, STAGE_BYTES = 8 * HTB, NXCD = 8, WGM = 8;
__host__ __device__ __forceinline__ int lds_byte(int r, int c) { const int st = (r >> 4) * 2 + (c >> 5), rr = r & 15, cc = c & 31, ob = rr * 64 + cc * 2; return st * 1024 + (ob ^ (((ob >> 9) & 1) << 5)); }
__host__ __device__ __forceinline__ void stage_rc(int b, int& R, int& C) { const int st = b / 1024, sb = b % 1024, swz = sb ^ (((sb >> 9) & 1) << 5); R = (st >> 1) * 16 + swz / 64; C = (st & 1) * 32 + (swz % 64) / 2; }
__host__ __device__ __forceinline__ int perm32(int rho) { const int n = rho >> 4, i = rho & 15; return 8 * (i >> 2) + 4 * n + (i & 3); }

struct Unit { int pm, pn; const char* A; const char* B; int aux; };

struct DenseOrder {
    static constexpr bool GATHER = false;
    const char* A; const char* Bt; int nM, nN, nwg, G, c, wgm; size_t tstep;
    __device__ void init(const void* A_, const void* Bt_, int M, int N, int K, int G_, int c_, int wgm_ = WGM) { A = (const char*)A_; Bt = (const char*)Bt_; nM = M / BM; nN = N / BM; nwg = nM * nN; G = G_; c = c_; wgm = wgm_; tstep = (size_t)BM * K * 2; }
    __device__ bool next(int i, Unit& u) const {
        const long L = (long)i * G + c; if (L >= nwg) return false;
        int wgid = (int)L; { const int q = nwg / NXCD, r = nwg % NXCD, xcd = wgid % NXCD, off = wgid / NXCD; wgid = (xcd < r ? xcd * (q + 1) : r * (q + 1) + (xcd - r) * q) + off; }
        const int nig = wgm * nN, gid = wgid / nig, fm = gid * wgm, gsz = (nM - fm) < wgm ? (nM - fm) : wgm;
        u.pm = fm + ((wgid % nig) % gsz); u.pn = (wgid % nig) / gsz; u.A = A + (size_t)u.pm * tstep; u.B = Bt + (size_t)u.pn * tstep; u.aux = 0; return true;
    }
    __device__ __forceinline__ void gather(const Unit&, int, int, int, int, unsigned (&)[2][2]) const {}
};

template <class Epi, class Sched, bool FP8 = false, int SCA = 127, int SCB = 127>
__device__ __forceinline__ void gemm_phase(LAS unsigned char* lds, const int K, const Sched& S, const Epi& E) {
    constexpr bool GATHER = Sched::GATHER;
    int tid = threadIdx.x; asm volatile("" : "+v"(tid));
    const int wid = __builtin_amdgcn_readfirstlane(tid >> 6), lane = tid & 63, wr = wid >> 2, wc = wid & 3, fr = lane & 15, fq = lane >> 4;
    const int nt = K / BK;
    unsigned voffA[2], voffB[2]; int sR[2], sC[2];
#pragma unroll
    for (int i = 0; i < 2; ++i) { int R, C; stage_rc(tid * 16 + i * 8192, R, C); const int Rb = Epi::PERM ? ((R & ~31) + perm32(R & 31)) : R;
        sR[i] = R; sC[i] = C; voffA[i] = (unsigned)(R * K + C) * 2u; voffB[i] = (unsigned)(Rb * K + C) * 2u; }
    const size_t kstep = (size_t)(BK * 2);
    const size_t hstep = (size_t)HALF * K * 2;
    const unsigned ldsw = (unsigned)wid * 1024u;
    const int aoff = lds_byte(wr * 64 + fr, fq * 8), boff = lds_byte(wc * 32 + fr, fq * 8);
#define PG8_SA(b, h) (((b) * 2 + (h)) * HTB)
#define PG8_SB(b, h) ((4 + (b) * 2 + (h)) * HTB)
#define PG8_STAGE2(bufoff, gbase, o0, o1) do { \
        __builtin_amdgcn_global_load_lds((const unsigned*)((const char*)(gbase) + (o0)), (LAS unsigned*)(lds + (bufoff) + ldsw), 16, 0, 0); \
        __builtin_amdgcn_global_load_lds((const unsigned*)((const char*)(gbase) + (o1)), (LAS unsigned*)(lds + (bufoff) + ldsw + 8192), 16, 0, 0); } while (0)
#define PG8_STAGE_B(bufoff, gbase) PG8_STAGE2(bufoff, gbase, voffB[0], voffB[1])
#define PG8_STAGE_A(bufoff, gbase, h, VA) PG8_STAGE2(bufoff, (gbase) + (GATHER ? (size_t)0 : (size_t)(h) * hstep), VA[GATHER ? (h) : 0][0], VA[GATHER ? (h) : 0][1])
#define PG8_LDA(dst, b, h) do { _Pragma("unroll") for (int m = 0; m < 4; ++m) _Pragma("unroll") for (int k = 0; k < 2; ++k) dst[m][k] = *(const LAS bf16x8*)(lds + PG8_SA(b, h) + aoff + m * 2048 + k * 1024); } while (0)
#define PG8_LDB(dst, b, h) do { _Pragma("unroll") for (int n = 0; n < 2; ++n) _Pragma("unroll") for (int k = 0; k < 2; ++k) dst[n][k] = *(const LAS bf16x8*)(lds + PG8_SB(b, h) + boff + n * 2048 + k * 1024); } while (0)
#define PG8_MMA(ai, bj, At, Bt) do { __builtin_amdgcn_s_setprio(1); _Pragma("unroll") for (int m = 0; m < 4; ++m) _Pragma("unroll") for (int n = 0; n < 2; ++n) { \
        if constexpr (FP8) { typedef int i32x4_ __attribute__((ext_vector_type(4))); typedef int i32x8_ __attribute__((ext_vector_type(8))); \
            const i32x8_ bq = __builtin_shufflevector(__builtin_bit_cast(i32x4_, Bt[n][0]), __builtin_bit_cast(i32x4_, Bt[n][1]), 0, 1, 2, 3, 4, 5, 6, 7); \
            const i32x8_ aq = __builtin_shufflevector(__builtin_bit_cast(i32x4_, At[m][0]), __builtin_bit_cast(i32x4_, At[m][1]), 0, 1, 2, 3, 4, 5, 6, 7); \
            asm volatile("v_mfma_scale_f32_16x16x128_f8f6f4 %0, %1, %2, %0, %3, %4 op_sel_hi:[0,0,0]" : "+v"(acc[ai][bj][m][n]) : "v"(bq), "v"(aq), "v"(scb_), "v"(sca_)); } \
        else { _Pragma("unroll") for (int k = 0; k < 2; ++k) acc[ai][bj][m][n] = __builtin_amdgcn_mfma_f32_16x16x32_bf16(Bt[n][k], At[m][k], acc[ai][bj][m][n], 0, 0, 0); } } \
        __builtin_amdgcn_s_setprio(0); } while (0)
#define PG8_WAIT_V(n) asm volatile("s_waitcnt vmcnt(" #n ")" ::: "memory")
#define PG8_WAIT_L(n) asm volatile("s_waitcnt lgkmcnt(" #n ")" ::: "memory")
#define PG8_BAR __builtin_amdgcn_s_barrier()
#define PG8_SCHED __builtin_amdgcn_sched_barrier(0)
    Unit cur, nxt; int ui = 0;
    if (!S.next(0, cur)) return;
    f32x4 acc[2][2][4][2];
#pragma unroll
    for (int a = 0; a < 2; ++a)
#pragma unroll
        for (int b = 0; b < 2; ++b)
#pragma unroll
            for (int m = 0; m < 4; ++m)
#pragma unroll
                for (int n = 0; n < 2; ++n) acc[a][b][m][n] = (f32x4){0.f, 0.f, 0.f, 0.f};
    bf16x8 At[4][2], B0[2][2], B1[2][2];
    int sca_ = SCA * 0x01010101, scb_ = SCB * 0x01010101;
    unsigned vAc[2][2], vAn[2][2];
    if constexpr (GATHER) { S.gather(cur, sR[0], sR[1], sC[0], sC[1], vAc); }
    else { vAc[0][0] = voffA[0]; vAc[0][1] = voffA[1]; vAc[1][0] = voffA[0]; vAc[1][1] = voffA[1]; }
#pragma unroll
    for (int h = 0; h < 2; ++h) { vAn[h][0] = vAc[h][0]; vAn[h][1] = vAc[h][1]; }
    const char* cA = cur.A; const char* cB = cur.B;
    PG8_STAGE_B(PG8_SB(0, 0), cB); PG8_STAGE_A(PG8_SA(0, 0), cA, 0, vAc); PG8_STAGE_B(PG8_SB(0, 1), cB + hstep); PG8_STAGE_A(PG8_SA(0, 1), cA, 1, vAc);
    if (wr == 1) PG8_BAR;
    PG8_WAIT_V(4); PG8_BAR;
    PG8_STAGE_B(PG8_SB(1, 0), cB + kstep); PG8_STAGE_A(PG8_SA(1, 0), cA + kstep, 0, vAc); PG8_STAGE_B(PG8_SB(1, 1), cB + hstep + kstep);
    PG8_WAIT_V(6); PG8_BAR;
    for (;;) {
        const bool has_next = S.next(ui + 1, nxt);
        const char* nA = has_next ? nxt.A : cA; const char* nB = has_next ? nxt.B : cB;
        if constexpr (GATHER) { if (has_next) S.gather(nxt, sR[0], sR[1], sC[0], sC[1], vAn); }
        for (int t = 0; t < nt; t += 2) {
            const bool last = (t == nt - 2);
            const char* a1 = cA + (size_t)(t + 1) * kstep;
            const char* a2 = last ? nA : cA + (size_t)(t + 2) * kstep; const char* b2 = last ? nB : cB + (size_t)(t + 2) * kstep;
            const char* a3 = a2 + kstep; const char* b3 = b2 + kstep;
            unsigned vA2[2][2];
#pragma unroll
            for (int h = 0; h < 2; ++h) { vA2[h][0] = (GATHER && last) ? vAn[h][0] : vAc[h][0]; vA2[h][1] = (GATHER && last) ? vAn[h][1] : vAc[h][1]; }
            PG8_LDB(B0, 0, 0); PG8_SCHED; PG8_LDA(At, 0, 0); PG8_STAGE_A(PG8_SA(1, 1), a1, 1, vAc);
            PG8_WAIT_L(8); PG8_BAR; PG8_WAIT_L(0); PG8_MMA(0, 0, At, B0); PG8_BAR; PG8_SCHED;
            PG8_LDB(B1, 0, 1); PG8_STAGE_B(PG8_SB(0, 0), b2);
            PG8_BAR; PG8_WAIT_L(0); PG8_MMA(0, 1, At, B1); PG8_BAR;
            PG8_LDA(At, 0, 1); PG8_STAGE_A(PG8_SA(0, 0), a2, 0, vA2);
            PG8_BAR; PG8_WAIT_L(0); PG8_MMA(1, 0, At, B0); PG8_BAR; PG8_SCHED;
            PG8_STAGE_B(PG8_SB(0, 1), b2 + hstep);
            PG8_WAIT_V(6); PG8_BAR; PG8_MMA(1, 1, At, B1); PG8_BAR;
            PG8_LDB(B0, 1, 0); PG8_SCHED; PG8_LDA(At, 1, 0); PG8_STAGE_A(PG8_SA(0, 1), a2, 1, vA2);
            PG8_WAIT_L(8); PG8_BAR; PG8_WAIT_L(0); PG8_MMA(0, 0, At, B0); PG8_BAR; PG8_SCHED;
            PG8_LDB(B1, 1, 1); PG8_STAGE_B(PG8_SB(1, 0), b3);
            PG8_BAR; PG8_WAIT_L(0); PG8_MMA(0, 1, At, B1); PG8_BAR;
            PG8_LDA(At, 1, 1); PG8_STAGE_A(PG8_SA(1, 0), a3, 0, vA2);
            PG8_BAR; PG8_WAIT_L(0); PG8_MMA(1, 0, At, B0); PG8_BAR; PG8_SCHED;
            PG8_STAGE_B(PG8_SB(1, 1), b3 + hstep);
            PG8_WAIT_V(6); PG8_BAR; PG8_MMA(1, 1, At, B1); PG8_BAR;
        }
        if constexpr (FP8) asm volatile("s_nop 15\n\ts_nop 15" ::: "memory");
        E(acc, cur, wr, wc, fr, fq);
        if (!has_next) break;
#pragma unroll
        for (int a = 0; a < 2; ++a)
#pragma unroll
            for (int b = 0; b < 2; ++b)
#pragma unroll
                for (int m = 0; m < 4; ++m)
#pragma unroll
                    for (int n = 0; n < 2; ++n) acc[a][b][m][n] = (f32x4){0.f, 0.f, 0.f, 0.f};
        cur = nxt; cA = nA; cB = nB; ++ui;
        if constexpr (GATHER) {
#pragma unroll
            for (int h = 0; h < 2; ++h) { vAc[h][0] = vAn[h][0]; vAc[h][1] = vAn[h][1]; }
        }
    }
    PG8_WAIT_V(0);
    if (wr == 0) PG8_BAR;
    PG8_BAR;
#undef PG8_SA
#undef PG8_SB
#undef PG8_STAGE2
#undef PG8_STAGE_A
#undef PG8_STAGE_B
#undef PG8_LDA
#undef PG8_LDB
#undef PG8_MMA
#undef PG8_WAIT_V
#undef PG8_WAIT_L
#undef PG8_BAR
#undef PG8_SCHED
}
}


#define XB_TMO      128
#define XB_XCNT(j)  (256  + 64 * (j))
#define XB_XSUB(j)  (1280 + 64 * (j))
#define XB_XGEN(j)  (2304 + 64 * (j))
#define XB_TOP      3328
#define XB_TOPGEN   3392
#define XCD_BAR_WORDS 3456
#define XB_SPIN_CAP (1u << 20)
constexpr int CW_BAR = 4096;
constexpr int LDS_MISC_OFF = 147456 - 64;
__device__ __forceinline__ unsigned xb_ld(unsigned* p)              { return __hip_atomic_load(p, __ATOMIC_RELAXED, __HIP_MEMORY_SCOPE_AGENT); }
__device__ __forceinline__ unsigned xb_add(unsigned* p, unsigned v) { return __hip_atomic_fetch_add(p, v, __ATOMIC_RELAXED, __HIP_MEMORY_SCOPE_AGENT); }
__device__ __forceinline__ unsigned xb_xcc_id() { return (unsigned)__builtin_amdgcn_s_getreg((3 << 11) | 20) & 0xFu; }
#define XB_SPIN(cond, bar) do { unsigned _sp = 0; while (cond) { __builtin_amdgcn_s_sleep(1); \
    if ((++_sp & 255u) == 0u) { if (xb_ld(&(bar)[XB_TMO])) break; if (_sp > XB_SPIN_CAP) { atomicAdd(&(bar)[XB_TMO], 1u); break; } } } } while (0)
struct XcdBarrier { unsigned* bar; unsigned x; volatile LAS unsigned* st; };
__device__ __forceinline__ XcdBarrier xcd_barrier_post(unsigned* bar, volatile LAS unsigned* st) {
    XcdBarrier b; b.bar = bar; b.x = xb_xcc_id(); b.st = st;
    if (threadIdx.x == 0) (void)xb_add(&bar[XB_XCNT(b.x)], 1u);
    return b;
}
__device__ __forceinline__ void xcd_barrier_complete(unsigned* bar, unsigned x, unsigned& nloc, unsigned& nx) {
    const unsigned G = gridDim.x * gridDim.y * gridDim.z;
    unsigned sum, cnt, mine, sp = 0u;
    for (;;) {
        sum = 0u; cnt = 0u; mine = 0u;
#pragma unroll
        for (unsigned j = 0; j < 16; ++j) { const unsigned c = xb_ld(&bar[XB_XCNT(j)]); sum += c; cnt += (c > 0u) ? 1u : 0u; mine = (j == x) ? c : mine; }
        if (sum == G) break;
        __builtin_amdgcn_s_sleep(1);
        if ((++sp & 255u) == 0u) { if (xb_ld(&bar[XB_TMO])) break; if (sp > XB_SPIN_CAP) { atomicAdd(&bar[XB_TMO], 1u); break; } }
    }
    nloc = mine > 0u ? mine : 1u; nx = cnt > 0u ? cnt : 1u;
}
__device__ __forceinline__ void xcd_barrier(const XcdBarrier& b) {
    asm volatile("s_waitcnt vmcnt(0)" ::: "memory");
    __syncthreads();
    if (threadIdx.x == 0) {
        unsigned* bar = b.bar;
        __builtin_amdgcn_s_waitcnt(0);
        unsigned nloc = b.st[0], nx = b.st[1];
        if (nloc == 0u) { xcd_barrier_complete(bar, b.x, nloc, nx); b.st[0] = nloc; b.st[1] = nx; }
        const unsigned old = xb_add(&bar[XB_XSUB(b.x)], 1u);
        const unsigned gen = old / nloc;
        if (old + 1u == (gen + 1u) * nloc) {
            __builtin_amdgcn_fence(__ATOMIC_RELEASE, "agent");
            asm volatile("s_waitcnt vmcnt(0)" ::: "memory");
            const unsigned og = xb_add(&bar[XB_TOP], 1u);
            const unsigned tg = og / nx;
            if (og + 1u == (tg + 1u) * nx) xb_add(&bar[XB_TOPGEN], 1u);
            else XB_SPIN(xb_ld(&bar[XB_TOPGEN]) == tg, bar);
            __builtin_amdgcn_fence(__ATOMIC_ACQUIRE, "agent");
            xb_add(&bar[XB_XGEN(b.x)], 1u);
            asm volatile("s_waitcnt vmcnt(0)" ::: "memory");
        } else {
            XB_SPIN(xb_ld(&bar[XB_XGEN(b.x)]) == gen, bar);
            __builtin_amdgcn_fence(__ATOMIC_ACQUIRE, "agent");
            asm volatile("s_waitcnt vmcnt(0)" ::: "memory");
        }
    }
    __syncthreads();
}

struct Params {
    const float* in[23];
    float* out; unsigned char* ws;
};
struct Frame {
    LAS unsigned char* lds; int tid, lane, wave, vcu, G;
    const Params* p; unsigned char* ws;
};
#define IN_X 0
#define IN_MEM 1
#define IN_NORM_MIX 2
#define IN_W_IN 3
#define IN_AQN 4
#define IN_AKN 5
#define IN_DECF 6
#define IN_DECB 7
#define IN_GNW 8
#define IN_W_OUT 9
#define IN_NORM_MEM 10
#define IN_NORM_MEMKV 11
#define IN_W_MQ 12
#define IN_W_MKV 13
#define IN_MQN 14
#define IN_MKN 15
#define IN_W_MO 16
#define IN_NORM_MOE 17
#define IN_W_GROUP 18
#define IN_W_ROUTER 19
#define IN_W1 20
#define IN_W3 21
#define IN_W2 22

template <class RowMap>
__device__ __forceinline__ void p0_transpose_item(const float* W, int K, int N, bf16_t* WT, const RowMap& rm, const float* kscale, LAS float* scr, int item, int lane) {
    const int nblk = N / 64, kb = item / nblk, nb = item % nblk, k0 = 64 * kb, n0 = 64 * nb;
    const int lr = lane >> 4, lc = (lane & 15) * 4;
    f32x4 v[16];
#pragma unroll
    for (int i = 0; i < 16; ++i) v[i] = __builtin_nontemporal_load((const f32x4*)(W + (size_t)(k0 + 4 * i + lr) * N + n0 + lc));
#pragma unroll
    for (int i = 0; i < 16; ++i) { const int kk = 4 * i + lr; f32x4 t = v[i]; if (kscale) t = t * kscale[k0 + kk];
        LAS float* d = scr + kk * 65 + lc; d[0] = t.x; d[1] = t.y; d[2] = t.z; d[3] = t.w; }
    LDS_WAIT(); asm volatile("" ::: "memory");
    const int c = lane & 7;
#pragma unroll
    for (int j = 0; j < 8; ++j) { const int n = (lane >> 3) + 8 * j; const LAS float* s = scr + (8 * c) * 65 + n;
        u32x4 o; o.x = cvt_pk_bf16(s[0 * 65], s[1 * 65]); o.y = cvt_pk_bf16(s[2 * 65], s[3 * 65]); o.z = cvt_pk_bf16(s[4 * 65], s[5 * 65]); o.w = cvt_pk_bf16(s[6 * 65], s[7 * 65]);
        *(u32x4*)(WT + (size_t)rm(n0 + n) * K + k0 + 8 * c) = o; }
    LDS_WAIT(); asm volatile("" ::: "memory");
}
template <class RowMap>
__device__ __forceinline__ void p0_transpose_item_fp8(const float* W, int K, int N, unsigned char* WT, const RowMap& rm, const float* kscale, float mul, LAS float* scr, int item, int lane) {
    const int nblk = N / 64, kb = item / nblk, nb = item % nblk, k0 = 64 * kb, n0 = 64 * nb;
    const int lr = lane >> 4, lc = (lane & 15) * 4;
    f32x4 v[16];
#pragma unroll
    for (int i = 0; i < 16; ++i) v[i] = __builtin_nontemporal_load((const f32x4*)(W + (size_t)(k0 + 4 * i + lr) * N + n0 + lc));
#pragma unroll
    for (int i = 0; i < 16; ++i) { const int kk = 4 * i + lr; const f32x4 t = v[i] * (kscale ? kscale[k0 + kk] * mul : mul);
        LAS float* d = scr + kk * 65 + lc; d[0] = t.x; d[1] = t.y; d[2] = t.z; d[3] = t.w; }
    LDS_WAIT(); asm volatile("" ::: "memory");
    const int c = lane & 7;
#pragma unroll
    for (int j = 0; j < 8; ++j) { const int n = (lane >> 3) + 8 * j; const LAS float* s = scr + (8 * c) * 65 + n;
        int w0 = 0, w1 = 0;
        w0 = __builtin_amdgcn_cvt_pk_fp8_f32(s[0 * 65], s[1 * 65], w0, false); w0 = __builtin_amdgcn_cvt_pk_fp8_f32(s[2 * 65], s[3 * 65], w0, true);
        w1 = __builtin_amdgcn_cvt_pk_fp8_f32(s[4 * 65], s[5 * 65], w1, false); w1 = __builtin_amdgcn_cvt_pk_fp8_f32(s[6 * 65], s[7 * 65], w1, true);
        __builtin_nontemporal_store((u32x2){(unsigned)w0, (unsigned)w1}, (u32x2*)(WT + (size_t)rm(n0 + n) * K + k0 + 8 * c)); }
    LDS_WAIT(); asm volatile("" ::: "memory");
}
struct RmId { __device__ __forceinline__ int operator()(int n) const { return n; } };
struct RmOff { int off; __device__ __forceinline__ int operator()(int n) const { return n + off; } };
struct RmIn { __device__ __forceinline__ int operator()(int n) const {
        if (n >= 1024) return n;
        const int seg = n >> 9, head = (n & 511) >> 6, dim = n & 63;
        return 256 * (seg * 2 + (head >> 2)) + 128 * (dim >> 5) + 32 * (head & 3) + (dim & 31); } };
struct RmGU { int up; __device__ __forceinline__ int operator()(int f) const { return 256 * (f >> 7) + 128 * up + (f & 127); } };

__device__ __forceinline__ void rms_row_to_bf16(const float* xrow, const float* w, bf16_t* orow, int lane, float* rstd_out = nullptr) {
    const f32x4* xr = (const f32x4*)xrow + lane; const f32x4* wr = (const f32x4*)w + lane;
    f32x4 v[4]; float s = 0.f;
#pragma unroll
    for (int j = 0; j < 4; ++j) { v[j] = xr[64 * j]; s += (v[j].x * v[j].x + v[j].y * v[j].y) + (v[j].z * v[j].z + v[j].w * v[j].w); }
    const float rstd = 1.0f / sqrtf(wave_sum(s) * (1.f / 1024.f) + 1e-6f);
    if (rstd_out && lane == 0) *rstd_out = rstd;
    u32x2* o8 = (u32x2*)orow + lane;
#pragma unroll
    for (int j = 0; j < 4; ++j) { const f32x4 ww = wr[64 * j]; u32x2 o; o.x = cvt_pk_bf16(v[j].x * rstd * ww.x, v[j].y * rstd * ww.y); o.y = cvt_pk_bf16(v[j].z * rstd * ww.z, v[j].w * rstd * ww.w); o8[64 * j] = o; }
}

template <int PART>
__device__ __forceinline__ void p0_prologue(Frame& F) {
    const Params& P = *F.p;
    LAS float* scr = (LAS float*)(F.lds + F.wave * 16640);
    const int gw = F.vcu * NWAVES + F.wave, NGW = F.G * NWAVES;
    constexpr int I_IN = 16 * 48, I_SQ = 16 * 16, I_MKV = 16 * 32, I_E1 = 16 * 8, I_E2 = 8 * 16;
    constexpr int NDENSE = I_IN, NITEMS = I_IN + 3 * I_SQ + I_MKV + NEXP * (2 * I_E1 + I_E2);
    unsigned char* ws = F.ws;
    for (int it = PART ? NDENSE + gw : (F.wave < 3 ? F.vcu * 3 + F.wave : NDENSE); it < (PART ? NITEMS : NDENSE); it += (PART ? NGW : NDENSE)) {
        int r = it;
        if (r < I_IN) { p0_transpose_item(P.in[IN_W_IN], 1024, 3072, (bf16_t*)(ws + WS_WIN), RmIn{}, nullptr, scr, r, F.lane); continue; } r -= I_IN;
        if (r < I_SQ) { p0_transpose_item(P.in[IN_W_OUT], 1024, 1024, (bf16_t*)(ws + WS_WOUT), RmId{}, nullptr, scr, r, F.lane); continue; } r -= I_SQ;
        if (r < I_SQ) { p0_transpose_item_fp8(P.in[IN_W_MQ], 1024, 1024, (unsigned char*)(ws + WS_WMQ), RmId{}, P.in[IN_NORM_MEM], 32.f, scr, r, F.lane); continue; } r -= I_SQ;
        if (r < I_SQ) { p0_transpose_item_fp8(P.in[IN_W_MO], 1024, 1024, (unsigned char*)(ws + WS_WMO), RmId{}, nullptr, 32.f, scr, r, F.lane); continue; } r -= I_SQ;
        if (r < I_MKV) { p0_transpose_item_fp8(P.in[IN_W_MKV], 1024, 2048, (unsigned char*)(ws + WS_WMKV), RmId{}, nullptr, 32.f, scr, r, F.lane); continue; } r -= I_MKV;
        const int e = r / (2 * I_E1 + I_E2); r -= e * (2 * I_E1 + I_E2);
        if (r < I_E1) { p0_transpose_item_fp8(P.in[IN_W1] + (size_t)e * 1024 * 512, 1024, 512, (unsigned char*)(ws + WS_W13) + (size_t)e * 1024 * 1024, RmGU{0}, P.in[IN_NORM_MOE], 32.f, scr, r, F.lane); continue; } r -= I_E1;
        if (r < I_E1) { p0_transpose_item_fp8(P.in[IN_W3] + (size_t)e * 1024 * 512, 1024, 512, (unsigned char*)(ws + WS_W13) + (size_t)e * 1024 * 1024, RmGU{1}, P.in[IN_NORM_MOE], 32.f, scr, r, F.lane); continue; } r -= I_E1;
        p0_transpose_item_fp8(P.in[IN_W2] + (size_t)e * 512 * 1024, 512, 1024, (unsigned char*)(ws + WS_W2) + (size_t)e * 1024 * 512, RmId{}, nullptr, 16.f, scr, r, F.lane);
    }
    if (PART) return;
    for (int i = blockIdx.x * NTHR + F.tid; i < (int)((WS_HSQ + (size_t)NT * 32 - WS_SUMSQ1) / 16); i += F.G * NTHR) ((u32x4*)(ws + WS_SUMSQ1))[i] = (u32x4){0u, 0u, 0u, 0u};
    for (int i = F.tid < 192 ? (int)blockIdx.x * 192 + F.tid : 48 * 1024; i < 48 * 1024; i += F.G * 192) { const int c = i >> 10, k = i & 1023; float v = 0.f;
        if (c < 4) v = P.in[IN_W_GROUP][(size_t)k * 4 + c]; else if (c < 36) v = P.in[IN_W_ROUTER][((size_t)((c - 4) >> 3) * 1024 + k) * 8 + ((c - 4) & 7)];
        v *= P.in[IN_NORM_MOE][k];
        const unsigned hi = cvt_pk_bf16(v, 0.f) & 0xffffu; const float rem = v - __uint_as_float(hi << 16);
        ((bf16_t*)(ws + WS_WRT))[i] = (bf16_t)hi; ((bf16_t*)(ws + WS_WRT))[48 * 1024 + i] = (bf16_t)(cvt_pk_bf16(rem, 0.f) & 0xffffu); }
    {   const f32x4* wr4 = (const f32x4*)P.in[IN_NORM_MIX] + F.lane; f32x4 ww[4];
#pragma unroll
        for (int j = 0; j < 4; ++j) ww[j] = wr4[64 * j];
        LAS unsigned* rq = (LAS unsigned*)(F.lds + LDS_MISC_OFF) + 4;
        for (;;) {
            unsigned bt = 0; if (F.lane == 0) bt = __hip_atomic_fetch_add(rq, 1u, __ATOMIC_RELAXED, __HIP_MEMORY_SCOPE_WORKGROUP);
            bt = (unsigned)__builtin_amdgcn_readfirstlane((int)bt); if (bt >= 32u) break;
            const int m0 = F.vcu * 128 + (int)bt * 4;
            f32x4 v[4][4];
#pragma unroll
            for (int r = 0; r < 4; ++r) { const f32x4* xr = (const f32x4*)(P.in[IN_X] + (size_t)(m0 + r) * DM) + F.lane;
#pragma unroll
                for (int j = 0; j < 4; ++j) v[r][j] = __builtin_nontemporal_load(&xr[64 * j]); }
#pragma unroll
            for (int r = 0; r < 4; ++r) { const int m = m0 + r; float s = 0.f;
#pragma unroll
                for (int j = 0; j < 4; ++j) s += (v[r][j].x * v[r][j].x + v[r][j].y * v[r][j].y) + (v[r][j].z * v[r][j].z + v[r][j].w * v[r][j].w);
                const float rstd = 1.0f / sqrtf(wave_sum(s) * (1.f / 1024.f) + 1e-6f);
                if (F.lane == 0) ((float*)(ws + WS_RSTD0))[m] = rstd;
                u32x2* o8 = (u32x2*)((bf16_t*)P.out + (size_t)m * DM) + F.lane;
#pragma unroll
                for (int j = 0; j < 4; ++j) { u32x2 o; o.x = cvt_pk_bf16(v[r][j].x * rstd * ww[j].x, v[r][j].y * rstd * ww[j].y); o.y = cvt_pk_bf16(v[r][j].z * rstd * ww[j].z, v[r][j].w * rstd * ww[j].w); o8[64 * j] = o; } }
        }
    }
    for (int m = gw; m < NB * NMEM; m += NGW) {
        const f32x4* xr = (const f32x4*)(P.in[IN_MEM] + (size_t)m * DM) + F.lane; const f32x4* wr = (const f32x4*)P.in[IN_NORM_MEMKV] + F.lane;
        f32x4 v[4]; float s = 0.f;
#pragma unroll
        for (int j = 0; j < 4; ++j) { v[j] = xr[64 * j]; s += (v[j].x * v[j].x + v[j].y * v[j].y) + (v[j].z * v[j].z + v[j].w * v[j].w); }
        const float rstd = 8.0f / sqrtf(wave_sum(s) * (1.f / 1024.f) + 1e-6f);
        unsigned* o4 = (unsigned*)(ws + WS_MEMH + (size_t)m * DM) + F.lane;
#pragma unroll
        for (int j = 0; j < 4; ++j) { const f32x4 ww = wr[64 * j]; int q = 0; q = __builtin_amdgcn_cvt_pk_fp8_f32(v[j].x * rstd * ww.x, v[j].y * rstd * ww.y, q, false); q = __builtin_amdgcn_cvt_pk_fp8_f32(v[j].z * rstd * ww.z, v[j].w * rstd * ww.w, q, true); o4[64 * j] = (unsigned)q; } }
}

struct EpiInProj {
    static constexpr bool PERM = true;
    unsigned char* ws; const float* qnw; const float* knw;
    __device__ __forceinline__ void operator()(const f32x4 (&acc)[2][2][4][2], const pg8::Unit& u, int wr, int wc, int fr, int fq) const {
        const int pn = u.pn; const int row0 = u.pm * 256 + wr * 64 + fr;
        if (pn < 4) {
            const float* nw = pn < 2 ? qnw : knw; const float sc = pn < 2 ? 0.125f * 1.44269504089f : 1.0f;
            bf16_t* dst = (bf16_t*)(ws + (pn < 2 ? WS_AQ : WS_AK)); const int head = 4 * (pn & 1) + wc;
            f32x4 w4[2][2];
#pragma unroll
            for (int bj = 0; bj < 2; ++bj)
#pragma unroll
                for (int n = 0; n < 2; ++n) w4[bj][n] = *(const f32x4*)(nw + 32 * bj + 8 * fq + 4 * n);
#pragma unroll
            for (int ai = 0; ai < 2; ++ai)
#pragma unroll
                for (int m = 0; m < 4; ++m) {
                    float ss = 0.f;
#pragma unroll
                    for (int bj = 0; bj < 2; ++bj)
#pragma unroll
                        for (int n = 0; n < 2; ++n) { const f32x4 v = acc[ai][bj][m][n]; ss += (v.x * v.x + v.y * v.y) + (v.z * v.z + v.w * v.w); }
                    ss = sum_g4(ss);
                    const float rs = sc / sqrtf(ss * (1.f / 64.f) + 1e-6f);
                    bf16_t* rowp = dst + (size_t)(row0 + ai * 128 + m * 16) * 512 + head * 64 + 8 * fq;
#pragma unroll
                    for (int bj = 0; bj < 2; ++bj) { const f32x4 v0 = acc[ai][bj][m][0] * rs * w4[bj][0], v1 = acc[ai][bj][m][1] * rs * w4[bj][1];
                        u32x4 w; w.x = cvt_pk_bf16(v0.x, v0.y); w.y = cvt_pk_bf16(v0.z, v0.w); w.z = cvt_pk_bf16(v1.x, v1.y); w.w = cvt_pk_bf16(v1.z, v1.w);
                        *(u32x4*)(rowp + 32 * bj) = w; }
                }
        } else {
            bf16_t* dst; int ld, c0; float sc = 1.f; bool act = false;
            if (pn < 6) { dst = (bf16_t*)(ws + WS_AV); ld = 512; c0 = (pn - 4) * 256; }
            else if (pn == 6) { dst = (bf16_t*)(ws + WS_RQ); ld = 256; c0 = 0; }
            else if (pn == 7) { dst = (bf16_t*)(ws + WS_RK); ld = 256; c0 = 0; sc = 0.125f; }
            else if (pn < 10) { dst = (bf16_t*)(ws + WS_RV); ld = 512; c0 = (pn - 8) * 256; }
            else { dst = (bf16_t*)(ws + WS_RG); ld = 512; c0 = (pn - 10) * 256; act = true; }
#pragma unroll
            for (int ai = 0; ai < 2; ++ai)
#pragma unroll
                for (int m = 0; m < 4; ++m) {
                    bf16_t* rowp = dst + (size_t)(row0 + ai * 128 + m * 16) * ld + c0 + wc * 32 + 8 * fq;
#pragma unroll
                    for (int bj = 0; bj < 2; ++bj) { f32x4 v0 = acc[ai][bj][m][0] * sc, v1 = acc[ai][bj][m][1] * sc;
                        if (act) { v0.x = silu_f(v0.x); v0.y = silu_f(v0.y); v0.z = silu_f(v0.z); v0.w = silu_f(v0.w); v1.x = silu_f(v1.x); v1.y = silu_f(v1.y); v1.z = silu_f(v1.z); v1.w = silu_f(v1.w); }
                        u32x4 w; w.x = cvt_pk_bf16(v0.x, v0.y); w.y = cvt_pk_bf16(v0.z, v0.w); w.z = cvt_pk_bf16(v1.x, v1.y); w.w = cvt_pk_bf16(v1.z, v1.w);
                        *(u32x4*)(rowp + 128 * bj) = w; }
                }
        }
    }
};


__device__ __forceinline__ void tr_read8(unsigned addr, bf16x4 (&r)[8]) {
    asm volatile("ds_read_b64_tr_b16 %0, %8\n\tds_read_b64_tr_b16 %1, %8 offset:32\n\tds_read_b64_tr_b16 %2, %8 offset:64\n\tds_read_b64_tr_b16 %3, %8 offset:96\n\t"
                 "ds_read_b64_tr_b16 %4, %8 offset:2048\n\tds_read_b64_tr_b16 %5, %8 offset:2080\n\tds_read_b64_tr_b16 %6, %8 offset:2112\n\tds_read_b64_tr_b16 %7, %8 offset:2144\n\t"
                 "s_waitcnt lgkmcnt(0)"
                 : "=&v"(r[0]), "=&v"(r[1]), "=&v"(r[2]), "=&v"(r[3]), "=&v"(r[4]), "=&v"(r[5]), "=&v"(r[6]), "=&v"(r[7]) : "v"(addr) : "memory");
}
__device__ __forceinline__ void tr_read8_issue(unsigned addr, bf16x4 (&r)[8]) {
    asm volatile("ds_read_b64_tr_b16 %0, %8\n\tds_read_b64_tr_b16 %1, %8 offset:32\n\tds_read_b64_tr_b16 %2, %8 offset:64\n\tds_read_b64_tr_b16 %3, %8 offset:96\n\t"
                 "ds_read_b64_tr_b16 %4, %8 offset:2048\n\tds_read_b64_tr_b16 %5, %8 offset:2080\n\tds_read_b64_tr_b16 %6, %8 offset:2112\n\tds_read_b64_tr_b16 %7, %8 offset:2144"
                 : "=&v"(r[0]), "=&v"(r[1]), "=&v"(r[2]), "=&v"(r[3]), "=&v"(r[4]), "=&v"(r[5]), "=&v"(r[6]), "=&v"(r[7]) : "v"(addr) : "memory");
}
__device__ __forceinline__ void tr_read8_wait(bf16x4 (&r)[8]) {
    asm volatile("s_waitcnt lgkmcnt(0)" : "+v"(r[0]), "+v"(r[1]), "+v"(r[2]), "+v"(r[3]), "+v"(r[4]), "+v"(r[5]), "+v"(r[6]), "+v"(r[7]) :: "memory");
}
__device__ __forceinline__ bf16x8 cat4(bf16x4 a, bf16x4 b) { return __builtin_shufflevector(a, b, 0, 1, 2, 3, 4, 5, 6, 7); }
constexpr int ACC_LD = 136;
constexpr int ATT_TOK = 512;
constexpr int ATT_ACC_BYTES = ATT_TOK * ACC_LD;
constexpr int ATT_VBUF_OFF = ATT_ACC_BYTES;

struct AttRing { bf16x8 kf[2][2][2]; u32x4 vst[2][4]; bf16x8 qn[2][2]; };
struct AttItem { const bf16_t* Qb; int d, r, jq0, L; };
constexpr size_t ATT_K_OFF = (WS_AK - WS_AQ) / 2, ATT_V_OFF = (WS_AV - WS_AQ) / 2;
template <int B>
__device__ __forceinline__ void att_ring_load(AttRing& R, const AttItem& it, int P, int lane) {
    asm volatile("" : "+v"(lane));
    const int g = lane >> 4, li = lane & 15, sc = lane & 7, sr = lane >> 3;
    const bf16_t* Kb = it.Qb + ATT_K_OFF; const bf16_t* Vb = it.Qb + ATT_V_OFF; const int jb = it.jq0 - 64 + 32 * P;
#pragma unroll
    for (int t = 0; t < 2; ++t) { int jk = jb + 16 * t + li; jk = jk < 0 ? 0 : (jk >= it.L ? it.L - 1 : jk); const bf16_t* kp = Kb + (size_t)(it.r + it.d * jk) * 512 + 8 * g;
        R.kf[B][t][0] = *(const bf16x8*)kp; R.kf[B][t][1] = *(const bf16x8*)(kp + 32); }
#pragma unroll
    for (int i = 0; i < 4; ++i) { int jk = jb + sr + 8 * i; jk = jk < 0 ? 0 : (jk >= it.L ? it.L - 1 : jk); R.vst[B][i] = *(const u32x4*)(Vb + (size_t)(it.r + it.d * jk) * 512 + 8 * sc); }
}
template <int NQ>
__device__ __forceinline__ void att_q_load(AttRing& R, const AttItem& it, int lane) {
    asm volatile("" : "+v"(lane));
    const int g = lane >> 4, li = lane & 15;
#pragma unroll
    for (int q = 0; q < NQ; ++q)
#pragma unroll
        for (int ks = 0; ks < 2; ++ks) R.qn[q][ks] = *(const bf16x8*)(it.Qb + (size_t)(it.r + it.d * (it.jq0 + 16 * q + li)) * 512 + 32 * ks + 8 * g);
}
template <int NQ, bool EDGE, int mode, int PAR, int NQN>
__device__ __forceinline__ void attn_item_r(AttRing& R, const AttItem& it, const AttItem& nx, float slope2  , unsigned m2w  ,
                                            LAS float* ACC, int T0, LAS unsigned char* vbuf  , bf16_t* mixrow0  , int lane) {
    asm volatile("" : "+v"(lane));
    const int g = lane >> 4, li = lane & 15;
    const int jq0 = it.jq0, L = it.L;
    const unsigned s2b = cvt_pk_bf16(slope2, 0.f) & 0xffffu;
    const float s2r = __builtin_bit_cast(float, s2b << 16);
    const unsigned gm = g == 0 ? 0xffffffffu : 0u;
    int tq[NQ]; bf16x8 qf[NQ][2], qa[NQ]; f32x4 o[NQ][4], ol[NQ];
#pragma unroll
    for (int q = 0; q < NQ; ++q) { tq[q] = it.r + it.d * (jq0 + 16 * q + li); qf[q][0] = R.qn[q][0]; qf[q][1] = R.qn[q][1];
        u32x4 a; a.x = ((__builtin_bit_cast(unsigned, (float)(16 * q + li)) >> 16) | (s2b << 16)) & gm; a.y = 0x3F80u & gm; a.z = 0u; a.w = 0u; qa[q] = __builtin_bit_cast(bf16x8, a);
#pragma unroll
        for (int dt = 0; dt < 4; ++dt) o[q][dt] = (f32x4){0.f, 0.f, 0.f, 0.f};
        ol[q] = (f32x4){0.f, 0.f, 0.f, 0.f}; }
    float kbase = (float)(li - 64), delta0 = (float)(4 * g - li); asm volatile("" : "+v"(kbase), "+v"(delta0));
    const unsigned kw0 = (s2b | 0x8000u) & gm, kmask = 0xffff0000u & gm, kflip = 0x80008000u & gm, kw1 = m2w & gm;
    u32x4 onesw; onesw.x = 0x3F803F80u; onesw.y = 0x3F803F80u; onesw.z = 0x3F803F80u; onesw.w = 0x3F803F80u; const bf16x8 ones = __builtin_bit_cast(bf16x8, onesw);
    const unsigned vaddr = (unsigned)(size_t)vbuf + (unsigned)((4 * g + (li >> 2)) * 128 + (li & 3) * 8);
    const int sc = lane & 7, sr = lane >> 3;
#pragma unroll
    for (int P = 0; P < 5; ++P) {
        const int B = (P + PAR) & 1; const int jb = jq0 - 64 + 32 * P;
        if (P < 4) { if (B) att_ring_load<0>(R, it, P + 1, lane); else att_ring_load<1>(R, it, P + 1, lane); }
        else if (NQN) { if (B) att_ring_load<0>(R, nx, 0, lane); else att_ring_load<1>(R, nx, 0, lane); att_q_load<NQN ? NQN : 1>(R, nx, lane); }
        bf16x4 vr[8]; tr_read8_issue(vaddr + B * 4096, vr);
        bf16x8 pb[NQ];
#pragma unroll
        for (int q = 0; q < NQ; ++q) {
            float p[8];
#pragma unroll
            for (int t = 0; t < 2; ++t) {
                const int c = 2 * P + t - q;
                if (c < 0 || c > 8) {
#pragma unroll
                    for (int e = 0; e < 4; ++e) p[t * 4 + e] = 0.f;
                } else {
                    u32x4 kw; kw.x = (__builtin_bit_cast(unsigned, kbase + (float)(32 * P + 16 * t)) & kmask) | kw0; if (c >= 5) kw.x ^= kflip;
                    kw.y = kw1; kw.z = 0u; kw.w = 0u;
                    __builtin_amdgcn_s_setprio(1);
                    f32x4 st = __builtin_amdgcn_mfma_f32_16x16x32_bf16(R.kf[B][t][0], qf[q][0], (f32x4){0.f, 0.f, 0.f, 0.f}, 0, 0, 0);
                    st = __builtin_amdgcn_mfma_f32_16x16x32_bf16(R.kf[B][t][1], qf[q][1], st, 0, 0, 0);
                    st = __builtin_amdgcn_mfma_f32_16x16x32_bf16(__builtin_bit_cast(bf16x8, kw), qa[q], st, 0, 0, 0);
                    __builtin_amdgcn_s_setprio(0);
#pragma unroll
                    for (int e = 0; e < 4; ++e) { float x = st[e];
                        if (c == 4) x = __builtin_fmaf(__builtin_fmaxf(delta0 + (float)e, 0.f), -2.f * s2r, x);
                        float v = __builtin_amdgcn_exp2f(x);
                        if (c == 0) v = (delta0 + (float)e < 0.f) ? 0.f : v;
                        if (c == 8) v = (delta0 + (float)e > 0.f) ? 0.f : v;
                        if (EDGE) { const int jk = jb + 16 * t + 4 * g + e; v = ((unsigned)jk < (unsigned)L) ? v : 0.f; }
                        p[t * 4 + e] = v; }
                }
            }
            u32x4 pw; pw.x = cvt_pk_bf16(p[0], p[1]); pw.y = cvt_pk_bf16(p[2], p[3]); pw.z = cvt_pk_bf16(p[4], p[5]); pw.w = cvt_pk_bf16(p[6], p[7]);
            pb[q] = __builtin_bit_cast(bf16x8, pw);
        }
        tr_read8_wait(vr);
        __builtin_amdgcn_sched_barrier(0);
__builtin_amdgcn_s_setprio(1);
#pragma unroll
        for (int dt = 0; dt < 4; ++dt) { const bf16x8 vf = cat4(vr[dt], vr[4 + dt]);
#pragma unroll
            for (int q = 0; q < NQ; ++q) o[q][dt] = __builtin_amdgcn_mfma_f32_16x16x32_bf16(vf, pb[q], o[q][dt], 0, 0, 0); }
#pragma unroll
        for (int q = 0; q < NQ; ++q) ol[q] = __builtin_amdgcn_mfma_f32_16x16x32_bf16(ones, pb[q], ol[q], 0, 0, 0);
        __builtin_amdgcn_s_setprio(0);
        if (P < 4 || NQN) {
#pragma unroll
            for (int i = 0; i < 4; ++i) *(LAS u32x4*)(vbuf + (B ^ 1) * 4096 + (sr + 8 * i) * 128 + sc * 16) = R.vst[B ^ 1][i]; }
    }
#pragma unroll
    for (int q = 0; q < NQ; ++q) {
        const float ls = ol[q][0];
        LAS unsigned char* arow = (LAS unsigned char*)ACC + (tq[q] - T0) * ACC_LD;
        if (mode == 0) {
#pragma unroll
            for (int dt = 0; dt < 4; ++dt) { u32x2 w; w.x = cvt_pk_bf16_c(o[q][dt].x, o[q][dt].y); w.y = cvt_pk_bf16_c(o[q][dt].z, o[q][dt].w); *(LAS u32x2*)(arow + 32 * dt + 8 * g) = w; }
            if (g == 0) *(LAS float*)(arow + 128) = ls;
        } else if (mode == 1) {
#pragma unroll
            for (int dt = 0; dt < 4; ++dt) { const u32x2 a = *(LAS u32x2*)(arow + 32 * dt + 8 * g);
                u32x2 w; w.x = cvt_pk_bf16_c(bflo(a.x) + o[q][dt].x, bfhi(a.x) + o[q][dt].y); w.y = cvt_pk_bf16_c(bflo(a.y) + o[q][dt].z, bfhi(a.y) + o[q][dt].w); *(LAS u32x2*)(arow + 32 * dt + 8 * g) = w; }
            if (g == 0) *(LAS float*)(arow + 128) += ls;
        } else {
            const float inv = 1.0f / (*(LAS float*)(arow + 128) + ls);
            bf16_t* orow = mixrow0 + (size_t)tq[q] * 1024;
#pragma unroll
            for (int dt = 0; dt < 4; ++dt) { const u32x2 a = *(LAS u32x2*)(arow + 32 * dt + 8 * g);
                u32x2 w; w.x = cvt_pk_bf16_c((bflo(a.x) + o[q][dt].x) * inv, (bfhi(a.x) + o[q][dt].y) * inv); w.y = cvt_pk_bf16_c((bflo(a.y) + o[q][dt].z) * inv, (bfhi(a.y) + o[q][dt].w) * inv);
                *(u32x2*)(orow + 16 * dt + 4 * g) = w; }
        }
    }
}
template <int NQ, int mode, int PAR, int NQN>
__device__ __forceinline__ void attn_item_d(AttRing& R, const AttItem& it, const AttItem& nx, float slope2, unsigned M2, LAS float* ACC, int T0, LAS unsigned char* vbuf, bf16_t* mixrow0, int lane) {
    if (it.jq0 - 64 < 0 || it.jq0 + 96 > it.L) attn_item_r<NQ, true, mode, PAR, NQN>(R, it, nx, slope2, M2, ACC, T0, vbuf, mixrow0, lane);
    else attn_item_r<NQ, false, mode, PAR, NQN>(R, it, nx, slope2, M2, ACC, T0, vbuf, mixrow0, lane);
}

template <int VAR>
__device__ __forceinline__ void p2_attention(Frame& F, bf16_t* mixbase) {
    const Params& P = *F.p; const int lane = F.lane, w = F.wave;
    LAS float* ACC = (LAS float*)F.lds; LAS unsigned char* vbuf = F.lds + ATT_VBUF_OFF + w * 8192;
    float mq = fabsf(P.in[IN_AQN][lane]), mk = fabsf(P.in[IN_AKN][lane]);
    mq = wave_max(mq); mk = wave_max(mk);
    const unsigned M2 = cvt_pk_bf16(-8.0f * mq * mk * 1.44269504089f, 0.f) & 0xffffu;
    AttRing R;
#define ATT_QB(U_) ((const bf16_t*)(F.ws + WS_AQ) + (size_t)((U_) >> 8) * SEQ * 512 + (((U_) >> 5) & 7) * 64)
#define ATT_L(n_) (VAR == 1 ? 32 : (n_))
    int U = F.vcu;
    if (U < 512) { const AttItem a0{ATT_QB(U), 16, 2 * w, ((U & 31) * ATT_TOK) / 16, ATT_L(SEQ / 16)}; att_ring_load<0>(R, a0, 0, lane); att_q_load<2>(R, a0, lane);
        const int sc = lane & 7, sr = lane >> 3;
#pragma unroll
        for (int i = 0; i < 4; ++i) *(LAS u32x4*)(vbuf + (sr + 8 * i) * 128 + sc * 16) = R.vst[0][i]; }
    for (; U < 512; U += F.G) {
        const int bh = U >> 5, blk = U & 31, b = bh >> 3, h = bh & 7, T0 = blk * ATT_TOK;
        const bf16_t* Qb = ATT_QB(U);
        bf16_t* mix = mixbase + (size_t)b * SEQ * 1024 + h * 64;
        const float slope = __builtin_amdgcn_exp2f(-(float)(h + 1)) * 1.44269504089f;
        const AttItem iA{Qb, 16, 2 * w, T0 / 16, ATT_L(SEQ / 16)}, iB{Qb, 16, 2 * w + 1, T0 / 16, ATT_L(SEQ / 16)};
        const AttItem iC{Qb, 4, w >> 1, T0 / 4 + 64 * (w & 1), ATT_L(SEQ / 4)}, iD{Qb, 4, w >> 1, T0 / 4 + 64 * (w & 1) + 32, ATT_L(SEQ / 4)};
        const AttItem iE{Qb, 1, 0, T0 + 64 * w, ATT_L(SEQ)}, iF{Qb, 1, 0, T0 + 64 * w + 32, ATT_L(SEQ)};
        const int Un = (U + F.G < 512) ? U + F.G : U;
        const AttItem nA{ATT_QB(Un), 16, 2 * w, ((Un & 31) * ATT_TOK) / 16, ATT_L(SEQ / 16)};
        attn_item_d<2, 0, 0, 2>(R, iA, iB, slope * 16.f, M2, ACC, T0, vbuf, mix, lane);
        attn_item_d<2, 0, 1, 2>(R, iB, iC, slope * 16.f, M2, ACC, T0, vbuf, mix, lane);
        __syncthreads();
        attn_item_d<2, 1, 0, 2>(R, iC, iD, slope * 4.f, M2, ACC, T0, vbuf, mix, lane);
        attn_item_d<2, 1, 1, 2>(R, iD, iE, slope * 4.f, M2, ACC, T0, vbuf, mix, lane);
        __syncthreads();
        attn_item_d<2, 2, 0, 2>(R, iE, iF, slope, M2, ACC, T0, vbuf, mix, lane);
        attn_item_d<2, 2, 1, 2>(R, iF, nA, slope, M2, ACC, T0, vbuf, mix, lane);
        __syncthreads();
    }
#undef ATT_QB
#undef ATT_L
}

template <int ROWB>
__device__ __forceinline__ bf16x8 tr_read2(unsigned addr) {
    bf16x4 a, b;
    asm volatile("ds_read_b64_tr_b16 %0, %2\n\tds_read_b64_tr_b16 %1, %2 offset:%3\n\ts_waitcnt lgkmcnt(0)" : "=&v"(a), "=&v"(b) : "v"(addr), "i"(16 * ROWB) : "memory");
    return cat4(a, b);
}
template <int ROWB, int STEP>
__device__ __forceinline__ void tr_read2x8(unsigned addr, bf16x8 (&f)[8]) {
    bf16x4 a[8], b[8];
    asm volatile("ds_read_b64_tr_b16 %0, %16\n\tds_read_b64_tr_b16 %8, %16 offset:%17\n\t"
                 "ds_read_b64_tr_b16 %1, %16 offset:%18\n\tds_read_b64_tr_b16 %9, %16 offset:%19\n\t"
                 "ds_read_b64_tr_b16 %2, %16 offset:%20\n\tds_read_b64_tr_b16 %10, %16 offset:%21\n\t"
                 "ds_read_b64_tr_b16 %3, %16 offset:%22\n\tds_read_b64_tr_b16 %11, %16 offset:%23\n\t"
                 "ds_read_b64_tr_b16 %4, %16 offset:%24\n\tds_read_b64_tr_b16 %12, %16 offset:%25\n\t"
                 "ds_read_b64_tr_b16 %5, %16 offset:%26\n\tds_read_b64_tr_b16 %13, %16 offset:%27\n\t"
                 "ds_read_b64_tr_b16 %6, %16 offset:%28\n\tds_read_b64_tr_b16 %14, %16 offset:%29\n\t"
                 "ds_read_b64_tr_b16 %7, %16 offset:%30\n\tds_read_b64_tr_b16 %15, %16 offset:%31\n\t"
                 "s_waitcnt lgkmcnt(0)"
                 : "=&v"(a[0]), "=&v"(a[1]), "=&v"(a[2]), "=&v"(a[3]), "=&v"(a[4]), "=&v"(a[5]), "=&v"(a[6]), "=&v"(a[7]),
                   "=&v"(b[0]), "=&v"(b[1]), "=&v"(b[2]), "=&v"(b[3]), "=&v"(b[4]), "=&v"(b[5]), "=&v"(b[6]), "=&v"(b[7])
                 : "v"(addr), "i"(16 * ROWB), "i"(1 * STEP), "i"(1 * STEP + 16 * ROWB), "i"(2 * STEP), "i"(2 * STEP + 16 * ROWB), "i"(3 * STEP), "i"(3 * STEP + 16 * ROWB),
                   "i"(4 * STEP), "i"(4 * STEP + 16 * ROWB), "i"(5 * STEP), "i"(5 * STEP + 16 * ROWB), "i"(6 * STEP), "i"(6 * STEP + 16 * ROWB), "i"(7 * STEP), "i"(7 * STEP + 16 * ROWB)
                 : "memory");
#pragma unroll
    for (int i = 0; i < 8; ++i) f[i] = cat4(a[i], b[i]);
}
template <int ROWB, int STEP>
__device__ __forceinline__ void tr_read2x4(unsigned addr, bf16x8 (&f)[4]) {
    bf16x4 a[4], b[4];
    asm volatile("ds_read_b64_tr_b16 %0, %8\n\tds_read_b64_tr_b16 %4, %8 offset:%9\n\t"
                 "ds_read_b64_tr_b16 %1, %8 offset:%10\n\tds_read_b64_tr_b16 %5, %8 offset:%11\n\t"
                 "ds_read_b64_tr_b16 %2, %8 offset:%12\n\tds_read_b64_tr_b16 %6, %8 offset:%13\n\t"
                 "ds_read_b64_tr_b16 %3, %8 offset:%14\n\tds_read_b64_tr_b16 %7, %8 offset:%15\n\t"
                 "s_waitcnt lgkmcnt(0)"
                 : "=&v"(a[0]), "=&v"(a[1]), "=&v"(a[2]), "=&v"(a[3]), "=&v"(b[0]), "=&v"(b[1]), "=&v"(b[2]), "=&v"(b[3])
                 : "v"(addr), "i"(16 * ROWB), "i"(1 * STEP), "i"(1 * STEP + 16 * ROWB), "i"(2 * STEP), "i"(2 * STEP + 16 * ROWB), "i"(3 * STEP), "i"(3 * STEP + 16 * ROWB)
                 : "memory");
#pragma unroll
    for (int i = 0; i < 4; ++i) f[i] = cat4(a[i], b[i]);
}
__device__ __forceinline__ float log2_sigmoid(float x) { return -log2f(1.0f + expf(-x)); }

__device__ __forceinline__ void p2_chunk_kv(Frame& F) {
    const Params& P = *F.p; const int lane = F.lane, w = F.wave, tid = F.tid, g = lane >> 4, li = lane & 15;
    LAS unsigned char* Vl = F.lds;
    LAS unsigned char* Kf = F.lds + 32768;
    LAS unsigned char* Kbk = F.lds + 32768 + 16384;
    u32x4 rv[4], rk[2];
#define P2B_LOAD(U) do { const int bh_ = (U) >> 7, n_ = (U) & 127, b_ = bh_ >> 2, h_ = bh_ & 3; const size_t row0_ = (size_t)b_ * SEQ + (size_t)n_ * 128; \
        const bf16_t* Vg_ = (const bf16_t*)(F.ws + WS_RV) + row0_ * 512 + h_ * 128; const bf16_t* Kg_ = (const bf16_t*)(F.ws + WS_RK) + row0_ * 256 + h_ * 64; \
        _Pragma("unroll") for (int i = 0; i < 4; ++i) { const int c = tid + 512 * i; rv[i] = *(const u32x4*)(Vg_ + (size_t)(c >> 4) * 512 + (c & 15) * 8); } \
        _Pragma("unroll") for (int i = 0; i < 2; ++i) { const int c = tid + 512 * i; rk[i] = *(const u32x4*)(Kg_ + (size_t)(c >> 3) * 256 + (c & 7) * 8); } } while (0)
    int U = F.vcu;
    if (U < 1024) P2B_LOAD(U);
    for (; U < 1024; U += F.G) {
        const int bh = U >> 7, h = bh & 3;
        const float l2f = log2_sigmoid(P.in[IN_DECF][h]), l2b = log2_sigmoid(P.in[IN_DECB][h]);
#pragma unroll
        for (int i = 0; i < 4; ++i) { const int c = tid + 512 * i, j = c >> 4, cc = c & 15; *(LAS u32x4*)(Vl + j * 256 + cc * 16) = rv[i]; }
#pragma unroll
        for (int i = 0; i < 2; ++i) { const int c = tid + 512 * i, j = c >> 3, cc = c & 7; const u32x4 kv = rk[i];
            const float wf = __builtin_amdgcn_exp2f(l2f * (float)(127 - j)), wb = __builtin_amdgcn_exp2f(l2b * (float)j);
            u32x4 a, bq;
            a.x = cvt_pk_bf16(bflo(kv.x) * wf, bfhi(kv.x) * wf); a.y = cvt_pk_bf16(bflo(kv.y) * wf, bfhi(kv.y) * wf); a.z = cvt_pk_bf16(bflo(kv.z) * wf, bfhi(kv.z) * wf); a.w = cvt_pk_bf16(bflo(kv.w) * wf, bfhi(kv.w) * wf);
            bq.x = cvt_pk_bf16(bflo(kv.x) * wb, bfhi(kv.x) * wb); bq.y = cvt_pk_bf16(bflo(kv.y) * wb, bfhi(kv.y) * wb); bq.z = cvt_pk_bf16(bflo(kv.z) * wb, bfhi(kv.z) * wb); bq.w = cvt_pk_bf16(bflo(kv.w) * wb, bfhi(kv.w) * wb);
            *(LAS u32x4*)(Kf + j * 128 + cc * 16) = a; *(LAS u32x4*)(Kbk + j * 128 + cc * 16) = bq; }
        __syncthreads();
        const int Un = U + F.G;
        if (Un < 1024) P2B_LOAD(Un);
        f32x4 acc[2][4];
#pragma unroll
        for (int dir = 0; dir < 2; ++dir)
#pragma unroll
            for (int dt = 0; dt < 4; ++dt) acc[dir][dt] = (f32x4){0.f, 0.f, 0.f, 0.f};
        const unsigned va = (unsigned)(size_t)Vl + (unsigned)((4 * g + (li >> 2)) * 256 + (16 * w + 4 * (li & 3)) * 2);
        const unsigned kaf = (unsigned)(size_t)Kf + (unsigned)((4 * g + (li >> 2)) * 128 + (4 * (li & 3)) * 2);
        const unsigned kab = (unsigned)(size_t)Kbk + (unsigned)((4 * g + (li >> 2)) * 128 + (4 * (li & 3)) * 2);
#pragma unroll
        for (int ks = 0; ks < 4; ++ks) {
            const bf16x8 af = tr_read2<256>(va + ks * 32 * 256);
            bf16x8 b0[4], b1[4]; tr_read2x4<128, 32>(kaf + ks * 32 * 128, b0); tr_read2x4<128, 32>(kab + ks * 32 * 128, b1);
#pragma unroll
            for (int dt = 0; dt < 4; ++dt) {
                acc[0][dt] = __builtin_amdgcn_mfma_f32_16x16x32_bf16(af, b0[dt], acc[0][dt], 0, 0, 0);
                acc[1][dt] = __builtin_amdgcn_mfma_f32_16x16x32_bf16(af, b1[dt], acc[1][dt], 0, 0, 0);
            }
        }
        LAS unsigned char* tp_ = F.lds + 65536 + w * 8704;
#pragma unroll
        for (int dir = 0; dir < 2; ++dir)
#pragma unroll
            for (int dt = 0; dt < 4; ++dt)
#pragma unroll
                for (int e = 0; e < 4; ++e) *(LAS float*)(tp_ + dir * 4352 + (4 * g + e) * 272 + (16 * dt + li) * 4) = acc[dir][dt][e];
        LDS_WAIT();
#pragma unroll
        for (int dir = 0; dir < 2; ++dir) { bf16_t* dst = (bf16_t*)(F.ws + WS_KV) + ((size_t)dir * 1024 + U) * 8192 + (size_t)(16 * w) * 64;
#pragma unroll
            for (int i = 0; i < 2; ++i) { const int q = lane + 64 * i; LAS const unsigned char* sp_ = tp_ + dir * 4352 + (q >> 3) * 272 + (q & 7) * 32;
                const f32x4 a = *(const LAS f32x4*)sp_, b = *(const LAS f32x4*)(sp_ + 16);
                u32x4 o; o.x = cvt_pk_bf16(a.x, a.y); o.y = cvt_pk_bf16(a.z, a.w); o.z = cvt_pk_bf16(b.x, b.y); o.w = cvt_pk_bf16(b.z, b.w);
                *(u32x4*)(dst + q * 8) = o; } }
        __syncthreads();
    }
#undef P2B_LOAD
}

__device__ __forceinline__ void p3_scan(Frame& F) {
    const Params& P = *F.p;
    for (int gt = F.tid < 256 ? (int)blockIdx.x * 256 + F.tid : 2 * 8 * 4096; gt < 2 * 8 * 4096; gt += F.G * 256) {
        const int dir = gt >> 15, bh = (gt >> 12) & 7, el = (gt & 4095) * 2, h = bh & 3;
        const float dec = __builtin_amdgcn_exp2f(128.f * log2_sigmoid(P.in[dir ? IN_DECB : IN_DECF][h]));
        const unsigned* kv = (const unsigned*)((const bf16_t*)(F.ws + WS_KV) + ((size_t)dir * 1024 + bh * 128) * 8192 + el);
        unsigned* st = (unsigned*)((bf16_t*)(F.ws + WS_ST) + ((size_t)dir * 1024 + bh * 128) * 8192 + el);
        float s0 = 0.f, s1 = 0.f;
        for (int c0 = 0; c0 < 128; c0 += 32) {
            unsigned v[32];
#pragma unroll
            for (int i = 0; i < 32; ++i) { const int n = dir ? 127 - (c0 + i) : c0 + i; v[i] = kv[(size_t)n * 4096]; }
#pragma unroll
            for (int i = 0; i < 32; ++i) { const int n = dir ? 127 - (c0 + i) : c0 + i; st[(size_t)n * 4096] = cvt_pk_bf16(s0, s1); s0 = s0 * dec + bflo(v[i]); s1 = s1 * dec + bfhi(v[i]); }
        }
    }
}

constexpr int P4_V = 0, P4_K = 32768, P4_SF = 49152, P4_SB = 65536;
__device__ __forceinline__ void p4_retention_out(Frame& F) {
    const Params& P = *F.p; const int lane = F.lane, w = F.wave, tid = F.tid, g = lane >> 4, li = lane & 15;
    LAS unsigned char* L = F.lds;
    u32x4 rv[4], rk[2], rf[2], rb[2]; bf16x8 qn[2];
    const int iq = 16 * w + li;
#define P4_LOAD(U) do { const int bh_ = (U) >> 7, n_ = (U) & 127, b_ = bh_ >> 2, h_ = bh_ & 3; const size_t row0_ = (size_t)b_ * SEQ + (size_t)n_ * 128; \
        const bf16_t* Vg_ = (const bf16_t*)(F.ws + WS_RV) + row0_ * 512 + h_ * 128; const bf16_t* Kg_ = (const bf16_t*)(F.ws + WS_RK) + row0_ * 256 + h_ * 64; \
        const bf16_t* Qg_ = (const bf16_t*)(F.ws + WS_RQ) + row0_ * 256 + h_ * 64; \
        const bf16_t* Sf_ = (const bf16_t*)(F.ws + WS_ST) + (size_t)(U) * 8192; const bf16_t* Sb_ = Sf_ + (size_t)1024 * 8192; \
        _Pragma("unroll") for (int i = 0; i < 4; ++i) { const int c = tid + 512 * i; rv[i] = *(const u32x4*)(Vg_ + (size_t)(c >> 4) * 512 + (c & 15) * 8); } \
        _Pragma("unroll") for (int i = 0; i < 2; ++i) { const int c = tid + 512 * i; rk[i] = *(const u32x4*)(Kg_ + (size_t)(c >> 3) * 256 + (c & 7) * 8); \
            rf[i] = *(const u32x4*)(Sf_ + (size_t)c * 8); rb[i] = *(const u32x4*)(Sb_ + (size_t)c * 8); } \
        _Pragma("unroll") for (int ks = 0; ks < 2; ++ks) qn[ks] = *(const bf16x8*)(Qg_ + (size_t)iq * 256 + 32 * ks + 8 * g); } while (0)
    int U = F.vcu;
    if (U < 1024) P4_LOAD(U);
    for (; U < 1024; U += F.G) {
        const int bh = U >> 7, n = U & 127, b = bh >> 2, h = bh & 3;
        const size_t row0 = (size_t)b * SEQ + (size_t)n * 128;
        const float l2f = log2_sigmoid(P.in[IN_DECF][h]), l2b = log2_sigmoid(P.in[IN_DECB][h]);
#pragma unroll
        for (int i = 0; i < 4; ++i) { const int c = tid + 512 * i; *(LAS u32x4*)(L + P4_V + (c >> 4) * 256 + (c & 15) * 16) = rv[i]; }
#pragma unroll
        for (int i = 0; i < 2; ++i) { const int c = tid + 512 * i, row = c >> 3, pos = ((c & 7) ^ ((row >> 1) & 7)) << 4;
            *(LAS u32x4*)(L + P4_K + row * 128 + pos) = rk[i]; *(LAS u32x4*)(L + P4_SF + row * 128 + pos) = rf[i]; *(LAS u32x4*)(L + P4_SB + row * 128 + pos) = rb[i]; }
        bf16x8 qf[2] = {qn[0], qn[1]};
        __syncthreads();
        const int Un = U + F.G;
        if (Un < 1024) P4_LOAD(Un);
        const bf16_t* gp = (const bf16_t*)(F.ws + WS_RG) + (row0 + iq) * 512 + h * 128;
        u32x2 gv[8];
#pragma unroll
        for (int et = 0; et < 8; ++et) gv[et] = *(const u32x2*)(gp + 16 * et + 4 * g);
        bf16x8 pb[4];
#pragma unroll
        for (int ks4 = 0; ks4 < 4; ++ks4) {
            float p[8];
#pragma unroll
            for (int t = 0; t < 2; ++t) { const int jt = 2 * ks4 + t, row = 16 * jt + li; const LAS unsigned char* kr = L + P4_K + row * 128;
                f32x4 s = __builtin_amdgcn_mfma_f32_16x16x32_bf16(*(const LAS bf16x8*)(kr + ((g ^ ((row >> 1) & 7)) << 4)), qf[0], (f32x4){0.f, 0.f, 0.f, 0.f}, 0, 0, 0);
                s = __builtin_amdgcn_mfma_f32_16x16x32_bf16(*(const LAS bf16x8*)(kr + (((g + 4) ^ ((row >> 1) & 7)) << 4)), qf[1], s, 0, 0, 0);
#pragma unroll
                for (int e = 0; e < 4; ++e) { const int j = 16 * jt + 4 * g + e, df = iq - j;
                    const float dcy = df >= 0 ? __builtin_amdgcn_exp2f(l2f * (float)df) : __builtin_amdgcn_exp2f(l2b * (float)(-df));
                    p[t * 4 + e] = s[e] * dcy; } }
            u32x4 pw; pw.x = cvt_pk_bf16(p[0], p[1]); pw.y = cvt_pk_bf16(p[2], p[3]); pw.z = cvt_pk_bf16(p[4], p[5]); pw.w = cvt_pk_bf16(p[6], p[7]);
            pb[ks4] = __builtin_bit_cast(bf16x8, pw);
        }
        f32x4 y[8];
#pragma unroll
        for (int et = 0; et < 8; ++et) y[et] = (f32x4){0.f, 0.f, 0.f, 0.f};
        const unsigned va = (unsigned)(size_t)(L + P4_V) + (unsigned)((4 * g + (li >> 2)) * 256 + (4 * (li & 3)) * 2);
#pragma unroll
        for (int ks4 = 0; ks4 < 4; ++ks4)
#pragma unroll
            for (int eh = 0; eh < 2; ++eh) { bf16x8 af[4]; tr_read2x4<256, 32>(va + ks4 * 32 * 256 + eh * 128, af);
#pragma unroll
                for (int et = 0; et < 4; ++et) y[4 * eh + et] = __builtin_amdgcn_mfma_f32_16x16x32_bf16(af[et], pb[ks4], y[4 * eh + et], 0, 0, 0); }
#pragma unroll
        for (int dir = 0; dir < 2; ++dir) {
            const float sc = dir ? __builtin_amdgcn_exp2f(l2b * (float)(128 - iq)) : __builtin_amdgcn_exp2f(l2f * (float)(iq + 1));
            const LAS unsigned char* sp = L + (dir ? P4_SB : P4_SF);
#pragma unroll
            for (int ks = 0; ks < 2; ++ks) {
                const u32x4 qv = __builtin_bit_cast(u32x4, qf[ks]); u32x4 qs;
                qs.x = cvt_pk_bf16(bflo(qv.x) * sc, bfhi(qv.x) * sc); qs.y = cvt_pk_bf16(bflo(qv.y) * sc, bfhi(qv.y) * sc); qs.z = cvt_pk_bf16(bflo(qv.z) * sc, bfhi(qv.z) * sc); qs.w = cvt_pk_bf16(bflo(qv.w) * sc, bfhi(qv.w) * sc);
                const bf16x8 qb = __builtin_bit_cast(bf16x8, qs);
#pragma unroll
                for (int et = 0; et < 8; ++et) { const int row = 16 * et + li; const bf16x8 af = *(const LAS bf16x8*)(sp + row * 128 + (((g + 4 * ks) ^ ((row >> 1) & 7)) << 4));
                    y[et] = __builtin_amdgcn_mfma_f32_16x16x32_bf16(af, qb, y[et], 0, 0, 0); }
            }
        }
        float s1 = 0.f;
#pragma unroll
        for (int et = 0; et < 8; ++et) s1 += (y[et].x + y[et].y) + (y[et].z + y[et].w);
        s1 = sum_g4(s1);
        const float mu = s1 * (1.f / 128.f); float s2 = 0.f;
#pragma unroll
        for (int et = 0; et < 8; ++et) { const f32x4 dv = y[et] - mu; s2 += (dv.x * dv.x + dv.y * dv.y) + (dv.z * dv.z + dv.w * dv.w); }
        s2 = sum_g4(s2);
        const float rstd = 1.0f / sqrtf(s2 * (1.f / 128.f) + 1e-5f);
        const float* gw = P.in[IN_GNW] + h * 128;
        bf16_t* op = (bf16_t*)(F.ws + WS_MIX) + (row0 + iq) * 1024 + 512 + h * 128;
#pragma unroll
        for (int et = 0; et < 8; ++et) { const int e0 = 16 * et + 4 * g; const f32x4 ww = *(const f32x4*)(gw + e0);
            const f32x4 v = (y[et] - mu) * rstd * ww; u32x2 o; o.x = cvt_pk_bf16(v.x * bflo(gv[et].x), v.y * bfhi(gv[et].x)); o.y = cvt_pk_bf16(v.z * bflo(gv[et].y), v.w * bfhi(gv[et].y));
            *(u32x2*)(op + e0) = o; }
        __syncthreads();
    }
#undef P4_LOAD
}

template <int VAR>
struct EpiResidT {
    static constexpr bool PERM = false;
    const float* base; float* out; bf16_t* ob; float* sumsq;
    __device__ __forceinline__ void operator()(const f32x4 (&acc)[2][2][4][2], const pg8::Unit& u, int wr, int wc, int fr, int fq) const {
        const int row0 = u.pm * 256 + wr * 64 + fr, col0 = u.pn * 256 + wc * 32 + 4 * fq;
#pragma unroll
        for (int ai = 0; ai < 2; ++ai)
#pragma unroll
            for (int m = 0; m < 4; ++m) { const int row = row0 + ai * 128 + m * 16; const size_t off = (size_t)row * DM + col0; float ss = 0.f;
#pragma unroll
                for (int bj = 0; bj < 2; ++bj)
#pragma unroll
                    for (int n = 0; n < 2; ++n) { const f32x4 v = (VAR == 3 ? (f32x4){0.f, 0.f, 0.f, 0.f} : *(const f32x4*)(base + off + bj * 128 + n * 16)) + acc[ai][bj][m][n];
                        if (VAR != 2) *(f32x4*)(out + off + bj * 128 + n * 16) = v; ss += (v.x * v.x + v.y * v.y) + (v.z * v.z + v.w * v.w);
                        u32x2 wv; wv.x = cvt_pk_bf16(v.x, v.y); wv.y = cvt_pk_bf16(v.z, v.w); *(u32x2*)(ob + off + bj * 128 + n * 16) = wv; }
                ss = sum_g4(ss);
                if (fq == 0 && VAR != 1) atomicAdd(sumsq + row, ss);
                asm volatile("" ::: "memory"); }
    }
};


__device__ __forceinline__ void memkv_item(Frame& F, int item) {
    const Params& P = *F.p; const int lane = F.lane, w = F.wave, g = lane >> 4, li = lane & 15;
    const int rt = item >> 3, hh = item & 7, row0 = rt * 16;
    const unsigned char* A = (const unsigned char*)(F.ws + WS_MEMH) + (size_t)(row0 + li) * 1024 + 32 * g;
    const unsigned char* Bw = (const unsigned char*)(F.ws + WS_WMKV) + (size_t)(hh * 256 + 32 * w + li) * 1024 + 32 * g;
    LAS float* part = (LAS float*)F.lds;
    f32x4 acc[2] = {(f32x4){0.f, 0.f, 0.f, 0.f}, (f32x4){0.f, 0.f, 0.f, 0.f}};
    {   typedef int i32x8_ __attribute__((ext_vector_type(8)));
        const int sca = 124 * 0x01010101, scb = 122 * 0x01010101;
        u32x4 ra[8][2], rb0[8][2], rb1[8][2];
#pragma unroll
        for (int s = 0; s < 8; ++s) { ra[s][0] = *(const u32x4*)(A + 128 * s); ra[s][1] = *(const u32x4*)(A + 128 * s + 16);
            rb0[s][0] = *(const u32x4*)(Bw + 128 * s); rb0[s][1] = *(const u32x4*)(Bw + 128 * s + 16);
            rb1[s][0] = *(const u32x4*)(Bw + (size_t)16 * 1024 + 128 * s); rb1[s][1] = *(const u32x4*)(Bw + (size_t)16 * 1024 + 128 * s + 16); }
#pragma unroll
        for (int s = 0; s < 8; ++s) {
            const i32x8_ af = (i32x8_){(int)ra[s][0].x, (int)ra[s][0].y, (int)ra[s][0].z, (int)ra[s][0].w, (int)ra[s][1].x, (int)ra[s][1].y, (int)ra[s][1].z, (int)ra[s][1].w};
            const i32x8_ b0 = (i32x8_){(int)rb0[s][0].x, (int)rb0[s][0].y, (int)rb0[s][0].z, (int)rb0[s][0].w, (int)rb0[s][1].x, (int)rb0[s][1].y, (int)rb0[s][1].z, (int)rb0[s][1].w};
            const i32x8_ b1 = (i32x8_){(int)rb1[s][0].x, (int)rb1[s][0].y, (int)rb1[s][0].z, (int)rb1[s][0].w, (int)rb1[s][1].x, (int)rb1[s][1].y, (int)rb1[s][1].z, (int)rb1[s][1].w};
            asm volatile("v_mfma_scale_f32_16x16x128_f8f6f4 %0, %1, %2, %0, %3, %4 op_sel_hi:[0,0,0]" : "+v"(acc[0]) : "v"(af), "v"(b0), "v"(sca), "v"(scb));
            asm volatile("v_mfma_scale_f32_16x16x128_f8f6f4 %0, %1, %2, %0, %3, %4 op_sel_hi:[0,0,0]" : "+v"(acc[1]) : "v"(af), "v"(b1), "v"(sca), "v"(scb)); }
        asm volatile("s_nop 15\n\ts_nop 15\n\ts_nop 15" : "+v"(acc[0]), "+v"(acc[1]));
    }
    const int b = row0 >> 8, key0 = (row0 & 255) + 4 * g;
    if (hh < 4) {
#pragma unroll
        for (int e = 0; e < 4; ++e) { const float s = sum_row16(acc[0][e] * acc[0][e] + acc[1][e] * acc[1][e]); if (li == 0) part[w * 16 + 4 * g + e] = s; }
    }
    __syncthreads();
    if (hh < 4) {
        float rs[4];
#pragma unroll
        for (int e = 0; e < 4; ++e) { float t = 0.f;
#pragma unroll
            for (int ww = 0; ww < 8; ++ww) t += part[ww * 16 + 4 * g + e];
            rs[e] = 0.0625f / sqrtf(t * (1.f / 256.f) + 1e-6f); }
        unsigned char* dst = (unsigned char*)(F.ws + WS_MK) + ((size_t)(b * 4 + hh) * 256 + key0) * 256;
#pragma unroll
        for (int c = 0; c < 2; ++c) { const int d = 32 * w + 16 * c + li; const float wv = P.in[IN_MKN][d] * P.in[IN_MQN][d] * 64.f;
#pragma unroll
            for (int e = 0; e < 4; ++e) dst[(size_t)e * 256 + d] = (unsigned char)(__builtin_amdgcn_cvt_pk_fp8_f32(acc[c][e] * rs[e] * wv, 0.f, 0, false) & 0xff); }
    } else {
        unsigned char* dst = (unsigned char*)(F.ws + WS_MVT) + ((size_t)(b * 4 + (hh - 4)) * 256) * 256 + 128 * ((row0 & 255) >> 7) + 32 * g + 4 * ((row0 & 127) >> 4);
#pragma unroll
        for (int c = 0; c < 2; ++c) { const int d = 32 * w + 16 * c + li; int q = 0;
            q = __builtin_amdgcn_cvt_pk_fp8_f32(acc[c][0] * 16.f, acc[c][1] * 16.f, q, false); q = __builtin_amdgcn_cvt_pk_fp8_f32(acc[c][2] * 16.f, acc[c][3] * 16.f, q, true);
            *(unsigned*)(dst + (size_t)d * 256) = (unsigned)q; }
    }
    __syncthreads();
}

#ifndef KEEP_LO
#define KEEP_LO 0
#endif
template <bool BASE_F32>
struct EpiResidHL {
    static constexpr bool PERM = true;
    const float* basef; const bf16_t* bhi; const float* blo_f; bf16_t* ohi; bf16_t* olo; u64_t* sumsq; unsigned char* oq;
    __device__ __forceinline__ void load_base(int row, int col0, u32x4 (&bh)[2]) const {
        const size_t off = (size_t)row * DM + col0;
#pragma unroll
        for (int bj = 0; bj < 2; ++bj) bh[bj] = __builtin_nontemporal_load((const u32x4*)(bhi + off + bj * 128));
    }
    __device__ __forceinline__ void operator()(const f32x4 (&acc)[2][2][4][2], const pg8::Unit& u, int wr, int wc, int fr, int fq) const {
        const int row0 = u.pm * 256 + wr * 64 + fr, col0 = u.pn * 256 + wc * 32 + 8 * fq;
        u32x4 bh[4][2];
#pragma unroll
        for (int i = 0; i < 3; ++i) load_base(row0 + (i >> 2) * 128 + (i & 3) * 16, col0, bh[i]);
        f32x4 iw[2][2]; float rr[8];
        if (BASE_F32) {
#pragma unroll
            for (int i = 0; i < 8; ++i) rr[i] = blo_f[row0 + (i >> 2) * 128 + (i & 3) * 16];
#pragma unroll
            for (int bj = 0; bj < 2; ++bj)
#pragma unroll
                for (int n = 0; n < 2; ++n) { const f32x4 w4 = *(const f32x4*)(basef + col0 + bj * 128 + 4 * n); iw[bj][n] = (f32x4){1.0f / w4.x, 1.0f / w4.y, 1.0f / w4.z, 1.0f / w4.w}; } }
#pragma unroll
        for (int i = 0; i < 8; ++i) { const int ai = i >> 2, m = i & 3; const int row = row0 + ai * 128 + m * 16; const size_t off = (size_t)row * DM + col0; float ss = 0.f;
            if (i < 5) load_base(row0 + ((i + 3) >> 2) * 128 + ((i + 3) & 3) * 16, col0, bh[(i + 3) & 3]);
            float rms = 1.f; if (BASE_F32) rms = 1.0f / rr[i];
#pragma unroll
            for (int bj = 0; bj < 2; ++bj) { f32x4 b0, b1;
                { const u32x4 h = bh[i & 3][bj];
                    b0 = (f32x4){bflo(h.x), bfhi(h.x), bflo(h.y), bfhi(h.y)}; b1 = (f32x4){bflo(h.z), bfhi(h.z), bflo(h.w), bfhi(h.w)}; }
                if (BASE_F32) { b0 = b0 * iw[bj][0] * rms; b1 = b1 * iw[bj][1] * rms; }
                const f32x4 v0 = b0 + acc[ai][bj][m][0], v1 = b1 + acc[ai][bj][m][1];
                ss += (v0.x * v0.x + v0.y * v0.y) + (v0.z * v0.z + v0.w * v0.w) + (v1.x * v1.x + v1.y * v1.y) + (v1.z * v1.z + v1.w * v1.w);
                u32x4 hw; hw.x = cvt_pk_bf16(v0.x, v0.y); hw.y = cvt_pk_bf16(v0.z, v0.w); hw.z = cvt_pk_bf16(v1.x, v1.y); hw.w = cvt_pk_bf16(v1.z, v1.w);
                *(u32x4*)(ohi + off + bj * 128) = hw;
                if (oq) { int q0 = 0, q1 = 0; q0 = __builtin_amdgcn_cvt_pk_fp8_f32(v0.x, v0.y, q0, false); q0 = __builtin_amdgcn_cvt_pk_fp8_f32(v0.z, v0.w, q0, true);
                    q1 = __builtin_amdgcn_cvt_pk_fp8_f32(v1.x, v1.y, q1, false); q1 = __builtin_amdgcn_cvt_pk_fp8_f32(v1.z, v1.w, q1, true);
                    *(u32x2*)(oq + off + bj * 128) = (u32x2){(unsigned)q0, (unsigned)q1}; } }
            ss = sum_g4(ss);
            if (fq == 0) stat_add(sumsq + row, ss);
        }
    }
};
struct EpiNull {
    static constexpr bool PERM = true;
    float* sink;
    __device__ __forceinline__ void operator()(const f32x4 (&acc)[2][2][4][2], const pg8::Unit& u, int wr, int wc, int fr, int fq) const {
        f32x4 s = (f32x4){0.f, 0.f, 0.f, 0.f};
#pragma unroll
        for (int a = 0; a < 2; ++a)
#pragma unroll
            for (int b = 0; b < 2; ++b)
#pragma unroll
                for (int m = 0; m < 4; ++m)
#pragma unroll
                    for (int n = 0; n < 2; ++n) s += acc[a][b][m][n];
        sink[(size_t)(u.pm * 4 + u.pn) * 512 + threadIdx.x] = s.x + s.y + s.z + s.w;
    }
};
typedef EpiResidT<0> EpiResid;
#ifndef EPI_VAR
#define EPI_VAR 0
#endif
struct EpiMemQ {
    static constexpr bool PERM = true;
    bf16_t* qm; const u64_t* sumsq1; u64_t* hsq;
    __device__ __forceinline__ void operator()(const f32x4 (&acc)[2][2][4][2], const pg8::Unit& u, int wr, int wc, int fr, int fq) const {
        const int row0 = u.pm * 256 + wr * 64 + fr, col0 = u.pn * 256 + wc * 32 + 8 * fq;
        float sq[8];
#pragma unroll
        for (int i = 0; i < 8; ++i) sq[i] = stat_get(sumsq1 + row0 + (i >> 2) * 128 + (i & 3) * 16);
#pragma unroll
        for (int ai = 0; ai < 2; ++ai)
#pragma unroll
            for (int m = 0; m < 4; ++m) { const int row = row0 + ai * 128 + m * 16; const float rs = 1.0f / sqrtf(sq[ai * 4 + m] * (1.f / 1024.f) + 1e-6f); float ss = 0.f;
                unsigned char* rowp = (unsigned char*)qm + (size_t)row * DM + col0;
#pragma unroll
                for (int bj = 0; bj < 2; ++bj) { const f32x4 v0 = acc[ai][bj][m][0] * rs, v1 = acc[ai][bj][m][1] * rs;
                    ss += (v0.x * v0.x + v0.y * v0.y) + (v0.z * v0.z + v0.w * v0.w) + (v1.x * v1.x + v1.y * v1.y) + (v1.z * v1.z + v1.w * v1.w);
                    int q0 = 0, q1 = 0; q0 = __builtin_amdgcn_cvt_pk_fp8_f32(v0.x * 8.f, v0.y * 8.f, q0, false); q0 = __builtin_amdgcn_cvt_pk_fp8_f32(v0.z * 8.f, v0.w * 8.f, q0, true);
                    q1 = __builtin_amdgcn_cvt_pk_fp8_f32(v1.x * 8.f, v1.y * 8.f, q1, false); q1 = __builtin_amdgcn_cvt_pk_fp8_f32(v1.z * 8.f, v1.w * 8.f, q1, true);
                    *(u32x2*)(rowp + 128 * bj) = (u32x2){(unsigned)q0, (unsigned)q1}; }
                ss = sum_g4(ss);
                if (fq == 0) stat_add(hsq + (size_t)row * 4 + u.pn, ss); }
    }
};

__device__ __forceinline__ void p7_mem_attention(Frame& F) {
    const Params& P = *F.p; const int lane = F.lane, w = F.wave, tid = F.tid, g = lane >> 4, li = lane & 15;
    float mq = 0.f, mk = 0.f;
#pragma unroll
    for (int i = 0; i < 4; ++i) { mq = fmaxf(mq, fabsf(P.in[IN_MQN][lane + 64 * i])); mk = fmaxf(mk, fabsf(P.in[IN_MKN][lane + 64 * i])); }
    mq = wave_max(mq); mk = wave_max(mk);
    const float M2 = 16.0f * mq * mk * 1.44269504089f;
    LAS unsigned char* buf = F.lds;
    const int kso = tid * 16, klo = (tid >> 4) * 256 + (((tid & 15) ^ ((tid >> 4) & 15)) << 4);
    const int vdim = tid >> 2, vseg = (tid & 3) ^ ((0 - (vdim >> 2)) & 3);
    typedef int i32x8_ __attribute__((ext_vector_type(8)));
    LAS unsigned char* qpatch = F.lds + 65536 + w * 8192; u64_t hn[2];
#define P7_QLOAD(U_) do { const int bhd_ = (U_) >> 6, qb_ = (U_) & 63, b_ = bhd_ >> 2, head_ = bhd_ & 3; const size_t tok0_ = (size_t)b_ * SEQ + (size_t)qb_ * 256 + 32 * w; \
        _Pragma("unroll") for (int qt = 0; qt < 2; ++qt) { const size_t tok = tok0_ + 16 * qt + li; const unsigned char* qp = (const unsigned char*)(F.ws + WS_QM) + tok * DM + head_ * 256 + 32 * g; \
            _Pragma("unroll") for (int kb = 0; kb < 2; ++kb) _Pragma("unroll") for (int h2 = 0; h2 < 2; ++h2) \
                __builtin_amdgcn_global_load_lds((const unsigned*)(qp + 128 * kb + 16 * h2), (LAS unsigned*)(qpatch + (qt * 4 + kb * 2 + h2) * 1024), 16, 0, 0); \
            hn[qt] = ((const u64_t*)(F.ws + WS_HSQ))[tok * 4 + head_]; } } while (0)
    if (F.vcu < 512) P7_QLOAD(F.vcu);
    for (int U = F.vcu; U < 512; U += F.G) {
        const int bhd = U >> 6, qb = U & 63, b = bhd >> 2, head = bhd & 3;
        const size_t tok0 = (size_t)b * SEQ + (size_t)qb * 256 + 32 * w;
        const unsigned char* Kp = (const unsigned char*)(F.ws + WS_MK) + (size_t)bhd * 65536;
        const bf16_t* Vt = (const bf16_t*)(F.ws + WS_MVT) + (size_t)bhd * 65536;
        i32x8_ qf[2][2]; float hs[2];
        asm volatile("s_waitcnt vmcnt(0)" ::: "memory");
#pragma unroll
        for (int qt = 0; qt < 2; ++qt) {
#pragma unroll
            for (int kb = 0; kb < 2; ++kb) { const u32x4 q0 = *(const LAS u32x4*)(qpatch + (qt * 4 + kb * 2) * 1024 + lane * 16), q1 = *(const LAS u32x4*)(qpatch + (qt * 4 + kb * 2 + 1) * 1024 + lane * 16);
                qf[qt][kb] = (i32x8_){(int)q0.x, (int)q0.y, (int)q0.z, (int)q0.w, (int)q1.x, (int)q1.y, (int)q1.z, (int)q1.w}; }
            const float hsq_ = (float)(unsigned)(hn[qt] >> 32) + (float)(unsigned)hn[qt] * 2.3283064365386963e-10f;
            hs[qt] = 1.44269504089f / sqrtf(hsq_ * (1.f / 256.f) + 1e-6f); }
        LDS_WAIT();
        u32x4 pb[2][8]; i32x8_ pb8[2][2]; float lsum[2] = {0.f, 0.f};
        u32x4 sreg[2];
        sreg[0] = *(const u32x4*)(Kp + kso); sreg[1] = *(const u32x4*)(Kp + (size_t)8192 + kso);
        __syncthreads();
        *(LAS u32x4*)(buf + klo) = sreg[0];
        __syncthreads();
        const int sck = 121 * 0x01010101, scq = 124 * 0x01010101;
#pragma unroll
        for (int Pp = 0; Pp < 8; ++Pp) {
            LAS unsigned char* cb = buf + (Pp & 1) * 8192;
            if (Pp < 6) sreg[Pp & 1] = *(const u32x4*)(Kp + (size_t)(Pp + 2) * 8192 + kso);
            f32x4 st[2][2];
#pragma unroll
            for (int t = 0; t < 2; ++t) { st[0][t] = (f32x4){0.f, 0.f, 0.f, 0.f}; st[1][t] = (f32x4){0.f, 0.f, 0.f, 0.f}; }
#pragma unroll
            for (int kb = 0; kb < 2; ++kb)
#pragma unroll
                for (int t = 0; t < 2; ++t) { LAS const unsigned char* rp = cb + (16 * t + li) * 256;
                    const u32x4 k0 = *(const LAS u32x4*)(rp + (((8 * kb + 2 * g) ^ li) << 4)), k1 = *(const LAS u32x4*)(rp + (((8 * kb + 2 * g + 1) ^ li) << 4));
                    const i32x8_ kf = (i32x8_){(int)k0.x, (int)k0.y, (int)k0.z, (int)k0.w, (int)k1.x, (int)k1.y, (int)k1.z, (int)k1.w};
                    asm volatile("v_mfma_scale_f32_16x16x128_f8f6f4 %0, %1, %2, %0, %3, %4 op_sel_hi:[0,0,0]" : "+v"(st[0][t]) : "v"(kf), "v"(qf[0][kb]), "v"(sck), "v"(scq));
                    asm volatile("v_mfma_scale_f32_16x16x128_f8f6f4 %0, %1, %2, %0, %3, %4 op_sel_hi:[0,0,0]" : "+v"(st[1][t]) : "v"(kf), "v"(qf[1][kb]), "v"(sck), "v"(scq)); }
            asm volatile("s_nop 15\n\ts_nop 15\n\ts_nop 15" : "+v"(st[0][0]), "+v"(st[0][1]), "+v"(st[1][0]), "+v"(st[1][1]));
#pragma unroll
            for (int qt = 0; qt < 2; ++qt) { float p[8];
#pragma unroll
                for (int t = 0; t < 2; ++t)
#pragma unroll
                    for (int e = 0; e < 4; ++e) { p[t * 4 + e] = __builtin_amdgcn_exp2f(__builtin_fmaf(st[qt][t][e], hs[qt], -M2)); lsum[qt] += p[t * 4 + e]; }
                u32x4 pw; pw.x = cvt_pk_bf16(p[0], p[1]); pw.y = cvt_pk_bf16(p[2], p[3]); pw.z = cvt_pk_bf16(p[4], p[5]); pw.w = cvt_pk_bf16(p[6], p[7]);
                pb[qt][Pp] = pw; }
            if (Pp < 7) *(LAS u32x4*)(buf + ((Pp + 1) & 1) * 8192 + klo) = sreg[(Pp + 1) & 1];
            __syncthreads();
        }
        float inv[2];
#pragma unroll
        for (int qt = 0; qt < 2; ++qt) {
            const float L = sum_g4(lsum[qt]); const unsigned eb = (__builtin_bit_cast(unsigned, L) >> 23) & 0xffu;
            const float f = __builtin_bit_cast(float, (261u - eb) << 23), fi = __builtin_bit_cast(float, (eb + 1u) << 23);
            inv[qt] = fi / L;
#pragma unroll
            for (int Pp = 0; Pp < 8; ++Pp) { const u32x4 pw = pb[qt][Pp]; int w0 = 0, w1 = 0;
                w0 = __builtin_amdgcn_cvt_pk_fp8_f32(bflo(pw.x) * f, bfhi(pw.x) * f, w0, false); w0 = __builtin_amdgcn_cvt_pk_fp8_f32(bflo(pw.y) * f, bfhi(pw.y) * f, w0, true);
                w1 = __builtin_amdgcn_cvt_pk_fp8_f32(bflo(pw.z) * f, bfhi(pw.z) * f, w1, false); w1 = __builtin_amdgcn_cvt_pk_fp8_f32(bflo(pw.w) * f, bfhi(pw.w) * f, w1, true);
                pb8[qt][Pp >> 2][2 * (Pp & 3)] = w0; pb8[qt][Pp >> 2][2 * (Pp & 3) + 1] = w1; } }
        if (U + F.G < 512) P7_QLOAD(U + F.G);
        const unsigned char* Vt8 = (const unsigned char*)(F.ws + WS_MVT) + (size_t)bhd * 65536;
        const int scv = 123 * 0x01010101, scp = 119 * 0x01010101;
        u32x4 vreg[2];
#define P7_VLOAD(c_) do { _Pragma("unroll") for (int j = 0; j < 2; ++j) { const int q_ = tid + 512 * j, dim_ = q_ >> 3, pc_ = q_ & 7; \
            vreg[j] = *(const u32x4*)(Vt8 + (size_t)(128 * ((c_) >> 1) + dim_) * 256 + 128 * ((c_) & 1) + 16 * pc_); } } while (0)
#define P7_VSTORE(st_) do { _Pragma("unroll") for (int j = 0; j < 2; ++j) { const int q_ = tid + 512 * j, dim_ = q_ >> 3, pc_ = q_ & 7; \
            *(LAS u32x4*)(buf + (st_) * 16384 + dim_ * 128 + ((pc_ ^ ((dim_ >> 1) & 7)) << 4)) = vreg[j]; } } while (0)
        P7_VLOAD(0); P7_VSTORE(0);
        __syncthreads();
#pragma unroll 1
        for (int dh = 0; dh < 2; ++dh) {
            f32x4 o[2][8];
#pragma unroll
            for (int dt = 0; dt < 8; ++dt) { o[0][dt] = (f32x4){0.f, 0.f, 0.f, 0.f}; o[1][dt] = (f32x4){0.f, 0.f, 0.f, 0.f}; }
#pragma unroll
            for (int kb = 0; kb < 2; ++kb) {
                const int c = dh * 2 + kb; LAS unsigned char* cb = buf + kb * 16384;
                if (c < 3) P7_VLOAD(c + 1);
#pragma unroll
                for (int dt = 0; dt < 8; ++dt) { const int dl = 16 * dt + li; LAS const unsigned char* rp = cb + dl * 128; const int sw = (li >> 1) & 7;
                    const u32x4 v0 = *(const LAS u32x4*)(rp + (((2 * g) ^ sw) << 4)), v1 = *(const LAS u32x4*)(rp + (((2 * g + 1) ^ sw) << 4));
                    const i32x8_ vf = (i32x8_){(int)v0.x, (int)v0.y, (int)v0.z, (int)v0.w, (int)v1.x, (int)v1.y, (int)v1.z, (int)v1.w};
                    asm volatile("v_mfma_scale_f32_16x16x128_f8f6f4 %0, %1, %2, %0, %3, %4 op_sel_hi:[0,0,0]" : "+v"(o[0][dt]) : "v"(vf), "v"(pb8[0][kb]), "v"(scv), "v"(scp));
                    asm volatile("v_mfma_scale_f32_16x16x128_f8f6f4 %0, %1, %2, %0, %3, %4 op_sel_hi:[0,0,0]" : "+v"(o[1][dt]) : "v"(vf), "v"(pb8[1][kb]), "v"(scv), "v"(scp)); }
                if (c < 3) P7_VSTORE(kb ^ 1);
                __syncthreads();
            }
            asm volatile("s_nop 15\n\ts_nop 15\n\ts_nop 15" : "+v"(o[0][0]), "+v"(o[0][1]), "+v"(o[0][2]), "+v"(o[0][3]), "+v"(o[0][4]), "+v"(o[0][5]), "+v"(o[0][6]), "+v"(o[0][7]),
                                                              "+v"(o[1][0]), "+v"(o[1][1]), "+v"(o[1][2]), "+v"(o[1][3]), "+v"(o[1][4]), "+v"(o[1][5]), "+v"(o[1][6]), "+v"(o[1][7]));
#pragma unroll
            for (int qt = 0; qt < 2; ++qt) { unsigned char* op = (unsigned char*)(F.ws + WS_OM) + (tok0 + 16 * qt + li) * DM + head * 256 + 128 * dh + 4 * g;
#pragma unroll
                for (int dt = 0; dt < 8; ++dt) { const f32x4 v = o[qt][dt] * (inv[qt] * 16.f); int q0 = 0; q0 = __builtin_amdgcn_cvt_pk_fp8_f32(v.x, v.y, q0, false); q0 = __builtin_amdgcn_cvt_pk_fp8_f32(v.z, v.w, q0, true);
                    *(unsigned*)(op + 16 * dt) = (unsigned)q0; } }
        }
#undef P7_VLOAD
#undef P7_VSTORE
    }
}

constexpr size_t WS_TOKSLOT = 117 * MiB + 512 * 1024;
constexpr size_t WS_SLOTE = 120 * MiB;
constexpr int LDS_MOE_TAB = 131072;
__device__ __forceinline__ int moe_tables(Frame& F) {
    LAS unsigned* cn = (LAS unsigned*)(F.lds + LDS_MOE_TAB); LAS unsigned* tp = cn + 32;
    const unsigned* cnt = (const unsigned*)(F.ws + WS_CTL) + CW_CNT;
    if (F.tid < 32) cn[F.tid] = __hip_atomic_load(cnt + F.tid, __ATOMIC_RELAXED, __HIP_MEMORY_SCOPE_AGENT);
    __syncthreads();
    if (F.tid == 0) { unsigned o = 0; for (int e = 0; e < 32; ++e) { tp[e] = o; o += (cn[e] + 255u) >> 8; } tp[32] = o; }
    __syncthreads();
    return (int)tp[32];
}

struct RouteRec { int e0, e1; float g0, g1; };
constexpr int P9_W_BYTES = 48 * 2048, P9_XROW = 288, P9_XT_OFF = P9_W_BYTES + 256;
__device__ __forceinline__ void p9_route(Frame& F, unsigned* gcnt) {
    const int lane = F.lane, w = F.wave, tid = F.tid, g = lane >> 4, li = lane & 15;
    LAS unsigned char* Wl = F.lds;
    LAS unsigned* lcnt = (LAS unsigned*)(F.lds + P9_W_BYTES);
    LAS unsigned char* xt = F.lds + P9_XT_OFF + w * (16 * P9_XROW);
    {
        const bf16_t* wg = (const bf16_t*)(F.ws + WS_WRT);
        u32x4 t[12];
#pragma unroll
        for (int i = 0; i < 12; ++i) { const int p = tid + 512 * i; t[i] = *(const u32x4*)(wg + (size_t)(p >> 7) * 1024 + (p & 127) * 8); }
#pragma unroll
        for (int i = 0; i < 12; ++i) { const int p = tid + 512 * i, row = p >> 7, ch = p & 127; *(LAS u32x4*)(Wl + row * 2048 + ((ch ^ (row & 15)) << 4)) = t[i]; }
    }
    if (tid < 32) lcnt[tid] = 0u;
    __syncthreads();
    const int gw = F.vcu * NWAVES + w, NGW = F.G * NWAVES;
    LAS unsigned* lbase = lcnt + 32;
    unsigned* slote = (unsigned*)(F.ws + WS_SLOTE); int* tokslot = (int*)(F.ws + WS_TOKSLOT);
    for (int tb = 0; tb < NT / 16; tb += NGW) {
        const int tt = tb + gw; const bool have = tt < NT / 16;
        const int tok0 = (have ? tt : 0) * 16;
        const bf16_t* xg = (const bf16_t*)(F.ws + WS_X2B) + (size_t)(tok0 + g) * DM + 8 * li;
        f32x4 acc[3];
#pragma unroll
        for (int ct = 0; ct < 3; ++ct) acc[ct] = (f32x4){0.f, 0.f, 0.f, 0.f};
        u32x4 xr[4];
#pragma unroll
        for (int i = 0; i < 4; ++i) xr[i] = *(const u32x4*)(xg + (size_t)(4 * i) * DM);
#pragma unroll 1
        for (int c = 0; c < 8; ++c) {
#pragma unroll
            for (int i = 0; i < 4; ++i) *(LAS u32x4*)(xt + (4 * i + g) * P9_XROW + li * 16) = xr[i];
            if (c < 7) {
#pragma unroll
                for (int i = 0; i < 4; ++i) xr[i] = *(const u32x4*)(xg + (size_t)(4 * i) * DM + 128 * (c + 1)); }
            LDS_WAIT();
#pragma unroll
            for (int ks = 0; ks < 4; ++ks) {
                const bf16x8 ah = *(const LAS bf16x8*)(xt + li * P9_XROW + (32 * ks + 8 * g) * 2);
                const int chi = 16 * c + 4 * ks + g;
#pragma unroll
                for (int ct = 0; ct < 3; ++ct) { const bf16x8 bh = *(const LAS bf16x8*)(Wl + (16 * ct + li) * 2048 + ((chi ^ li) << 4));
                    acc[ct] = __builtin_amdgcn_mfma_f32_16x16x32_bf16(ah, bh, acc[ct], 0, 0, 0); }
            }
            LDS_WAIT();
        }
        LAS float* lg = (LAS float*)xt;
#pragma unroll
        for (int ct = 0; ct < 3; ++ct)
#pragma unroll
            for (int e = 0; e < 4; ++e) lg[(4 * g + e) * 52 + 16 * ct + li] = acc[ct][e];
        LDS_WAIT();
        int e0 = 0, e1 = 0; float g0 = 0.f, g1 = 0.f; unsigned lp0 = 0u, lp1 = 0u;
        if (lane < 16) {
            const int tok = tok0 + lane; const LAS float* a = lg + lane * 52;
            const float rstd = 1.0f / sqrtf(stat_get((const u64_t*)(F.ws + WS_SUMSQ2) + tok) * (1.f / 1024.f) + 1e-6f);
            int grp = 0; float gm = a[0];
#pragma unroll
            for (int q = 1; q < 4; ++q) { const float v = a[q]; if (v > gm) { gm = v; grp = q; } }
            float gden = 0.f;
#pragma unroll
            for (int q = 0; q < 4; ++q) gden += expf((a[q] - gm) * rstd);
            const float ggate = 1.0f / gden;
            const LAS float* el = a + 4 + grp * 8;
            int i1 = 0; float v1 = el[0];
#pragma unroll
            for (int e = 1; e < 8; ++e) { const float v = el[e]; if (v > v1) { v1 = v; i1 = e; } }
            int i2 = -1; float v2 = -3.0e38f;
#pragma unroll
            for (int e = 0; e < 8; ++e) { const float v = el[e]; if (e != i1 && v > v2) { v2 = v; i2 = e; } }
            const float ex = expf((v2 - v1) * rstd);
            e0 = grp * 8 + i1; e1 = grp * 8 + i2; g0 = ggate / (1.0f + ex); g1 = ggate * ex / (1.0f + ex);
            if (have) { lp0 = __hip_atomic_fetch_add(&lcnt[e0], 1u, __ATOMIC_RELAXED, __HIP_MEMORY_SCOPE_WORKGROUP); lp1 = __hip_atomic_fetch_add(&lcnt[e1], 1u, __ATOMIC_RELAXED, __HIP_MEMORY_SCOPE_WORKGROUP); }
        }
        __syncthreads();
        if (tid < 32) { const unsigned n = lcnt[tid]; lbase[tid] = n ? atomicAdd(gcnt + tid, n) : 0u; }
        __syncthreads();
        if (lane < 16 && have) { const int tok = tok0 + lane; const unsigned p0 = lbase[e0] + lp0, p1 = lbase[e1] + lp1;
            slote[((size_t)e0 << 15) + p0] = (unsigned)tok | (cvt_pk_bf16(g0, 0.f) << 16);
            slote[((size_t)e1 << 15) + p1] = (unsigned)tok | 0x8000u | (cvt_pk_bf16(g1, 0.f) << 16);
            tokslot[tok * 2] = (int)(((unsigned)e0 << 16) | p0); tokslot[tok * 2 + 1] = (int)(((unsigned)e1 << 16) | p1); }
        __syncthreads();
        if (tid < 32) lcnt[tid] = 0u;
        __syncthreads();
    }
}
struct MoeOrder {
    const char* A; const char* W; LAS const unsigned* cn; const unsigned* slote; int ntiles, G, c, kb; size_t wstride, tstepB, tstepA;
    __device__ bool next_(int i, pg8::Unit& u, bool gatherA) const {
        const int L = i * G + c, T = L >> 2; if (T >= ntiles) return false;
        LAS const unsigned* tp = cn + 32; int e = 0;
#pragma unroll
        for (int k = 16; k; k >>= 1) e += (tp[e + k] <= (unsigned)T) ? k : 0;
        u.pm = T; u.pn = L & 3; u.aux = e;
        u.A = gatherA ? A : A + (size_t)T * tstepA; u.B = W + (size_t)e * wstride + (size_t)u.pn * tstepB; return true;
    }
};
struct MoeOrder1 : MoeOrder {
    static constexpr bool GATHER = true;
    __device__ bool next(int i, pg8::Unit& u) const { return next_(i, u, true); }
    __device__ __forceinline__ void gather(const pg8::Unit& u, int R0, int R1, int C0, int C1, unsigned (&vA)[2][2]) const {
        const int e = u.aux; const unsigned n = cn[e]; const unsigned pb = (unsigned)(u.pm - (int)cn[32 + e]) * 256u; const unsigned* se = slote + ((size_t)e << 15);
#pragma unroll
        for (int h = 0; h < 2; ++h) { const unsigned p0 = pb + R0 + 128 * h, p1 = pb + R1 + 128 * h;
            const int t0 = p0 < n ? (int)(se[p0] & 0x7fffu) : 0, t1 = p1 < n ? (int)(se[p1] & 0x7fffu) : 0;
            vA[h][0] = (unsigned)(t0 * kb + C0) * 2u; vA[h][1] = (unsigned)(t1 * kb + C1) * 2u; }
    }
};
struct MoeOrder2 : MoeOrder {
    static constexpr bool GATHER = false;
    __device__ bool next(int i, pg8::Unit& u) const { return next_(i, u, false); }
    __device__ __forceinline__ void gather(const pg8::Unit&, int, int, int, int, unsigned (&)[2][2]) const {}
};
struct EpiMoe1 {
    static constexpr bool PERM = true;
    unsigned char* H; const unsigned* slote; LAS const unsigned* cn; const u64_t* sumsq2;
    __device__ __forceinline__ void operator()(const f32x4 (&acc)[2][2][4][2], const pg8::Unit& u, int wr, int wc, int fr, int fq) const {
        const int row0 = u.pm * 256 + wr * 64 + fr;
        const int e = u.aux; const unsigned n = cn[e]; const unsigned pb = (unsigned)(u.pm - (int)cn[32 + e]) * 256u; const unsigned* se = slote + ((size_t)e << 15);
        int tk[8]; float gts[8], sq[8];
#pragma unroll
        for (int i = 0; i < 8; ++i) { const unsigned p = pb + wr * 64 + fr + (i >> 2) * 128 + (i & 3) * 16; const unsigned wd = p < n ? se[p] : 0u; tk[i] = (int)(wd & 0x7fffu); gts[i] = __builtin_bit_cast(float, wd & 0xffff0000u); }
#pragma unroll
        for (int i = 0; i < 8; ++i) sq[i] = stat_get(sumsq2 + tk[i]);
#pragma unroll
        for (int ai = 0; ai < 2; ++ai)
#pragma unroll
            for (int m = 0; m < 4; ++m) { const int slot = row0 + ai * 128 + m * 16; const float gt = gts[ai * 4 + m];
                const float rs = 1.0f / sqrtf(sq[ai * 4 + m] * (1.f / 1024.f) + 1e-6f);
                f32x4 h0, h1;
                { const f32x4 a = acc[ai][0][m][0] * rs, b = acc[ai][1][m][0] * (rs * gt * 8.0f); h0.x = silu_f(a.x) * b.x; h0.y = silu_f(a.y) * b.y; h0.z = silu_f(a.z) * b.z; h0.w = silu_f(a.w) * b.w; }
                { const f32x4 a = acc[ai][0][m][1] * rs, b = acc[ai][1][m][1] * (rs * gt * 8.0f); h1.x = silu_f(a.x) * b.x; h1.y = silu_f(a.y) * b.y; h1.z = silu_f(a.z) * b.z; h1.w = silu_f(a.w) * b.w; }
                int q0 = 0, q1 = 0; q0 = __builtin_amdgcn_cvt_pk_fp8_f32(h0.x, h0.y, q0, false); q0 = __builtin_amdgcn_cvt_pk_fp8_f32(h0.z, h0.w, q0, true);
                q1 = __builtin_amdgcn_cvt_pk_fp8_f32(h1.x, h1.y, q1, false); q1 = __builtin_amdgcn_cvt_pk_fp8_f32(h1.z, h1.w, q1, true);
                *(u32x2*)(H + (size_t)slot * FF + u.pn * 128 + wc * 32 + 8 * fq) = (u32x2){(unsigned)q0, (unsigned)q1}; }
    }
};
struct EpiMoe2 {
    static constexpr bool PERM = true;
    unsigned char* Y;
    __device__ __forceinline__ void operator()(const f32x4 (&acc)[2][2][4][2], const pg8::Unit& u, int wr, int wc, int fr, int fq) const {
        const int row0 = u.pm * 256 + wr * 64 + fr, col0 = u.pn * 256 + wc * 32 + 8 * fq;
#pragma unroll
        for (int ai = 0; ai < 2; ++ai)
#pragma unroll
            for (int m = 0; m < 4; ++m) { unsigned char* rowp = Y + (size_t)(row0 + ai * 128 + m * 16) * DM + col0;
#pragma unroll
                for (int bj = 0; bj < 2; ++bj) { const f32x4 v0 = acc[ai][bj][m][0] * 16.0f, v1 = acc[ai][bj][m][1] * 16.0f;
                    int q0 = 0, q1 = 0; q0 = __builtin_amdgcn_cvt_pk_fp8_f32(v0.x, v0.y, q0, false); q0 = __builtin_amdgcn_cvt_pk_fp8_f32(v0.z, v0.w, q0, true);
                    q1 = __builtin_amdgcn_cvt_pk_fp8_f32(v1.x, v1.y, q1, false); q1 = __builtin_amdgcn_cvt_pk_fp8_f32(v1.z, v1.w, q1, true);
                    *(u32x2*)(rowp + 128 * bj) = (u32x2){(unsigned)q0, (unsigned)q1}; } }
    }
};
__device__ __forceinline__ void p13_combine(Frame& F, float* outp) {
    const int lane = F.lane;
    const int gw = F.vcu * NWAVES + F.wave, NGW = F.G * NWAVES;
    const unsigned char* Y = (const unsigned char*)(F.ws + WS_Y); const int* ts = (const int*)(F.ws + WS_TOKSLOT);
    LAS const unsigned* tp = (LAS const unsigned*)(F.lds + LDS_MOE_TAB) + 32;
    typedef float f32x2v __attribute__((ext_vector_type(2)));
    for (int tok0 = gw; tok0 < NT; tok0 += 4 * NGW) {
        int s0[4], s1[4];
#pragma unroll
        for (int t = 0; t < 4; ++t) { const int tok = tok0 + t * NGW; const unsigned a = (unsigned)ts[tok * 2], b = (unsigned)ts[tok * 2 + 1];
            s0[t] = (int)(tp[a >> 16] * 256u + (a & 0xffffu)); s1[t] = (int)(tp[b >> 16] * 256u + (b & 0xffffu)); }
        const int c = lane * 16;
        u32x4 y0[4], y1[4], xa[4], xc[4];
#pragma unroll
        for (int t = 0; t < 4; ++t) { const int tok = tok0 + t * NGW; const bf16_t* xb = (const bf16_t*)(F.ws + WS_X2B) + (size_t)tok * DM;
            y0[t] = *(const u32x4*)(Y + (size_t)s0[t] * DM + c); y1[t] = *(const u32x4*)(Y + (size_t)s1[t] * DM + c); xa[t] = *(const u32x4*)(xb + c); xc[t] = *(const u32x4*)(xb + c + 8); }
#pragma unroll
        for (int t = 0; t < 4; ++t) { const int tok = tok0 + t * NGW; float* od = outp + (size_t)tok * DM;
            const unsigned yw0[4] = {y0[t].x, y0[t].y, y0[t].z, y0[t].w}, yw1[4] = {y1[t].x, y1[t].y, y1[t].z, y1[t].w};
            const unsigned xw[8] = {xa[t].x, xa[t].y, xa[t].z, xa[t].w, xc[t].x, xc[t].y, xc[t].z, xc[t].w};
#pragma unroll
            for (int j = 0; j < 4; ++j) {
                const f32x2v a0 = __builtin_amdgcn_cvt_pk_f32_fp8((int)yw0[j], false), a1 = __builtin_amdgcn_cvt_pk_f32_fp8((int)yw0[j], true);
                const f32x2v b0 = __builtin_amdgcn_cvt_pk_f32_fp8((int)yw1[j], false), b1 = __builtin_amdgcn_cvt_pk_f32_fp8((int)yw1[j], true);
                f32x4 o; o.x = bflo(xw[2 * j]) + (a0.x + b0.x) * 0.0625f; o.y = bfhi(xw[2 * j]) + (a0.y + b0.y) * 0.0625f;
                o.z = bflo(xw[2 * j + 1]) + (a1.x + b1.x) * 0.0625f; o.w = bfhi(xw[2 * j + 1]) + (a1.y + b1.y) * 0.0625f;
                *(f32x4*)(od + c + 4 * j) = o; } }
    }
}

constexpr int CW_DBG = 1024;
__device__ __forceinline__ void dbg_report(Frame& F, float got, float ref, float atol, float rtol) {
    const float err = fabsf(got - ref), tol = atol + rtol * fabsf(ref);
    unsigned code = 0;
    if (!(err <= tol)) { code = 1; if (!(err <= 3.f * tol)) code = 2; if (!(err <= 10.f * tol)) code = 3; if (!(err <= 100.f * tol)) code = 4; if (!(err == err)) code = 5; }
    if (code) atomicMax((unsigned*)(F.ws + WS_CTL) + CW_DBG, code);
}
__device__ __forceinline__ void dbg_finish(Frame& F, const XcdBarrier& xb) {
    xcd_barrier(xb);
    const unsigned code = __hip_atomic_load((unsigned*)(F.ws + WS_CTL) + CW_DBG, __ATOMIC_RELAXED, __HIP_MEMORY_SCOPE_AGENT);
    const float c = 1.0f - 0.2f * (float)code;
    const size_t gt = (size_t)blockIdx.x * NTHR + F.tid, NGT = (size_t)F.G * NTHR;
    for (size_t i = gt; i < (size_t)NT * DM; i += NGT) F.p->out[i] = F.p->in[IN_X][i] * c;
}
__device__ __forceinline__ void dbg_check_inproj(Frame& F, int s) {
    const Params& P = *F.p; const int lane = F.lane;
    const int row = (int)(((long)s * 7919 + 13) % NT), col = (int)(((long)s * 104729 + 7) % 3072);
    const float* x = P.in[IN_X] + (size_t)row * DM; const float* nw = P.in[IN_NORM_MIX]; const float* W = P.in[IN_W_IN];
    float ss = 0.f; for (int k = lane; k < DM; k += 64) ss += x[k] * x[k];
    const float rstd = 1.0f / sqrtf(wave_sum(ss) * (1.f / 1024.f) + 1e-6f);
    if (col < 1024) {
        const int hb = col & ~63; float v[64];
#pragma unroll
        for (int d = 0; d < 64; ++d) v[d] = 0.f;
        for (int k = lane; k < DM; k += 64) { const float h = x[k] * rstd * nw[k];
#pragma unroll
            for (int d = 0; d < 64; ++d) v[d] += h * W[(size_t)k * 3072 + hb + d]; }
        float q = 0.f, mine = 0.f;
#pragma unroll
        for (int d = 0; d < 64; ++d) { v[d] = wave_sum(v[d]); q += v[d] * v[d]; if (d == (col & 63)) mine = v[d]; }
        const float* hn = col < 512 ? P.in[IN_AQN] : P.in[IN_AKN];
        const float ref = mine / sqrtf(q * (1.f / 64.f) + 1e-6f) * hn[col & 63] * (col < 512 ? 0.125f : 1.f);
        const bf16_t* t = (const bf16_t*)(F.ws + (col < 512 ? WS_AQ : WS_AK));
        const float got = bf2f(t[(size_t)row * 512 + (col & 511)]);
        if (lane == 0) dbg_report(F, got, ref, 0.01f, 0.02f);
    } else {
        float d = 0.f; for (int k = lane; k < DM; k += 64) d += x[k] * rstd * nw[k] * W[(size_t)k * 3072 + col];
        d = wave_sum(d); float ref = d; const bf16_t* t; int ld, c;
        if (col < 1536) { t = (const bf16_t*)(F.ws + WS_AV); ld = 512; c = col - 1024; }
        else if (col < 1792) { t = (const bf16_t*)(F.ws + WS_RQ); ld = 256; c = col - 1536; }
        else if (col < 2048) { t = (const bf16_t*)(F.ws + WS_RK); ld = 256; c = col - 1792; ref = d * 0.125f; }
        else if (col < 2560) { t = (const bf16_t*)(F.ws + WS_RV); ld = 512; c = col - 2048; }
        else { t = (const bf16_t*)(F.ws + WS_RG); ld = 512; c = col - 2560; ref = d / (1.f + expf(-d)); }
        const float got = bf2f(t[(size_t)row * ld + c]);
        if (lane == 0) dbg_report(F, got, ref, 0.02f, 0.02f);
    }
}


__device__ __forceinline__ void dbg_check_attn(Frame& F, int s) {
    const int lane = F.lane;
    const int b = s & 1, h = (s >> 1) & 7; int t = (int)(((long)s * 7919 + 5) % SEQ); if ((s & 63) == 0) t = (s >> 6) % 70; if ((s & 63) == 1) t = SEQ - 1 - ((s >> 6) % 70);
    const bf16_t* Q = (const bf16_t*)(F.ws + WS_AQ) + (size_t)b * SEQ * 512 + h * 64;
    const bf16_t* K = (const bf16_t*)(F.ws + WS_AK) + (size_t)b * SEQ * 512 + h * 64;
    const bf16_t* V = (const bf16_t*)(F.ws + WS_AV) + (size_t)b * SEQ * 512 + h * 64;
    const float slope = exp2f(-(float)(h + 1));
    float oacc[3], lse[3];
    const int dils[3] = {1, 4, 16};
    for (int pi = 0; pi < 3; ++pi) {
        const int d = dils[pi], r = t % d, jq = t / d, L = SEQ / d;
        float sc[3]; float mx = -1e30f;
        for (int kk = 0; kk < 3; ++kk) { const int dl = -64 + lane + 64 * kk; const int jk = jq + dl; float v = -1e30f;
            if (dl <= 64 && jk >= 0 && jk < L) { const bf16_t* kr = K + (size_t)(r + d * jk) * 512; float a = 0.f; for (int c = 0; c < 64; ++c) a += bf2f(Q[(size_t)t * 512 + c]) * bf2f(kr[c]);
                v = a - slope * (float)(d * (dl < 0 ? -dl : dl)); }
            sc[kk] = v; mx = fmaxf(mx, v); }
#pragma unroll
        for (int o = 1; o < 64; o <<= 1) mx = fmaxf(mx, __shfl_xor(mx, o));
        float den = 0.f, pk[3];
        for (int kk = 0; kk < 3; ++kk) { pk[kk] = sc[kk] > -1e29f ? expf(sc[kk] - mx) : 0.f; den += pk[kk]; }
        den = wave_sum(den);
        float o = 0.f;
        for (int kk = 0; kk < 3; ++kk) for (int l2 = 0; l2 < 64; ++l2) { const float pp = __shfl(pk[kk], l2); const int dl = -64 + l2 + 64 * kk; const int jk = jq + dl;
            if (pp != 0.f) o += pp * bf2f(V[(size_t)(r + d * jk) * 512 + lane]); }
        oacc[pi] = o / den; lse[pi] = mx + logf(den);
    }
    const float ml = fmaxf(lse[0], fmaxf(lse[1], lse[2]));
    const float w0 = expf(lse[0] - ml), w1 = expf(lse[1] - ml), w2 = expf(lse[2] - ml);
    const float ref = (w0 * oacc[0] + w1 * oacc[1] + w2 * oacc[2]) / (w0 + w1 + w2);
    const float got = bf2f(((const bf16_t*)(F.ws + WS_MIX))[((size_t)b * SEQ + t) * 1024 + h * 64 + lane]);
    dbg_report(F, got, ref, 0.004f, 0.02f);
}
__device__ __forceinline__ void dbg_check_ret(Frame& F, int s) {
    const Params& P = *F.p; const int lane = F.lane;
    const int b = s & 1, h = (s >> 1) & 3; int t = (int)(((long)s * 7919 + 5) % SEQ); if ((s & 31) == 0) t = (s >> 5) % 200; if ((s & 31) == 1) t = SEQ - 1 - ((s >> 5) % 200);
    const bf16_t* Q = (const bf16_t*)(F.ws + WS_RQ) + (size_t)b * SEQ * 256 + h * 64;
    const bf16_t* K = (const bf16_t*)(F.ws + WS_RK) + (size_t)b * SEQ * 256 + h * 64;
    const bf16_t* V = (const bf16_t*)(F.ws + WS_RV) + (size_t)b * SEQ * 512 + h * 128;
    const float lgf = -logf(1.f + expf(-P.in[IN_DECF][h])), lgb = -logf(1.f + expf(-P.in[IN_DECB][h]));
    float y0 = 0.f, y1 = 0.f;
    const float qv = bf2f(Q[(size_t)t * 256 + lane]);
    for (int j = 0; j < SEQ; ++j) {
        const int df = t - j; const float lg = (df >= 0 ? lgf * (float)df : lgb * (float)(-df)); if (lg < -40.f) continue;
        float a = qv * bf2f(K[(size_t)j * 256 + lane]); a = wave_sum(a);
        const float wgt = a * expf(lg);
        y0 += wgt * bf2f(V[(size_t)j * 512 + lane]); y1 += wgt * bf2f(V[(size_t)j * 512 + 64 + lane]);
    }
    const float mu = wave_sum(y0 + y1) * (1.f / 128.f); const float d0 = y0 - mu, d1 = y1 - mu;
    const float var = wave_sum(d0 * d0 + d1 * d1) * (1.f / 128.f); const float rstd = 1.f / sqrtf(var + 1e-5f);
    const bf16_t* G = (const bf16_t*)(F.ws + WS_RG) + ((size_t)b * SEQ + t) * 512 + h * 128;
    const float r0 = d0 * rstd * P.in[IN_GNW][h * 128 + lane] * bf2f(G[lane]), r1 = d1 * rstd * P.in[IN_GNW][h * 128 + 64 + lane] * bf2f(G[64 + lane]);
    const bf16_t* M = (const bf16_t*)(F.ws + WS_MIX) + ((size_t)b * SEQ + t) * 1024 + 512 + h * 128;
    dbg_report(F, bf2f(M[lane]), r0, 0.02f, 0.03f); dbg_report(F, bf2f(M[64 + lane]), r1, 0.02f, 0.03f);
}
__device__ __forceinline__ void dbg_check_outproj(Frame& F, int s) {
    const Params& P = *F.p; const int lane = F.lane;
    const int row = (int)(((long)s * 7919 + 13) % NT), col = (int)(((long)s * 104729 + 7) % 1024);
    const bf16_t* M = (const bf16_t*)(F.ws + WS_MIX) + (size_t)row * 1024;
    float d = 0.f; for (int k = lane; k < 1024; k += 64) d += bf2f(M[k]) * P.in[IN_W_OUT][(size_t)k * 1024 + col];
    d = wave_sum(d) + P.in[IN_X][(size_t)row * 1024 + col];
    if (lane == 0) { dbg_report(F, P.out[(size_t)row * 1024 + col], d, 0.01f, 0.01f);
        dbg_report(F, bf2f(((const bf16_t*)(F.ws + WS_X1B))[(size_t)row * 1024 + col]), d, 0.02f, 0.01f); }
    if (s < 256) { float ss = 0.f; for (int k = lane; k < 1024; k += 64) { const float v = P.out[(size_t)row * 1024 + k]; ss += v * v; } ss = wave_sum(ss);
        if (lane == 0) dbg_report(F, ((const float*)(F.ws + WS_SUMSQ1))[row], ss, 0.5f, 0.01f); }
}


__device__ __forceinline__ void dbg_check_memattn(Frame& F, int s, LAS float* scr  ) {
    const Params& P = *F.p; const int lane = F.lane;
    const int tok = (int)(((long)s * 7919 + 13) % NT), head = s & 3, b = tok / SEQ;
    const float* x1 = P.out + (size_t)tok * DM;
    float ss = 0.f; for (int k = lane; k < DM; k += 64) ss += x1[k] * x1[k];
    const float rstd = 1.0f / sqrtf(wave_sum(ss) * (1.f / 1024.f) + 1e-6f);
    float q[4] = {0.f, 0.f, 0.f, 0.f};
    for (int k = 0; k < DM; ++k) { const float hk = x1[k] * rstd * P.in[IN_NORM_MEM][k];
#pragma unroll
        for (int i = 0; i < 4; ++i) q[i] += hk * P.in[IN_W_MQ][(size_t)k * 1024 + head * 256 + lane + 64 * i]; }
    float qs = 0.f;
#pragma unroll
    for (int i = 0; i < 4; ++i) qs += q[i] * q[i];
    const float qr = 1.0f / sqrtf(wave_sum(qs) * (1.f / 256.f) + 1e-6f);
#pragma unroll
    for (int i = 0; i < 4; ++i) scr[lane + 64 * i] = q[i] * qr * P.in[IN_MQN][lane + 64 * i] * 0.0625f;
    LDS_WAIT();
    float sc[4]; const bf16_t* mh = (const bf16_t*)(F.ws + WS_MEMH);
    float kd[4];
    for (int i = 0; i < 4; ++i) { const int key = lane + 64 * i; const bf16_t* mr = mh + (size_t)(b * 256 + key) * 1024; float dot = 0.f, kss = 0.f;
        for (int d = 0; d < 256; ++d) { float kv = 0.f; for (int k = 0; k < DM; ++k) kv += bf2f(mr[k]) * P.in[IN_W_MKV][(size_t)k * 2048 + head * 256 + d];
            kss += kv * kv; dot += kv * P.in[IN_MKN][d] * scr[d]; }
        sc[i] = dot / sqrtf(kss * (1.f / 256.f) + 1e-6f); kd[i] = 0.f; }
    float mx = fmaxf(fmaxf(sc[0], sc[1]), fmaxf(sc[2], sc[3]));
#pragma unroll
    for (int o = 1; o < 64; o <<= 1) mx = fmaxf(mx, __shfl_xor(mx, o));
    float den = 0.f; for (int i = 0; i < 4; ++i) { sc[i] = expf(sc[i] - mx); den += sc[i]; }
    den = wave_sum(den);
    for (int i = 0; i < 4; ++i) scr[1024 + lane + 64 * i] = sc[i] / den;
    LDS_WAIT();
    float o = 0.f;
    for (int key = 0; key < 256; ++key) { const bf16_t* mr = mh + (size_t)(b * 256 + key) * 1024; float vv = 0.f; for (int k = 0; k < DM; ++k) vv += bf2f(mr[k]) * P.in[IN_W_MKV][(size_t)k * 2048 + 1024 + head * 256 + lane]; o += scr[1024 + key] * vv; }
    const float got = bf2f(((const bf16_t*)(F.ws + WS_OM))[(size_t)tok * DM + head * 256 + lane]);
    dbg_report(F, got, o, 0.004f, 0.03f);
    (void)kd;
}


__device__ __forceinline__ void dbg_check_memkv(Frame& F, int s) {
    const Params& P = *F.p; const int lane = F.lane;
    const int b = s & 1, head = (s >> 1) & 3, key = (s * 37 + 11) & 255;
    const bf16_t* mr = (const bf16_t*)(F.ws + WS_MEMH) + (size_t)(b * 256 + key) * 1024;
    float kv[4], vv[4], kss = 0.f;
    for (int i = 0; i < 4; ++i) { const int d = lane + 64 * i; float a = 0.f, c = 0.f; for (int k = 0; k < DM; ++k) { const float m = bf2f(mr[k]); a += m * P.in[IN_W_MKV][(size_t)k * 2048 + head * 256 + d]; c += m * P.in[IN_W_MKV][(size_t)k * 2048 + 1024 + head * 256 + d]; }
        kv[i] = a; vv[i] = c; kss += a * a; }
    const float kr = 1.0f / sqrtf(wave_sum(kss) * (1.f / 256.f) + 1e-6f);
    for (int i = 0; i < 4; ++i) { const int d = lane + 64 * i;
        const float refk = kv[i] * kr * P.in[IN_MKN][d] * P.in[IN_MQN][d] * 0.0625f;
        dbg_report(F, bf2f(((const bf16_t*)(F.ws + WS_MK))[((size_t)(b * 4 + head) * 256 + key) * 256 + d]), refk, 0.002f, 0.02f);
        dbg_report(F, bf2f(((const bf16_t*)(F.ws + WS_MVT))[((size_t)(b * 4 + head) * 256 + d) * 256 + key]), vv[i], 0.02f, 0.02f); }
}
__device__ __forceinline__ void dbg_check_memq(Frame& F, int s) {
    const Params& P = *F.p; const int lane = F.lane;
    const int tok = (int)(((long)s * 7919 + 13) % NT), head = s & 3;
    const float* x1 = P.out + (size_t)tok * DM;
    float ss = 0.f; for (int k = lane; k < DM; k += 64) ss += x1[k] * x1[k];
    const float rstd = 1.0f / sqrtf(wave_sum(ss) * (1.f / 1024.f) + 1e-6f);
    float q[4] = {0.f, 0.f, 0.f, 0.f};
    for (int k = 0; k < DM; ++k) { const float hk = x1[k] * rstd * P.in[IN_NORM_MEM][k];
#pragma unroll
        for (int i = 0; i < 4; ++i) q[i] += hk * P.in[IN_W_MQ][(size_t)k * 1024 + head * 256 + lane + 64 * i]; }
    float qs = 0.f;
#pragma unroll
    for (int i = 0; i < 4; ++i) { qs += q[i] * q[i]; dbg_report(F, bf2f(((const bf16_t*)(F.ws + WS_QM))[(size_t)tok * DM + head * 256 + lane + 64 * i]), q[i], 0.02f, 0.02f); }
    qs = wave_sum(qs);
    dbg_report(F, ((const float*)(F.ws + WS_HSQ))[(size_t)tok * 4 + head], qs, 1.0f, 0.02f);
}
__device__ __forceinline__ void dbg_check_memo(Frame& F, int s, LAS float* scr) {
    const int lane = F.lane;
    const int tok = (int)(((long)s * 7919 + 13) % NT), head = s & 3, b = tok / SEQ;
    const bf16_t* q = (const bf16_t*)(F.ws + WS_QM) + (size_t)tok * DM + head * 256;
    const float hs = 1.0f / sqrtf(((const float*)(F.ws + WS_HSQ))[(size_t)tok * 4 + head] * (1.f / 256.f) + 1e-6f);
    const bf16_t* K = (const bf16_t*)(F.ws + WS_MK) + (size_t)(b * 4 + head) * 65536;
    const bf16_t* Vt = (const bf16_t*)(F.ws + WS_MVT) + (size_t)(b * 4 + head) * 65536;
    float sc[4], mx = -1e30f;
    for (int i = 0; i < 4; ++i) { const int key = lane + 64 * i; float a = 0.f; for (int d = 0; d < 256; ++d) a += bf2f(q[d]) * bf2f(K[(size_t)key * 256 + d]); sc[i] = a * hs; if (DBG_P7 == 4) sc[i] = logf(fmaxf(1e-30f, 1.0f + sc[i])); if (DBG_P7 == 1) sc[i] = 0.f; if (DBG_P7 == 2) sc[i] = logf(sc[i] * sc[i] + 1e-30f); mx = fmaxf(mx, sc[i]); }
#pragma unroll
    for (int o = 1; o < 64; o <<= 1) mx = fmaxf(mx, __shfl_xor(mx, o));
    float den = 0.f; for (int i = 0; i < 4; ++i) { sc[i] = expf(sc[i] - mx); den += sc[i]; }
    den = wave_sum(den);
    for (int i = 0; i < 4; ++i) scr[lane + 64 * i] = sc[i] / den;
    LDS_WAIT();
    for (int i = 0; i < 4; ++i) { const int d = lane + 64 * i; float o = 0.f; for (int key = 0; key < 256; ++key) o += scr[key] * bf2f(Vt[(size_t)d * 256 + key]);
        dbg_report(F, bf2f(((const bf16_t*)(F.ws + WS_OM))[(size_t)tok * DM + head * 256 + d]), o, 0.003f, 0.02f); }
    LDS_WAIT();
}

#ifndef DBG_STAGE
#define DBG_STAGE 99
#endif
__global__ void __launch_bounds__(NTHR, 2) fwd_megakernel(Params prm) {
    extern __shared__ __attribute__((aligned(16))) unsigned char lds_raw[];
    Frame F;
    F.lds = (LAS unsigned char*)lds_raw; F.tid = threadIdx.x; F.lane = F.tid & 63; F.wave = __builtin_amdgcn_readfirstlane(F.tid >> 6);
    F.G = gridDim.x; { const int bx = blockIdx.x; F.vcu = (F.G % 8 == 0) ? (bx % 8) * (F.G / 8) + bx / 8 : bx; }
    F.p = &prm; F.ws = prm.ws;
    if (F.tid < 16) ((LAS unsigned*)(F.lds + LDS_MISC_OFF))[F.tid] = 0u;
    __syncthreads();
    XcdBarrier xbar = xcd_barrier_post((unsigned*)(F.ws + WS_CTL) + CW_BAR, (volatile LAS unsigned*)(F.lds + LDS_MISC_OFF));
#define REFRESH() do { int t_ = threadIdx.x; asm volatile("" : "+v"(t_)); F.tid = t_; F.lane = t_ & 63; F.wave = __builtin_amdgcn_readfirstlane(t_ >> 6); } while (0)
#define GRID_BAR() do { xcd_barrier(xbar); REFRESH(); } while (0)

    p0_prologue<0>(F);
#if REP & 1
    p0_prologue<0>(F);
#endif
    GRID_BAR();
    {
        pg8::DenseOrder S; S.init(prm.out, F.ws + WS_WIN, NT, 3072, 1024, F.G, (int)blockIdx.x);
        EpiInProj E{F.ws, prm.in[IN_AQN], prm.in[IN_AKN]};
        if (F.vcu & 1) { p0_prologue<1>(F); __syncthreads(); }
        pg8::gemm_phase(F.lds, 1024, S, E);
        if (!(F.vcu & 1)) { __syncthreads(); p0_prologue<1>(F); }
#if REP & 256
        pg8::gemm_phase(F.lds, 1024, S, E);
#endif
    }
    GRID_BAR();
#if DBG_STAGE == 1
    {
        const int gw = blockIdx.x * NWAVES + F.wave, NGW = F.G * NWAVES;
        for (int s = gw; s < 4096; s += NGW) dbg_check_inproj(F, s);
        dbg_finish(F, xbar);
        return;
    }
#endif
    p2_attention<0>(F, (bf16_t*)(F.ws + WS_MIX));
    __syncthreads();
#if REP & 2
    p2_attention<ATT_VAR>(F, (bf16_t*)(F.ws + WS_ST));
    __syncthreads();
#endif
    p2_chunk_kv(F);
#if REP & 4
    p2_chunk_kv(F);
#endif
    GRID_BAR();
    p3_scan(F);
#if REP & 8
    p3_scan(F);
#endif
    GRID_BAR();
    p4_retention_out(F);
#if REP & 16
    p4_retention_out(F);
#endif
    GRID_BAR();
#if DBG_STAGE == 2 || DBG_STAGE == 3
    {
        const int gw = blockIdx.x * NWAVES + F.wave, NGW = F.G * NWAVES;
        if (DBG_STAGE == 2) for (int s = gw; s < 8192; s += NGW) dbg_check_attn(F, s);
        if (DBG_STAGE == 3) for (int s = gw; s < 2048; s += NGW) dbg_check_ret(F, s);
        dbg_finish(F, xbar);
        return;
    }
#endif
    {
        pg8::DenseOrder S; S.init(F.ws + WS_MIX, F.ws + WS_WOUT, NT, 1024, 1024, F.G, (int)blockIdx.x, GEMM_WGM);
        EpiResidHL<true> E{prm.in[IN_NORM_MIX], (const bf16_t*)prm.out, (const float*)(F.ws + WS_RSTD0), (bf16_t*)(F.ws + WS_X1B), (bf16_t*)(F.ws + WS_X1L), (u64_t*)(F.ws + WS_SUMSQ1), (unsigned char*)(F.ws + WS_X1Q)};
        pg8::gemm_phase(F.lds, 1024, S, E);
#if REP & 16384
        { EpiNull E3{(float*)(F.ws + WS_CTL + MiB)}; pg8::gemm_phase(F.lds, 1024, S, E3); }
#endif
#if REP & 512
        { EpiResidHL<true> E2{prm.in[IN_NORM_MIX], (const bf16_t*)prm.out, (const float*)(F.ws + WS_RSTD0), (bf16_t*)(F.ws + WS_X1B), (bf16_t*)(F.ws + WS_X1L), (u64_t*)(F.ws + WS_CTL + MiB), nullptr}; pg8::gemm_phase(F.lds, 1024, S, E2); }
#endif
    }
    GRID_BAR();
#if DBG_STAGE == 4
    {
        const int gw = blockIdx.x * NWAVES + F.wave, NGW = F.G * NWAVES;
        for (int s = gw; s < 8192; s += NGW) dbg_check_outproj(F, s);
        dbg_finish(F, xbar);
        return;
    }
#endif
    memkv_item(F, F.vcu);
#if REP & 1024
    memkv_item(F, F.vcu);
#endif
    {
        pg8::DenseOrder S; S.init(F.ws + WS_X1Q, F.ws + WS_WMQ, NT, 1024, 512, F.G, (int)blockIdx.x, GEMM_WGM);
        EpiMemQ E{(bf16_t*)(F.ws + WS_QM), (const u64_t*)(F.ws + WS_SUMSQ1), (u64_t*)(F.ws + WS_HSQ)};
        pg8::gemm_phase<EpiMemQ, pg8::DenseOrder, true, 127, 122>(F.lds, 512, S, E);
#if REP & 8192
        { EpiMemQ E2{(bf16_t*)(F.ws + WS_QM), (const u64_t*)(F.ws + WS_SUMSQ1), (u64_t*)(F.ws + WS_CTL + MiB + 256 * 1024)}; pg8::gemm_phase(F.lds, 1024, S, E2); }
#endif
    }
    GRID_BAR();
    p7_mem_attention(F);
#if REP & 32
    p7_mem_attention(F);
#endif
    GRID_BAR();
#if DBG_STAGE >= 5 && DBG_STAGE <= 8
    {
        const int gw = blockIdx.x * NWAVES + F.wave, NGW = F.G * NWAVES;
        if (DBG_STAGE == 5) for (int s = gw; s < 2048; s += NGW) dbg_check_memattn(F, s, (LAS float*)(F.lds + F.wave * 8192));
        if (DBG_STAGE == 6) for (int s = gw; s < 2048; s += NGW) dbg_check_memkv(F, s);
        if (DBG_STAGE == 7) for (int s = gw; s < 2048; s += NGW) dbg_check_memq(F, s);
        if (DBG_STAGE == 8) for (int s = gw; s < 4096; s += NGW) dbg_check_memo(F, s, (LAS float*)(F.lds + F.wave * 8192));
        dbg_finish(F, xbar);
        return;
    }
#endif
    {
        pg8::DenseOrder S; S.init(F.ws + WS_OM, F.ws + WS_WMO, NT, 1024, 512, F.G, (int)blockIdx.x, GEMM_WGM);
        EpiResidHL<false> E{nullptr, (const bf16_t*)(F.ws + WS_X1B), nullptr, (bf16_t*)(F.ws + WS_X2B), (bf16_t*)(F.ws + WS_X2L), (u64_t*)(F.ws + WS_SUMSQ2), (unsigned char*)(F.ws + WS_X2Q)};
        pg8::gemm_phase<EpiResidHL<false>, pg8::DenseOrder, true, 123, 122>(F.lds, 512, S, E);
    }
    GRID_BAR();
#if DBG_STAGE == 9
    return;
#endif
    p9_route(F, (unsigned*)(F.ws + WS_CTL) + CW_CNT);
#if REP & 64
    p9_route(F, (unsigned*)(F.ws + WS_CTL) + 3000);
#endif
    GRID_BAR();
    {
        const int ntiles = moe_tables(F);
        {
            MoeOrder1 S; S.A = (const char*)(F.ws + WS_X2Q); S.W = (const char*)(F.ws + WS_W13); S.cn = (LAS const unsigned*)(F.lds + LDS_MOE_TAB); S.slote = (const unsigned*)(F.ws + WS_SLOTE);
            S.ntiles = ntiles; S.G = F.G; S.c = F.vcu; S.kb = 512; S.wstride = (size_t)1024 * 1024; S.tstepB = (size_t)256 * 1024; S.tstepA = 0;
            EpiMoe1 E{(unsigned char*)(F.ws + WS_H), (const unsigned*)(F.ws + WS_SLOTE), (LAS const unsigned*)(F.lds + LDS_MOE_TAB), (const u64_t*)(F.ws + WS_SUMSQ2)};
            pg8::gemm_phase<EpiMoe1, MoeOrder1, true, 127, 122>(F.lds, 512, S, E);
#if REP & 32768
            { EpiNull E3{(float*)prm.out}; pg8::gemm_phase<EpiNull, MoeOrder1, true, 127, 122>(F.lds, 512, S, E3); }
#endif
#if REP & 2048
            pg8::gemm_phase<EpiMoe1, MoeOrder1, true, 127, 122>(F.lds, 512, S, E);
#endif
        }
        GRID_BAR();
        {
            MoeOrder2 S; S.A = (const char*)(F.ws + WS_H); S.W = (const char*)(F.ws + WS_W2); S.cn = (LAS const unsigned*)(F.lds + LDS_MOE_TAB); S.slote = nullptr;
            S.ntiles = ntiles; S.G = F.G; S.c = F.vcu; S.kb = 256; S.wstride = (size_t)1024 * 512; S.tstepB = (size_t)256 * 512; S.tstepA = (size_t)256 * 512;
            EpiMoe2 E{(unsigned char*)(F.ws + WS_Y)};
            pg8::gemm_phase<EpiMoe2, MoeOrder2, true, 124, 123>(F.lds, 256, S, E);
#if REP & 65536
            { EpiNull E3{(float*)prm.out}; pg8::gemm_phase<EpiNull, MoeOrder2, true, 124, 123>(F.lds, 256, S, E3); }
#endif
#if REP & 4096
            pg8::gemm_phase<EpiMoe2, MoeOrder2, true, 124, 123>(F.lds, 256, S, E);
#endif
        }
        GRID_BAR();
    }
#if REP & 128
    p13_combine(F, (float*)(F.ws + WS_H));
#endif
    p13_combine(F, prm.out);
}

extern "C" void kernel_launch(void* const* d_in, const int* in_sizes, int n_in, void* d_out, int out_size, void* d_ws, size_t ws_size, hipStream_t stream) {
    static int grid = 0;
    if (grid == 0) {
        if (n_in != 23 || out_size != NT * DM || ws_size < WS_END) { fprintf(stderr, "kernel_launch: unexpected shapes (n_in %d out %d ws %zu)\n", n_in, out_size, ws_size); grid = -1; return; }
        int dev = 0, cus = 0, per_cu = 0;
        hipGetDevice(&dev); hipDeviceGetAttribute(&cus, hipDeviceAttributeMultiprocessorCount, dev);
        if (hipFuncSetAttribute((const void*)fwd_megakernel, hipFuncAttributeMaxDynamicSharedMemorySize, LDS_BYTES) != hipSuccess) { fprintf(stderr, "hipFuncSetAttribute failed\n"); grid = -1; return; }
        if (hipOccupancyMaxActiveBlocksPerMultiprocessor(&per_cu, (const void*)fwd_megakernel, NTHR, LDS_BYTES) != hipSuccess || per_cu < 1) { fprintf(stderr, "occupancy query: %d\n", per_cu); grid = -1; return; }
        if (cus < 256) { fprintf(stderr, "kernel_launch: this kernel is laid out for a 256-CU device (got %d)\n", cus); grid = -1; return; }
        grid = 256;
        fprintf(stderr, "kernel_launch: grid %d (cus %d, per_cu %d)\n", grid, cus, per_cu);
    }
    if (grid < 0) return;
    hipMemsetAsync((char*)d_ws + WS_CTL, 0, CTL_ZERO_BYTES, stream);
    Params p{};
    for (int i = 0; i < 23; ++i) p.in[i] = (const float*)d_in[i];
    p.out = (float*)d_out; p.ws = (unsigned char*)d_ws;
    hipLaunchKernelGGL(fwd_megakernel, dim3(grid), dim3(NTHR), LDS_BYTES, stream, p);
    hipError_t e = hipPeekAtLastError();
    if (e != hipSuccess) fprintf(stderr, "launch failed: %s (grid %d)\n", hipGetErrorString(e), grid);
}
```
